# Optimizing an MI355X kernel written in HIP

```python
import math
import jax, jax.numpy as jnp
from jax import lax
import numpy as np

D_MODEL = 1024
BATCH = 2
SEQ = 8192
DEPTH = 2

GRID_W = 64
A_HEADS = 8
A_HEAD_DIM = 64
DIL_CFG = ((128, 1), (512, 4), (2048, 16))
A_PAD = 1024
A_QB = 64
N_BUCKETS = 32
T5_MAX_DIST = 1024
B_HEADS = 4
B_DK = 128
B_DV = 128
B_CHUNK = 64
C_GROUPS = 4
C_WIDTH = 128
D_Q_HEADS = 8
D_KV_HEADS = 2
D_HEAD_DIM = 64
D_QB = 128
ROPE_THETA = 10000.0
FFN_HIDDEN = ((8 * D_MODEL + 2) // 3 + 255) // 256 * 256
A_W = A_HEADS * A_HEAD_DIM
B_WK = B_HEADS * B_DK
B_WV = B_HEADS * B_DV
AB_IN = 3 * A_W + 3 * B_WK + 2 * B_WV
AB_OUT = A_W + B_WV
C_W = C_GROUPS * C_WIDTH
DQ_W = D_Q_HEADS * D_HEAD_DIM
DKV_W = D_KV_HEADS * D_HEAD_DIM
CD_IN = C_W + DQ_W + 2 * DKV_W
CD_OUT = C_W + DQ_W
NEG_INF = -1e30

kernel_name = 'hybrid_dilated_hgrn2_fnet_gqa_encoder'


def rms_norm(x, gain, eps=1e-6):
    xf = x.astype(jnp.float32)
    y = xf * lax.rsqrt(jnp.mean(xf * xf, axis=-1, keepdims=True) + eps)
    return (y * gain.astype(jnp.float32)).astype(x.dtype)


def modulate(h, shift, scale):
    return h * (1.0 + scale[:, None, :]) + shift[:, None, :]


def split_cols(z, sizes):
    outs, start = [], 0
    for s in sizes:
        outs.append(z[..., start:start + s])
        start += s
    return outs


def t5_buckets(rel):
    half = N_BUCKETS // 2
    max_exact = half // 2
    n = np.abs(rel)
    large = max_exact + (np.log(np.maximum(n, 1) / max_exact) / np.log(T5_MAX_DIST / max_exact)
                         * (half - max_exact)).astype(np.int32)
    large = np.minimum(large, half - 1)
    return (np.where(rel > 0, half, 0) + np.where(n < max_exact, n, large)).astype(np.int32)


def dilated_offsets():
    offs = []
    for w, d in DIL_CFG:
        r = (w // 2) // d
        offs.append(np.arange(-r, r + 1) * d)
    return np.concatenate(offs).astype(np.int32)


def dilated_attention(q, k, v, bias_table):
    bsz, seq, nh, dh = q.shape
    f32 = jnp.float32
    n_br = len(DIL_CFG)
    offs = dilated_offsets()
    bias = bias_table[t5_buckets(offs)].astype(f32).T
    local = np.arange(A_QB)[:, None] + offs[None, :]
    gather_idx = local + A_PAD
    kv = jnp.pad(jnp.concatenate([k, v], axis=-1), ((0, 0), (A_PAD, A_PAD), (0, 0), (0, 0)))
    scale = dh ** -0.5

    def block(bi):
        q0 = bi * A_QB
        qb = lax.dynamic_slice_in_dim(q, q0, A_QB, axis=1).astype(f32)
        kv_win = lax.dynamic_slice_in_dim(kv, q0, A_QB + 2 * A_PAD, axis=1)
        kv_g = kv_win[:, gather_idx].astype(f32)
        kg, vg = kv_g[..., :dh], kv_g[..., dh:]
        logits = jnp.einsum('bqhd,bqjhd->bqhj', qb, kg) * scale + bias[None, None]
        pos = q0 + local
        valid = (pos >= 0) & (pos < seq)
        logits = jnp.where(valid[None, :, None, :], logits, NEG_INF)
        logits = logits.reshape(bsz, A_QB, nh, n_br, -1)
        m = jnp.max(logits, axis=-1, keepdims=True)
        p = jnp.exp(logits - m)
        den = jnp.sum(p, axis=-1)
        vg = vg.reshape(bsz, A_QB, n_br, -1, nh, dh)
        o_br = jnp.einsum('bqhrj,bqrjhd->bqhrd', p, vg) / den[..., None]
        m = m[..., 0]
        wgt = den * jnp.exp(m - jnp.max(m, axis=-1, keepdims=True))
        wgt = wgt / jnp.sum(wgt, axis=-1, keepdims=True)
        return jnp.einsum('bqhr,bqhrd->bqhd', wgt, o_br).astype(q.dtype)

    out = lax.map(block, jnp.arange(seq // A_QB))
    return out.transpose(1, 0, 2, 3, 4).reshape(bsz, seq, nh, dh)


def hgrn2_scan(q, k, log_f, v):
    bsz, seq, nh, dk = q.shape
    dv = v.shape[-1]
    nc = seq // B_CHUNK

    def to_chunks(a):
        return a.reshape(bsz, nc, B_CHUNK, nh, a.shape[-1]).transpose(1, 0, 3, 2, 4)

    causal = np.tril(np.ones((B_CHUNK, B_CHUNK), dtype=bool))[:, :, None]

    def step(state, inp):
        qc, kc, gc, vc = inp
        b = jnp.cumsum(gc, axis=2)
        o_inter = jnp.einsum('bhtk,bhkv->bhtv', qc * jnp.exp(b), state)
        diff = b[:, :, :, None, :] - b[:, :, None, :, :]
        decay = jnp.exp(jnp.where(causal, diff, -jnp.inf))
        attn = jnp.einsum('bhtk,bhsk,bhtsk->bhts', qc, kc, decay)
        o_intra = jnp.einsum('bhts,bhsv->bhtv', attn, vc)
        b_last = b[:, :, -1:, :]
        new_state = (jnp.exp(b_last[:, :, 0, :, None]) * state
                     + jnp.einsum('bhsk,bhsv->bhkv', kc * jnp.exp(b_last - b), vc))
        return new_state, o_inter + o_intra

    state0 = jnp.zeros((bsz, nh, dk, dv), jnp.float32)
    _, o = lax.scan(step, state0, (to_chunks(q), to_chunks(k), to_chunks(log_f), to_chunks(v)))
    return o.transpose(1, 0, 3, 2, 4).reshape(bsz, seq, nh, dv)


def hgrn2_mixer(q, f_fwd, f_bwd, i, g, lb, out_norm):
    bsz, seq, _ = q.shape
    f32 = jnp.float32
    shp_k = (bsz, seq, B_HEADS, B_DK)
    qf = q.astype(f32).reshape(shp_k) * B_DK ** -0.5
    vf = i.astype(f32).reshape(bsz, seq, B_HEADS, B_DV)
    lb = lb.reshape(2, B_HEADS, B_DK)

    def gates(fpre, lbd):
        fa = lbd + (1.0 - lbd) * jax.nn.sigmoid(fpre.astype(f32).reshape(shp_k))
        return 1.0 - fa, jnp.log(fa)

    k_f, lf_f = gates(f_fwd, lb[0])
    k_b, lf_b = gates(f_bwd, lb[1])
    o_fwd = hgrn2_scan(qf, k_f, lf_f, vf)
    o_bwd = jnp.flip(hgrn2_scan(jnp.flip(qf, 1), jnp.flip(k_b, 1), jnp.flip(lf_b, 1), jnp.flip(vf, 1)), 1)
    o = rms_norm(o_fwd + o_bwd, out_norm) * jax.nn.silu(g.astype(f32).reshape(bsz, seq, B_HEADS, B_DV))
    return o.reshape(bsz, seq, B_WV).astype(q.dtype)


def fourier_mixer(u):
    bsz, seq, _ = u.shape
    ug = u.astype(jnp.float32).reshape(bsz, seq, C_GROUPS, C_WIDTH)
    y = jnp.fft.fftn(ug, axes=(1, 3), norm='ortho').real
    return y.reshape(bsz, seq, C_W).astype(u.dtype)


def axial_rope_tables(seq):
    rows = seq // GRID_W
    row = jnp.repeat(jnp.arange(rows, dtype=jnp.float32), GRID_W)
    col = jnp.tile(jnp.arange(GRID_W, dtype=jnp.float32), rows)
    axis_dim = D_HEAD_DIM // 2
    inv_freq = jnp.power(ROPE_THETA, -jnp.arange(0, axis_dim, 2, dtype=jnp.float32) / axis_dim)
    ang_r = row[:, None] * inv_freq[None, :]
    ang_c = col[:, None] * inv_freq[None, :]
    return (jnp.cos(ang_r), jnp.sin(ang_r), jnp.cos(ang_c), jnp.sin(ang_c))


def rotate(x, cos, sin):
    m = x.shape[-1] // 2
    x1, x2 = x[..., :m], x[..., m:]
    cos = cos[None, :, None, :]
    sin = sin[None, :, None, :]
    return jnp.concatenate([x1 * cos - x2 * sin, x1 * sin + x2 * cos], axis=-1)


def apply_axial_rope(x, tabs):
    cr, sr, cc, sc = tabs
    half = x.shape[-1] // 2
    xf = x.astype(jnp.float32)
    out = jnp.concatenate([rotate(xf[..., :half], cr, sr), rotate(xf[..., half:], cc, sc)], axis=-1)
    return out.astype(x.dtype)


def gqa_attention(q, k, v):
    bsz, seq, hq, dh = q.shape
    hkv = k.shape[2]
    rep = hq // hkv
    f32 = jnp.float32
    qb = q.reshape(bsz, seq // D_QB, D_QB, hkv, rep, dh).transpose(1, 0, 2, 3, 4, 5)
    kf = k.astype(f32)
    vf = v.astype(f32)
    scale = dh ** -0.5

    def block(qblk):
        s = jnp.einsum('bqgrd,bkgd->bgrqk', qblk.astype(f32), kf) * scale
        p = jax.nn.softmax(s, axis=-1)
        return jnp.einsum('bgrqk,bkgd->bqgrd', p, vf).astype(q.dtype)

    o = lax.map(block, qb)
    return o.transpose(1, 0, 2, 3, 4, 5).reshape(bsz, seq, hq * dh)


def setup_inputs(seed: int = 0) -> dict:
    key = jax.random.key(seed)
    ks = jax.random.split(key, 16)
    f32 = jnp.float32
    n_even = (DEPTH + 1) // 2
    n_odd = DEPTH // 2

    def nrm(k, shape, scale):
        return jax.random.normal(k, shape, f32) * scale

    return {
        'x': nrm(ks[0], (BATCH, SEQ, D_MODEL), 1.0),
        'c': nrm(ks[1], (BATCH, D_MODEL), 1.0),
        't5_bias': nrm(ks[2], (N_BUCKETS, A_HEADS), 0.5),
        'hgrn_lb_logits': nrm(ks[3], (DEPTH + 1, 2, B_WK), 0.5),
        'ada_w': nrm(ks[4], (DEPTH, D_MODEL, 6 * D_MODEL), 0.5 * D_MODEL ** -0.5),
        'ada_b': nrm(ks[5], (DEPTH, 6 * D_MODEL), 0.02),
        'norm_gains': 1.0 + nrm(ks[6], (DEPTH, 4, D_MODEL), 0.02),
        'ab_w_in': nrm(ks[7], (n_even, D_MODEL, AB_IN), D_MODEL ** -0.5),
        'ab_w_out': nrm(ks[8], (n_even, AB_OUT, D_MODEL), AB_OUT ** -0.5),
        'hgrn_out_norm': 1.0 + nrm(ks[9], (n_even, B_DV), 0.02),
        'cd_w_in': nrm(ks[10], (n_odd, D_MODEL, CD_IN), D_MODEL ** -0.5),
        'cd_w_out': nrm(ks[11], (n_odd, CD_OUT, D_MODEL), CD_OUT ** -0.5),
        'qk_norm': 1.0 + nrm(ks[12], (n_odd, 2, D_HEAD_DIM), 0.02),
        'ffn_w_in': nrm(ks[13], (DEPTH, D_MODEL, 2 * FFN_HIDDEN), D_MODEL ** -0.5),
        'ffn_w_out': nrm(ks[14], (DEPTH, FFN_HIDDEN, D_MODEL), FFN_HIDDEN ** -0.5),
    }


def reference(x, c, t5_bias, hgrn_lb_logits, ada_w, ada_b, norm_gains, ab_w_in, ab_w_out,
              hgrn_out_norm, cd_w_in, cd_w_out, qk_norm, ffn_w_in, ffn_w_out):
    bsz, seq, _ = x.shape
    lb_all = jnp.cumsum(jax.nn.softmax(hgrn_lb_logits.astype(jnp.float32), axis=0), axis=0)
    rope = axial_rope_tables(seq)
    cond = jax.nn.silu(c)
    for layer in range(DEPTH):
        mod = cond @ ada_w[layer] + ada_b[layer]
        sh_m, sc_m, g_m, sh_f, sc_f, g_f = jnp.split(mod, 6, axis=-1)
        h = modulate(rms_norm(x, norm_gains[layer, 0]), sh_m, sc_m)
        j = layer // 2
        if layer % 2 == 0:
            z = h @ ab_w_in[j]
            qa, ka, va, qh, ffw, fbw, ih, gh = split_cols(
                z, (A_W, A_W, A_W, B_WK, B_WK, B_WK, B_WV, B_WV))
            hs = (bsz, seq, A_HEADS, A_HEAD_DIM)
            a_out = dilated_attention(qa.reshape(hs), ka.reshape(hs), va.reshape(hs), t5_bias)
            b_out = hgrn2_mixer(qh, ffw, fbw, ih, gh, lb_all[layer], hgrn_out_norm[j])
            y = jnp.concatenate([a_out.reshape(bsz, seq, A_W), b_out], axis=-1) @ ab_w_out[j]
        else:
            z = h @ cd_w_in[j]
            uc, qd, kd, vd = split_cols(z, (C_W, DQ_W, DKV_W, DKV_W))
            c_out = fourier_mixer(uc)
            qd = apply_axial_rope(rms_norm(qd.reshape(bsz, seq, D_Q_HEADS, D_HEAD_DIM), qk_norm[j, 0]), rope)
            kd = apply_axial_rope(rms_norm(kd.reshape(bsz, seq, D_KV_HEADS, D_HEAD_DIM), qk_norm[j, 1]), rope)
            d_out = gqa_attention(qd, kd, vd.reshape(bsz, seq, D_KV_HEADS, D_HEAD_DIM))
            y = jnp.concatenate([c_out, d_out], axis=-1) @ cd_w_out[j]
        x = x + g_m[:, None, :] * rms_norm(y, norm_gains[layer, 1])
        h = modulate(rms_norm(x, norm_gains[layer, 2]), sh_f, sc_f)
        gt, up = jnp.split(h @ ffn_w_in[layer], 2, axis=-1)
        y = (jax.nn.silu(gt) * up) @ ffn_w_out[layer]
        x = x + g_f[:, None, :] * rms_norm(y, norm_gains[layer, 3])
    return x
```

```cpp
#include <hip/hip_runtime.h>
#include <cstdio>
#include <cstdint>
namespace pg8 {
#define PG8_LAS __attribute__((address_space(3)))
typedef unsigned short bf16_t;
typedef short bf16x8 __attribute__((ext_vector_type(8)));
typedef float f32x4 __attribute__((ext_vector_type(4)));
typedef unsigned u32x4 __attribute__((ext_vector_type(4)));
constexpr int BM = 256, BK = 64, HALF = 128, HTB = HALF * BK * 2  , STAGE_BYTES = 8 * HTB, NXCD = 8, WGM = 8;

__host__ __device__ __forceinline__ int lds_byte(int r, int c) { const int st = (r >> 4) * 2 + (c >> 5), rr = r & 15, cc = c & 31, ob = rr * 64 + cc * 2; return st * 1024 + (ob ^ (((ob >> 9) & 1) << 5)); }
__host__ __device__ __forceinline__ void stage_rc(int b, int& R, int& C) { const int st = b / 1024, sb = b % 1024, swz = sb ^ (((sb >> 9) & 1) << 5); R = (st >> 1) * 16 + swz / 64; C = (st & 1) * 32 + (swz % 64) / 2; }
__host__ __device__ __forceinline__ int perm32(int rho) { const int n = rho >> 4, i = rho & 15; return 8 * (i >> 2) + 4 * n + (i & 3); }

struct Unit { int pm, pn; };
struct Gemm { const bf16_t* A; const bf16_t* Bt; int M, N, K; };

struct StaticOrder {
    int nM, nN, nwg, G, c;
    __host__ __device__ void init(int M, int N, int G_, int c_) { nM = M / BM; nN = N / BM; nwg = nM * nN; G = G_; c = c_; }
    __host__ __device__ bool next(int i, Unit& u) const {
        const long L = (long)i * G + c; if (L >= nwg) return false;
        int wgid = (int)L; { const int q = nwg / NXCD, r = nwg % NXCD, xcd = wgid % NXCD, off = wgid / NXCD; wgid = (xcd < r ? xcd * (q + 1) : r * (q + 1) + (xcd - r) * q) + off; }
        const int nig = WGM * nN, gid = wgid / nig, fm = gid * WGM, gsz = (nM - fm) < WGM ? (nM - fm) : WGM;
        u.pm = fm + ((wgid % nig) % gsz); u.pn = (wgid % nig) / gsz; return true;
    }
    __device__ __forceinline__ void a_ready(const Unit&) const {}
    __device__ __forceinline__ void done(const Unit&) const {}
};

__device__ __forceinline__ unsigned cvt_pk_bf16(float lo, float hi) { unsigned r; asm volatile("v_cvt_pk_bf16_f32 %0, %1, %2" : "=v"(r) : "v"(lo), "v"(hi)); return r; }
typedef float f32x2 __attribute__((ext_vector_type(2)));
__device__ __forceinline__ f32x2 gelu_pk(f32x2 v) {
    const f32x2 av = __builtin_elementwise_abs(v), d = av * 0.2316418882f + 1.0f;
    f32x2 t; t.x = __builtin_amdgcn_rcpf(d.x); t.y = __builtin_amdgcn_rcpf(d.y);
    f32x2 q = t * 0.5307027145f + (-0.7265760135f); q = q * t + 0.7107068705f; q = q * t + (-0.142248368f); q = q * t + 0.127414796f; q = q * t;
    const f32x2 s = (v * v) * (-0.72134752044f);
    f32x2 e; e.x = __builtin_amdgcn_exp2f(s.x); e.y = __builtin_amdgcn_exp2f(s.y);
    const f32x2 m = v * (q * e), r = v - m;
    f32x2 o; o.x = v.x < 0.f ? m.x : r.x; o.y = v.y < 0.f ? m.y : r.y; return o;
}

template <int ACT  > struct EpiBf16 {
    static constexpr bool PERM = true, AFTER_DRAIN = false; static_assert(ACT == 0 || ACT == 1, "EpiBf16: ACT is 0 (none) or 1 (gelu_pk)");
    bf16_t* O; int ldc; const float* bias; int split_cols; size_t split_stride; float scale0;
    __device__ __forceinline__ void operator()(const f32x4 (&acc)[2][2][4][2], const Unit& u, int wr, int wc, int fr, int fq) const {
        const int row0 = u.pm * BM + wr * 64 + fr; int colt = u.pn * BM; bf16_t* base = O;
        float sc = 1.f; if (split_cols) { const int t = colt / split_cols; base += (size_t)t * split_stride; colt -= t * split_cols; if (t == 0) sc = scale0; }
        const int col0 = colt + wc * 32 + 8 * fq, bcol0 = u.pn * BM + wc * 32 + 8 * fq;
        f32x4 bv[2][2];
#pragma unroll
        for (int bj = 0; bj < 2; ++bj)
#pragma unroll
            for (int n = 0; n < 2; ++n) bv[bj][n] = bias ? *(const f32x4*)(bias + bcol0 + bj * HALF + 4 * n) : (f32x4){0.f, 0.f, 0.f, 0.f};
#pragma unroll
        for (int ai = 0; ai < 2; ++ai)
#pragma unroll
            for (int m = 0; m < 4; ++m) { bf16_t* rowp = base + (size_t)(row0 + ai * HALF + m * 16) * ldc + col0;
#pragma unroll
                for (int bj = 0; bj < 2; ++bj) { f32x4 v0 = acc[ai][bj][m][0] + bv[bj][0], v1 = acc[ai][bj][m][1] + bv[bj][1];
                    if (ACT == 1) { f32x2 a = gelu_pk((f32x2){v0[0], v0[1]}), b = gelu_pk((f32x2){v0[2], v0[3]}), c = gelu_pk((f32x2){v1[0], v1[1]}), d = gelu_pk((f32x2){v1[2], v1[3]});
                        v0 = (f32x4){a.x, a.y, b.x, b.y}; v1 = (f32x4){c.x, c.y, d.x, d.y}; }
                    v0 = v0 * sc; v1 = v1 * sc; u32x4 w; w.x = cvt_pk_bf16(v0[0], v0[1]); w.y = cvt_pk_bf16(v0[2], v0[3]); w.z = cvt_pk_bf16(v1[0], v1[1]); w.w = cvt_pk_bf16(v1[2], v1[3]);
                    *(u32x4*)(rowp + bj * HALF) = w; } }
    }
};
template <class Epi, class Sched, bool ALIGN_EPI = false, bool SP2 = false>
__device__ __forceinline__ void gemm_phase(PG8_LAS unsigned char* lds, const Gemm g, const Sched& S, const Epi& E) {
    const int tid = threadIdx.x, wid = __builtin_amdgcn_readfirstlane(tid >> 6), lane = tid & 63, wr = wid >> 2, wc = wid & 3, fr = lane & 15, fq = lane >> 4;
    const int K = g.K, nt = K / BK;
    unsigned voffA[2], voffB[2];
#pragma unroll
    for (int i = 0; i < 2; ++i) { int R, C; stage_rc(tid * 16 + i * 8192, R, C); const int Rb = Epi::PERM ? ((R & ~31) + perm32(R & 31)) : R;
        voffA[i] = (unsigned)(R * K + C) * 2u; voffB[i] = (unsigned)(Rb * K + C) * 2u; }
    const size_t kstep = (size_t)(BK * 2);
    const size_t hstep = (size_t)HALF * K * 2;
    const size_t tstep = 2 * hstep;
    const unsigned ldsw = (unsigned)wid * 1024u;
    const int aoff = lds_byte(wr * 64 + fr, fq * 8), boff = lds_byte(wc * 32 + fr, fq * 8);
#define PG8_SA(b, h) (((b) * 2 + (h)) * HTB)
#define PG8_SB(b, h) ((4 + (b) * 2 + (h)) * HTB)
#define PG8_STAGE(bufoff, gbase, voff) do { _Pragma("unroll") for (int _i = 0; _i < 2; ++_i) \
        __builtin_amdgcn_global_load_lds((const unsigned*)((const char*)(gbase) + (voff)[_i]), (PG8_LAS unsigned*)(lds + (bufoff) + ldsw + _i * 8192), 16, 0, 0); } while (0)
#define PG8_LDA(dst, b, h) do { _Pragma("unroll") for (int m = 0; m < 4; ++m) _Pragma("unroll") for (int k = 0; k < 2; ++k) dst[m][k] = *(const PG8_LAS bf16x8*)(lds + PG8_SA(b, h) + aoff + m * 2048 + k * 1024); } while (0)
#define PG8_LDB(dst, b, h) do { _Pragma("unroll") for (int n = 0; n < 2; ++n) _Pragma("unroll") for (int k = 0; k < 2; ++k) dst[n][k] = *(const PG8_LAS bf16x8*)(lds + PG8_SB(b, h) + boff + n * 2048 + k * 1024); } while (0)
#define PG8_MMA(ai, bj, At, Bt) do { __builtin_amdgcn_s_setprio(1); _Pragma("unroll") for (int m = 0; m < 4; ++m) _Pragma("unroll") for (int n = 0; n < 2; ++n) _Pragma("unroll") for (int k = 0; k < 2; ++k) \
        acc[ai][bj][m][n] = __builtin_amdgcn_mfma_f32_16x16x32_bf16(Bt[n][k], At[m][k], acc[ai][bj][m][n], 0, 0, 0); __builtin_amdgcn_s_setprio(0); } while (0)
#define PG8_WAIT_V(n) asm volatile("s_waitcnt vmcnt(" #n ")" ::: "memory")
#define PG8_WAIT_L(n) asm volatile("s_waitcnt lgkmcnt(" #n ")" ::: "memory")
#define PG8_BAR __builtin_amdgcn_s_barrier()
#define PG8_SCHED __builtin_amdgcn_sched_barrier(0)
    Unit cur, nxt; int ui = 0;
    if (!S.next(0, cur)) return;
    f32x4 acc[2][2][4][2];
#pragma unroll
    for (int a = 0; a < 2; ++a)
#pragma unroll
        for (int b = 0; b < 2; ++b)
#pragma unroll
            for (int m = 0; m < 4; ++m)
#pragma unroll
                for (int n = 0; n < 2; ++n) acc[a][b][m][n] = (f32x4){0.f, 0.f, 0.f, 0.f};
    bf16x8 At[4][2], B0[2][2], B1[2][2];
    const char* cA = (const char*)g.A + (size_t)cur.pm * tstep; const char* cB = (const char*)g.Bt + (size_t)cur.pn * tstep;
    S.a_ready(cur);
    if constexpr (SP2) {
        PG8_STAGE(PG8_SB(0, 0), cB, voffB); PG8_STAGE(PG8_SB(0, 1), cB + hstep, voffB); PG8_STAGE(PG8_SA(0, 0), cA, voffA); PG8_STAGE(PG8_SA(0, 1), cA + hstep, voffA);
        if (wr == 1) PG8_BAR;
        PG8_WAIT_V(2); PG8_BAR;
        PG8_STAGE(PG8_SB(1, 0), cB + kstep, voffB); PG8_STAGE(PG8_SA(1, 0), cA + kstep, voffA); PG8_STAGE(PG8_SB(1, 1), cB + hstep + kstep, voffB);
        PG8_WAIT_V(6); PG8_BAR;
    } else {
        PG8_STAGE(PG8_SB(0, 0), cB, voffB); PG8_STAGE(PG8_SA(0, 0), cA, voffA); PG8_STAGE(PG8_SB(0, 1), cB + hstep, voffB); PG8_STAGE(PG8_SA(0, 1), cA + hstep, voffA);
        if (wr == 1) PG8_BAR;
        PG8_WAIT_V(4); PG8_BAR;
        PG8_STAGE(PG8_SB(1, 0), cB + kstep, voffB); PG8_STAGE(PG8_SA(1, 0), cA + kstep, voffA); PG8_STAGE(PG8_SB(1, 1), cB + hstep + kstep, voffB);
        PG8_WAIT_V(6); PG8_BAR;
    }
    for (;;) {
        const bool has_next = S.next(ui + 1, nxt);
        const char* nA = has_next ? (const char*)g.A + (size_t)nxt.pm * tstep : cA; const char* nB = has_next ? (const char*)g.Bt + (size_t)nxt.pn * tstep : cB;
        for (int t = 0; t < nt; t += 2) {
            const bool last = (t == nt - 2);
            const char* a1 = cA + (size_t)(t + 1) * kstep;
            const char* a2 = last ? nA : cA + (size_t)(t + 2) * kstep; const char* b2 = last ? nB : cB + (size_t)(t + 2) * kstep;
            const char* a3 = a2 + kstep; const char* b3 = b2 + kstep;
            if (last && has_next) S.a_ready(nxt);
            if constexpr (SP2) {
            PG8_LDB(B0, 0, 0); PG8_LDB(B1, 0, 1); PG8_SCHED; PG8_LDA(At, 0, 0); PG8_STAGE(PG8_SA(1, 1), a1 + hstep, voffA);
            PG8_WAIT_V(8); PG8_WAIT_L(0); PG8_BAR; PG8_MMA(0, 0, At, B0); PG8_MMA(0, 1, At, B1); PG8_BAR; PG8_SCHED;
            PG8_LDA(At, 0, 1); PG8_STAGE(PG8_SB(0, 0), b2, voffB); PG8_STAGE(PG8_SB(0, 1), b2 + hstep, voffB); PG8_STAGE(PG8_SA(0, 0), a2, voffA);
            PG8_WAIT_V(8); PG8_WAIT_L(0); PG8_BAR; PG8_MMA(1, 0, At, B0); PG8_MMA(1, 1, At, B1); PG8_BAR; PG8_SCHED;
            PG8_LDB(B0, 1, 0); PG8_LDB(B1, 1, 1); PG8_SCHED; PG8_LDA(At, 1, 0); PG8_STAGE(PG8_SA(0, 1), a2 + hstep, voffA);
            PG8_WAIT_V(8); PG8_WAIT_L(0); PG8_BAR; PG8_MMA(0, 0, At, B0); PG8_MMA(0, 1, At, B1); PG8_BAR; PG8_SCHED;
            PG8_LDA(At, 1, 1); PG8_STAGE(PG8_SB(1, 0), b3, voffB); PG8_STAGE(PG8_SB(1, 1), b3 + hstep, voffB); PG8_STAGE(PG8_SA(1, 0), a3, voffA);
            PG8_WAIT_V(8); PG8_WAIT_L(0); PG8_BAR; PG8_MMA(1, 0, At, B0); PG8_MMA(1, 1, At, B1); PG8_BAR; PG8_SCHED;
            } else {
            PG8_LDB(B0, 0, 0); PG8_SCHED; PG8_LDA(At, 0, 0); PG8_STAGE(PG8_SA(1, 1), a1 + hstep, voffA);
            PG8_WAIT_L(8); PG8_BAR; PG8_WAIT_L(0); PG8_MMA(0, 0, At, B0); PG8_BAR; PG8_SCHED;
            PG8_LDB(B1, 0, 1); PG8_STAGE(PG8_SB(0, 0), b2, voffB);
            PG8_BAR; PG8_WAIT_L(0); PG8_MMA(0, 1, At, B1); PG8_BAR;
            PG8_LDA(At, 0, 1); PG8_STAGE(PG8_SA(0, 0), a2, voffA);
            PG8_BAR; PG8_WAIT_L(0); PG8_MMA(1, 0, At, B0); PG8_BAR; PG8_SCHED;
            PG8_STAGE(PG8_SB(0, 1), b2 + hstep, voffB);
            PG8_WAIT_V(6); PG8_BAR; PG8_MMA(1, 1, At, B1); PG8_BAR;
            PG8_LDB(B0, 1, 0); PG8_SCHED; PG8_LDA(At, 1, 0); PG8_STAGE(PG8_SA(0, 1), a2 + hstep, voffA);
            PG8_WAIT_L(8); PG8_BAR; PG8_WAIT_L(0); PG8_MMA(0, 0, At, B0); PG8_BAR; PG8_SCHED;
            PG8_LDB(B1, 1, 1); PG8_STAGE(PG8_SB(1, 0), b3, voffB);
            PG8_BAR; PG8_WAIT_L(0); PG8_MMA(0, 1, At, B1); PG8_BAR;
            PG8_LDA(At, 1, 1); PG8_STAGE(PG8_SA(1, 0), a3, voffA);
            PG8_BAR; PG8_WAIT_L(0); PG8_MMA(1, 0, At, B0); PG8_BAR; PG8_SCHED;
            PG8_STAGE(PG8_SB(1, 1), b3 + hstep, voffB);
            PG8_WAIT_V(6); PG8_BAR; PG8_MMA(1, 1, At, B1); PG8_BAR;
            }
        }
        if constexpr (ALIGN_EPI) { if (wr == 0) PG8_BAR; }
        if constexpr (!Epi::AFTER_DRAIN) { E(acc, cur, wr, wc, fr, fq); S.done(cur); }
        if (!has_next) break;
#pragma unroll
        for (int a = 0; a < 2; ++a)
#pragma unroll
            for (int b = 0; b < 2; ++b)
#pragma unroll
                for (int m = 0; m < 4; ++m)
#pragma unroll
                    for (int n = 0; n < 2; ++n) acc[a][b][m][n] = (f32x4){0.f, 0.f, 0.f, 0.f};
        cur = nxt; cA = nA; cB = nB; ++ui;
        if constexpr (ALIGN_EPI) { if (wr == 1) PG8_BAR; }
    }
    PG8_WAIT_V(0);
    if constexpr (!ALIGN_EPI) { if (wr == 0) PG8_BAR; }
    PG8_BAR;
    if constexpr (Epi::AFTER_DRAIN) { E.fused(acc, cur, wr, wc, fr, fq, lds, wid, lane); S.done(cur); }
#undef PG8_SA
#undef PG8_SB
#undef PG8_STAGE
#undef PG8_LDA
#undef PG8_LDB
#undef PG8_MMA
#undef PG8_WAIT_V
#undef PG8_WAIT_L
#undef PG8_BAR
#undef PG8_SCHED
}
}
#define GAS __attribute__((address_space(1)))
#define LAS __attribute__((address_space(3)))
typedef unsigned short bf16;
typedef unsigned v4u __attribute__((ext_vector_type(4)));
typedef float f32x4 __attribute__((ext_vector_type(4)));
typedef short bf16x8 __attribute__((ext_vector_type(8)));
typedef GAS unsigned gu32;
typedef GAS unsigned long long gu64;
#define RLX_AGENT __ATOMIC_RELAXED, __HIP_MEMORY_SCOPE_AGENT
#define LDS_WAIT() asm volatile("s_waitcnt lgkmcnt(0)" ::: "memory")
#define VM_WAIT() asm volatile("s_waitcnt vmcnt(0)" ::: "memory")
__device__ __forceinline__ unsigned long long rt() { return __builtin_amdgcn_s_memrealtime(); }
__device__ __forceinline__ unsigned f2bf(float f) { unsigned u = __builtin_bit_cast(unsigned, f); return (u + 0x7fffu + ((u >> 16) & 1u)) >> 16; }
__device__ __forceinline__ unsigned pk2(float lo, float hi) { return f2bf(lo) | (f2bf(hi) << 16); }
#define XB_TMO      128
#define XB_XCNT(j)  (256  + 64 * (j))
#define XB_XSUB(j)  (1280 + 64 * (j))
#define XB_XGEN(j)  (2304 + 64 * (j))
#define XB_TOP      3328
#define XB_TOPGEN   3392
#define XCD_BAR_WORDS 3456
#define XB_SPIN_CAP (1u << 18)

__device__ __forceinline__ unsigned xb_ld(unsigned* p)              { return __hip_atomic_load(p, __ATOMIC_RELAXED, __HIP_MEMORY_SCOPE_AGENT); }
__device__ __forceinline__ unsigned xb_add(unsigned* p, unsigned v) { return __hip_atomic_fetch_add(p, v, __ATOMIC_RELAXED, __HIP_MEMORY_SCOPE_AGENT); }
__device__ __forceinline__ unsigned xb_xcc_id() { return (unsigned)__builtin_amdgcn_s_getreg((3 << 11) | 20) & 0xFu; }
#define XB_SPIN(cond, bar) do { unsigned _sp = 0; while (cond) { __builtin_amdgcn_s_sleep(1); \
    if ((++_sp & 255u) == 0u) { if (xb_ld(&(bar)[XB_TMO])) break; if (_sp > XB_SPIN_CAP) { atomicAdd(&(bar)[XB_TMO], 1u); break; } } } } while (0)

struct XcdBarrier {
    unsigned* bar; unsigned x;
    volatile LAS unsigned* st;
};

__device__ __forceinline__ XcdBarrier xcd_barrier_post(unsigned* bar, volatile LAS unsigned* st) {
    XcdBarrier b; b.bar = bar; b.x = xb_xcc_id(); b.st = st;
    if (threadIdx.x == 0) (void)xb_add(&bar[XB_XCNT(b.x)], 1u);
    return b;
}
__device__ __forceinline__ void xcd_barrier_complete(unsigned* bar, unsigned x, unsigned& nloc, unsigned& nx) {
    const unsigned G = gridDim.x * gridDim.y * gridDim.z;
    unsigned sum, cnt, mine, sp = 0u;
    for (;;) {
        sum = 0u; cnt = 0u; mine = 0u;
#pragma unroll
        for (unsigned j = 0; j < 16; ++j) { const unsigned c = xb_ld(&bar[XB_XCNT(j)]); sum += c; cnt += (c > 0u) ? 1u : 0u; mine = (j == x) ? c : mine; }
        if (sum == G) break;
        __builtin_amdgcn_s_sleep(1);
        if ((++sp & 255u) == 0u) { if (xb_ld(&bar[XB_TMO])) break; if (sp > XB_SPIN_CAP) { atomicAdd(&bar[XB_TMO], 1u); break; } }
    }
    nloc = mine > 0u ? mine : 1u; nx = cnt > 0u ? cnt : 1u;
}

__device__ __forceinline__ void xcd_barrier(const XcdBarrier& b) {
    asm volatile("s_waitcnt vmcnt(0)" ::: "memory");
    __syncthreads();
    if (threadIdx.x == 0) {
        unsigned* bar = b.bar;
        __builtin_amdgcn_s_waitcnt(0);
        unsigned nloc = b.st[0], nx = b.st[1];
        if (nloc == 0u) { xcd_barrier_complete(bar, b.x, nloc, nx); b.st[0] = nloc; b.st[1] = nx; }
        const unsigned old = xb_add(&bar[XB_XSUB(b.x)], 1u);
        const unsigned gen = old / nloc;
        if (old + 1u == (gen + 1u) * nloc) {
            __builtin_amdgcn_fence(__ATOMIC_RELEASE, "agent");
            asm volatile("s_waitcnt vmcnt(0)" ::: "memory");
            const unsigned og = xb_add(&bar[XB_TOP], 1u);
            const unsigned tg = og / nx;
            if (og + 1u == (tg + 1u) * nx) xb_add(&bar[XB_TOPGEN], 1u);
            else XB_SPIN(xb_ld(&bar[XB_TOPGEN]) == tg, bar);
            __builtin_amdgcn_fence(__ATOMIC_ACQUIRE, "agent");
            xb_add(&bar[XB_XGEN(b.x)], 1u);
            asm volatile("s_waitcnt vmcnt(0)" ::: "memory");
        } else {
            XB_SPIN(xb_ld(&bar[XB_XGEN(b.x)]) == gen, bar);
            __builtin_amdgcn_fence(__ATOMIC_ACQUIRE, "agent");
            asm volatile("s_waitcnt vmcnt(0)" ::: "memory");
        }
    }
    __syncthreads();
}

namespace pg8 {
struct EpiSwiGLU {
    static constexpr bool PERM = true, AFTER_DRAIN = false;
    bf16_t* O; int ldc;
    __device__ __forceinline__ void operator()(const f32x4 (&acc)[2][2][4][2], const Unit& u, int wr, int wc, int fr, int fq) const {
        const int row0 = u.pm * BM + wr * 64 + fr; const int col0 = u.pn * HALF + wc * 32 + 8 * fq;
#pragma unroll
        for (int ai = 0; ai < 2; ++ai)
#pragma unroll
            for (int m = 0; m < 4; ++m) { bf16_t* rowp = O + (size_t)(row0 + ai * HALF + m * 16) * ldc + col0;
                float r[8];
#pragma unroll
                for (int n = 0; n < 2; ++n)
#pragma unroll
                    for (int i = 0; i < 4; ++i) { const float g = acc[ai][0][m][n][i], up = acc[ai][1][m][n][i];
                        const float e = __builtin_amdgcn_exp2f(-g * 1.4426950408889634f); r[n * 4 + i] = g * __builtin_amdgcn_rcpf(1.0f + e) * up; }
                u32x4 w; w.x = cvt_pk_bf16(r[0], r[1]); w.y = cvt_pk_bf16(r[2], r[3]); w.z = cvt_pk_bf16(r[4], r[5]); w.w = cvt_pk_bf16(r[6], r[7]);
                *(u32x4*)rowp = w; }
    }
};
}

constexpr int NWAVES = 8;
constexpr int BATCH = 2, SEQ = 8192, D = 1024, M = BATCH * SEQ, FFH = 2816;
constexpr float EPS = 1e-6f;
constexpr int NKEY = 387, NKEYP = 392;

constexpr size_t MiB = 1u << 20, HMiB = 1u << 19;
constexpr size_t WS_CTL = 0, CTL_ZERO_BYTES = 1 * MiB;
constexpr size_t WS_SMALL = 1 * MiB;
constexpr size_t SM_MOD = 0;
constexpr size_t SM_BIAST = 131072;
constexpr size_t SM_LB = 147456;
constexpr size_t SM_TW = 262144;
constexpr size_t WS_WINAB = 2 * MiB, WS_WOUTAB = 10 * MiB, WS_WINCD = 12 * MiB, WS_WOUTCD = 14 * MiB + HMiB;
constexpr size_t WS_WF1 = 16 * MiB + HMiB, WF1_BYTES = 11 * MiB, WS_WF2 = 38 * MiB + HMiB, WF2_BYTES = 5 * MiB + HMiB;
constexpr size_t WS_XN = 50 * MiB, WS_YB = 82 * MiB, WS_Z = 114 * MiB, WS_END = 242 * MiB;
constexpr size_t SEG = (size_t)M * 512;
constexpr int CW_BAR = 4096;

constexpr int RING_OFF = 0, RING_BYTES = 131072;
constexpr int TAB_OFF = RING_BYTES;
constexpr int LDSCTL_OFF = RING_BYTES + 1024, MISC_OFF = LDSCTL_OFF + 320;
constexpr int LDS_BYTES = 147456;

__device__ __forceinline__ float bf2f(unsigned short h) { return __builtin_bit_cast(float, (unsigned)h << 16); }
__device__ __forceinline__ float bflo(unsigned w) { return __builtin_bit_cast(float, w << 16); }
__device__ __forceinline__ float bfhi(unsigned w) { return __builtin_bit_cast(float, w & 0xffff0000u); }
__device__ __forceinline__ float wave_sum(float v) {
#pragma unroll
    for (int o = 1; o < 64; o <<= 1) v += __shfl_xor(v, o);
    return v;
}
__device__ __forceinline__ float wave_max(float v) {
#pragma unroll
    for (int o = 1; o < 64; o <<= 1) v = fmaxf(v, __shfl_xor(v, o));
    return v;
}
__device__ __forceinline__ float rdlane(float v, int j) { return __builtin_bit_cast(float, __builtin_amdgcn_readlane(__builtin_bit_cast(int, v), j)); }
__device__ __forceinline__ float siluf(float g) { return g / (1.0f + __expf(-g)); }

struct Frame {
    LAS unsigned char* lds;
    volatile LAS unsigned* MISC;
    gu32* ctl;
    int tid, lane, wave, vcu, G;
    const float *x, *c, *t5, *lbl, *ada_w, *ada_b, *gains, *ab_in, *ab_out, *hnorm, *cd_in, *cd_out, *qkn, *f_in, *f_out;
    float* out;
    unsigned char* ws;
};

__device__ __forceinline__ void p_adaln(Frame& F) {
    LAS float* red = (LAS float*)(F.lds + RING_OFF);
    float* MOD = (float*)(F.ws + WS_SMALL + SM_MOD);
    const int r4 = F.lane >> 4, c4 = F.lane & 15;
    for (int task = blockIdx.x; task < 192; task += F.G) {
        const int l = task / 96, cg = task % 96;
        const float* W = F.ada_w + (size_t)l * 1024 * 6144 + cg * 64 + 4 * c4;
        f32x4 a0 = {0.f, 0.f, 0.f, 0.f}, a1 = {0.f, 0.f, 0.f, 0.f};
#pragma unroll 4
        for (int i = 0; i < 32; ++i) {
            const int row = 128 * F.wave + 4 * i + r4;
            const f32x4 wv = *(const f32x4*)(W + (size_t)row * 6144);
            const float c0 = F.c[row], c1 = F.c[1024 + row];
            a0 += siluf(c0) * wv; a1 += siluf(c1) * wv;
        }
#pragma unroll
        for (int i = 0; i < 4; ++i) { a0[i] += __shfl_xor(a0[i], 16); a0[i] += __shfl_xor(a0[i], 32); a1[i] += __shfl_xor(a1[i], 16); a1[i] += __shfl_xor(a1[i], 32); }
        if (r4 == 0) {
#pragma unroll
            for (int i = 0; i < 4; ++i) { red[(F.wave * 2 + 0) * 64 + 4 * c4 + i] = a0[i]; red[(F.wave * 2 + 1) * 64 + 4 * c4 + i] = a1[i]; }
        }
        __syncthreads();
        if (F.tid < 128) { const int b = F.tid >> 6, col = F.tid & 63; float s = 0.f;
#pragma unroll
            for (int w = 0; w < 8; ++w) s += red[(w * 2 + b) * 64 + col];
            MOD[(l * 2 + b) * 6144 + cg * 64 + col] = s + F.ada_b[l * 6144 + cg * 64 + col]; }
        __syncthreads();
    }
    if ((int)blockIdx.x == F.G - 1) {
        float* BT = (float*)(F.ws + WS_SMALL + SM_BIAST);
        for (int idx = F.tid; idx < NKEY; idx += NWAVES * 64) {
            const int r = idx / 129, j = idx - r * 129 - 64, d = (r == 0) ? 1 : (r == 1) ? 4 : 16, rel = j * d, n = rel < 0 ? -rel : rel;
            int large = 8 + (int)(log((double)(n > 1 ? n : 1) / 8.0) / log(128.0) * 8.0); if (large > 15) large = 15;
            const int bucket = (rel > 0 ? 16 : 0) + (n < 8 ? n : large);
#pragma unroll
            for (int h = 0; h < 8; ++h) BT[h * NKEYP + idx] = F.t5[bucket * 8 + h];
        }
    }
    if ((int)blockIdx.x == F.G - 2) {
        float* LB = (float*)(F.ws + WS_SMALL + SM_LB);
        for (int i = F.tid; i < 1024; i += NWAVES * 64) {
            const float l0 = F.lbl[i], l1 = F.lbl[1024 + i], l2 = F.lbl[2048 + i]; const float mx = fmaxf(l0, fmaxf(l1, l2));
            const float e0 = expf(l0 - mx), e1 = expf(l1 - mx), e2 = expf(l2 - mx); LB[i] = e0 / (e0 + e1 + e2);
        }
    }
    if ((int)blockIdx.x >= F.G - 18 && (int)blockIdx.x < F.G - 2) {
        float* TW = (float*)(F.ws + WS_SMALL + SM_TW);
        const int j = ((int)blockIdx.x - (F.G - 18)) * 512 + F.tid;
        const double a = (double)j * (6.283185307179586476925286766559 / 8192.0);
        TW[j] = (float)cos(a); TW[8192 + j] = (float)sin(a);
    }
}

__device__ __forceinline__ void transpose_item(const float* W, int K, int N, bf16* WT, int dest_row0, int k0, int n0, LAS float* scr, int lane) {
#pragma unroll 8
    for (int i = 0; i < 32; ++i) { const int kk = 2 * i + (lane >> 5); scr[kk * 33 + (lane & 31)] = W[(size_t)(k0 + kk) * N + n0 + (lane & 31)]; }
    LDS_WAIT(); asm volatile("" ::: "memory");
    const int c = lane & 7;
#pragma unroll
    for (int j = 0; j < 4; ++j) { const int n = (lane >> 3) + 8 * j; const LAS float* s = scr + (8 * c) * 33 + n;
        v4u o; o.x = pk2(s[0 * 33], s[1 * 33]); o.y = pk2(s[2 * 33], s[3 * 33]); o.z = pk2(s[4 * 33], s[5 * 33]); o.w = pk2(s[6 * 33], s[7 * 33]);
        *(GAS v4u*)(WT + (size_t)(dest_row0 + n) * K + k0 + 8 * c) = o; }
    LDS_WAIT(); asm volatile("" ::: "memory");
}
__device__ __forceinline__ void p_weights(Frame& F) {
    LAS float* scr = (LAS float*)(F.lds + RING_OFF + F.wave * 16384);
    const int gw = F.vcu * NWAVES + F.wave, NGW = F.G * NWAVES;
    constexpr int I_ABI = 16 * 128, I_ABO = 16 * 32, I_CDI = 16 * 40, I_CDO = 16 * 32, I_F1 = 16 * 176, I_F2 = 44 * 32;
    constexpr int NITEMS = I_ABI + I_ABO + I_CDI + I_CDO + 2 * I_F1 + 2 * I_F2;
    for (int it = gw; it < NITEMS; it += NGW) {
        int r = it;
        if (r < I_ABI) { const int nb = 128, kb = r / nb, n0 = 32 * (r % nb); transpose_item(F.ab_in, 1024, 4096, (bf16*)(F.ws + WS_WINAB), n0, 64 * kb, n0, scr, F.lane); continue; } r -= I_ABI;
        if (r < I_ABO) { const int nb = 32, kb = r / nb, n0 = 32 * (r % nb); transpose_item(F.ab_out, 1024, 1024, (bf16*)(F.ws + WS_WOUTAB), n0, 64 * kb, n0, scr, F.lane); continue; } r -= I_ABO;
        if (r < I_CDI) { const int nb = 40, kb = r / nb, n0 = 32 * (r % nb); transpose_item(F.cd_in, 1024, 1280, (bf16*)(F.ws + WS_WINCD), n0, 64 * kb, n0, scr, F.lane); continue; } r -= I_CDI;
        if (r < I_CDO) { const int nb = 32, kb = r / nb, n0 = 32 * (r % nb); transpose_item(F.cd_out, 1024, 1024, (bf16*)(F.ws + WS_WOUTCD), n0, 64 * kb, n0, scr, F.lane); continue; } r -= I_CDO;
        if (r < 2 * I_F1) { const int l = r / I_F1; r -= l * I_F1; const int nb = 176, kb = r / nb, n0 = 32 * (r % nb);
            const int up = n0 >= FFH ? 1 : 0, j = n0 - up * FFH, drow = 256 * (j >> 7) + 128 * up + (j & 127);
            transpose_item(F.f_in + (size_t)l * 1024 * 5632, 1024, 5632, (bf16*)(F.ws + WS_WF1 + l * WF1_BYTES), drow, 64 * kb, n0, scr, F.lane); continue; } r -= 2 * I_F1;
        { const int l = r / I_F2; r -= l * I_F2; const int nb = 32, kb = r / nb, n0 = 32 * (r % nb);
            transpose_item(F.f_out + (size_t)l * FFH * 1024, FFH, 1024, (bf16*)(F.ws + WS_WF2 + l * WF2_BYTES), n0, 64 * kb, n0, scr, F.lane); }
    }
}
__device__ __forceinline__ void p_rows(Frame& F, const float* xin, const bf16* y, const float* gate_mod  , const float* gain_post,
                                       float* xout, const float* mod_next  , const float* gain_pre, bf16* xn) {
    const int gw = F.vcu * NWAVES + F.wave, NGW = F.G * NWAVES;
    for (int b = 0; b < BATCH; ++b) {
        f32x4 A1[4], A2[4], B2[4];
#pragma unroll
        for (int j = 0; j < 4; ++j) { const int col = 4 * F.lane + 256 * j;
            if (y) { const f32x4 g = *(const f32x4*)(gate_mod + b * 6144 + col), gp = *(const f32x4*)(gain_post + col); A1[j] = g * gp; } else A1[j] = (f32x4){0.f, 0.f, 0.f, 0.f};
            if (mod_next) { const f32x4 sh = *(const f32x4*)(mod_next + b * 6144 + col), sc = *(const f32x4*)(mod_next + b * 6144 + 1024 + col), gp = *(const f32x4*)(gain_pre + col);
                A2[j] = gp * (sc + 1.0f); B2[j] = sh; } else { A2[j] = (f32x4){0.f, 0.f, 0.f, 0.f}; B2[j] = A2[j]; } }
        for (int m = b * SEQ + gw; m < (b + 1) * SEQ; m += NGW) {
            f32x4 v[4];
#pragma unroll
            for (int j = 0; j < 4; ++j) v[j] = *(const f32x4*)(xin + (size_t)m * D + 4 * F.lane + 256 * j);
            if (y) {
                f32x4 yv[4]; float ss = 0.f;
#pragma unroll
                for (int j = 0; j < 4; ++j) { const uint2 w = *(const uint2*)(y + (size_t)m * D + 4 * F.lane + 256 * j);
                    yv[j] = (f32x4){bflo(w.x), bfhi(w.x), bflo(w.y), bfhi(w.y)}; ss += (yv[j].x * yv[j].x + yv[j].y * yv[j].y) + (yv[j].z * yv[j].z + yv[j].w * yv[j].w); }
                const float rs = 1.0f / sqrtf(wave_sum(ss) * (1.0f / D) + EPS);
#pragma unroll
                for (int j = 0; j < 4; ++j) v[j] = v[j] + A1[j] * (yv[j] * rs);
            }
            if (xout) {
#pragma unroll
                for (int j = 0; j < 4; ++j) *(f32x4*)(xout + (size_t)m * D + 4 * F.lane + 256 * j) = v[j];
            }
            if (mod_next) {
                float ss = 0.f;
#pragma unroll
                for (int j = 0; j < 4; ++j) ss += (v[j].x * v[j].x + v[j].y * v[j].y) + (v[j].z * v[j].z + v[j].w * v[j].w);
                const float rs = 1.0f / sqrtf(wave_sum(ss) * (1.0f / D) + EPS);
#pragma unroll
                for (int j = 0; j < 4; ++j) { const f32x4 h = (v[j] * rs) * A2[j] + B2[j];
                    uint2 w; w.x = pk2(h.x, h.y); w.y = pk2(h.z, h.w); *(uint2*)(xn + (size_t)m * D + 4 * F.lane + 256 * j) = w; }
            }
        }
    }
}

__device__ __forceinline__ void p_dilated_naive(Frame& F, const bf16* Q, const bf16* K, const bf16* V, bf16* O  ) {
    const float* BT = (const float*)(F.ws + WS_SMALL + SM_BIAST);
    const int gw = F.vcu * NWAVES + F.wave, NGW = F.G * NWAVES, lane = F.lane;
    for (int item = gw; item < M * 8; item += NGW) {
        const int m = item >> 3, h = item & 7, b = m >> 13, t = m & 8191;
        float qf[64];
        { const uint4* qp = (const uint4*)(Q + (size_t)m * 512 + h * 64);
#pragma unroll
          for (int i = 0; i < 8; ++i) { const uint4 w = qp[i]; qf[8 * i + 0] = bflo(w.x); qf[8 * i + 1] = bfhi(w.x); qf[8 * i + 2] = bflo(w.y); qf[8 * i + 3] = bfhi(w.y);
              qf[8 * i + 4] = bflo(w.z); qf[8 * i + 5] = bfhi(w.z); qf[8 * i + 6] = bflo(w.w); qf[8 * i + 7] = bfhi(w.w); } }
        float lg[7]; int posv[7]; float mx = -3.0e38f;
#pragma unroll
        for (int g = 0; g < 7; ++g) {
            const int idx = g * 64 + lane; float l = -3.0e38f; int pos = t;
            if (idx < NKEY) { const int r = idx / 129, j = idx - r * 129 - 64, d = (r == 0) ? 1 : (r == 1) ? 4 : 16; pos = t + j * d;
                if (pos >= 0 && pos < SEQ) { const uint4* kp = (const uint4*)(K + (size_t)(b * SEQ + pos) * 512 + h * 64); float dot = 0.f;
#pragma unroll
                    for (int i = 0; i < 8; ++i) { const uint4 w = kp[i]; dot += qf[8 * i + 0] * bflo(w.x) + qf[8 * i + 1] * bfhi(w.x) + qf[8 * i + 2] * bflo(w.y) + qf[8 * i + 3] * bfhi(w.y)
                                                                            + qf[8 * i + 4] * bflo(w.z) + qf[8 * i + 5] * bfhi(w.z) + qf[8 * i + 6] * bflo(w.w) + qf[8 * i + 7] * bfhi(w.w); }
                    l = dot * 0.125f + BT[h * NKEYP + idx]; } else pos = t; }
            lg[g] = l; posv[g] = pos; mx = fmaxf(mx, l);
        }
        mx = wave_max(mx);
        float s = 0.f;
#pragma unroll
        for (int g = 0; g < 7; ++g) { lg[g] = (lg[g] > -1.0e38f) ? __expf(lg[g] - mx) : 0.f; s += lg[g]; }
        s = wave_sum(s);
        float acc = 0.f; const bf16* Vb = V + (size_t)b * SEQ * 512 + h * 64 + lane;
#pragma unroll
        for (int g = 0; g < 7; ++g) { const int n = (g < 6) ? 64 : (NKEY - 384);
            for (int j = 0; j < n; ++j) { const float pj = rdlane(lg[g], j); const int pos = __builtin_amdgcn_readlane(posv[g], j);
                if (pj != 0.f) acc += pj * bf2f(Vb[(size_t)pos * 512]); } }
        O[(size_t)m * 1024 + h * 64 + lane] = (bf16)f2bf(acc / s);
    }
}

__device__ __forceinline__ void p_hgrn_naive(Frame& F, const bf16* Qh, const bf16* Ff, const bf16* Fb, const bf16* Ih, float* Odir) {
    const float* LB = (const float*)(F.ws + WS_SMALL + SM_LB);
    constexpr int TT = 32;
    LAS float* qs = (LAS float*)(F.lds + RING_OFF);
    LAS float* fa = qs + TT * 128;
    LAS float* vv = fa + TT * 128;
    const int tid = F.tid, lane = F.lane, vi = lane & 1, kq = lane >> 1;
    for (int item = blockIdx.x; item < 128; item += F.G) {
        const int chain = item >> 3, vs = item & 7, dir = chain >> 3, b = (chain >> 2) & 1, h = chain & 3;
        const bf16* Fp = dir ? Fb : Ff;
        float S[4] = {0.f, 0.f, 0.f, 0.f};
        const int vcol = h * 128 + vs * 16 + F.wave * 2 + vi;
        for (int s0 = 0; s0 < SEQ; s0 += TT) {
            __syncthreads();
            { const int tt = tid >> 4, k0 = (tid & 15) * 8; const int t = dir ? (SEQ - 1 - (s0 + tt)) : (s0 + tt); const size_t row = (size_t)(b * SEQ + t) * 512 + h * 128 + k0;
              const uint4 qw = *(const uint4*)(Qh + row), fw = *(const uint4*)(Fp + row);
              const unsigned qa[4] = {qw.x, qw.y, qw.z, qw.w}, fb_[4] = {fw.x, fw.y, fw.z, fw.w};
#pragma unroll
              for (int i = 0; i < 4; ++i) {
                  const float lb0 = LB[dir * 512 + h * 128 + k0 + 2 * i], lb1 = LB[dir * 512 + h * 128 + k0 + 2 * i + 1];
                  qs[tt * 128 + k0 + 2 * i] = bflo(qa[i]) * 0.08838834764831845f; qs[tt * 128 + k0 + 2 * i + 1] = bfhi(qa[i]) * 0.08838834764831845f;
                  fa[tt * 128 + k0 + 2 * i] = lb0 + (1.0f - lb0) / (1.0f + __expf(-bflo(fb_[i]))); fa[tt * 128 + k0 + 2 * i + 1] = lb1 + (1.0f - lb1) / (1.0f + __expf(-bfhi(fb_[i]))); }
              if (tid < TT * 16) { const int tv = tid >> 4, vc = tid & 15; const int t2 = dir ? (SEQ - 1 - (s0 + tv)) : (s0 + tv);
                  vv[tv * 16 + vc] = bf2f(Ih[(size_t)(b * SEQ + t2) * 512 + h * 128 + vs * 16 + vc]); } }
            __syncthreads();
#pragma unroll 4
            for (int tt = 0; tt < TT; ++tt) {
                const f32x4 f4 = *(const LAS f32x4*)(fa + tt * 128 + 4 * kq), q4 = *(const LAS f32x4*)(qs + tt * 128 + 4 * kq); const float v = vv[tt * 16 + F.wave * 2 + vi];
                float o = 0.f;
#pragma unroll
                for (int i = 0; i < 4; ++i) { S[i] = f4[i] * S[i] + (1.0f - f4[i]) * v; o += q4[i] * S[i]; }
                o += __shfl_xor(o, 2); o += __shfl_xor(o, 4); o += __shfl_xor(o, 8); o += __shfl_xor(o, 16); o += __shfl_xor(o, 32);
                if (kq == 0) { const int t = dir ? (SEQ - 1 - (s0 + tt)) : (s0 + tt); Odir[((size_t)dir * M + (size_t)(b * SEQ + t)) * 512 + vcol] = o; }
            }
        }
    }
}
__device__ __forceinline__ void p_hgrn_final(Frame& F, const float* Odir, const bf16* Gh, bf16* O) {
    const int gw = F.vcu * NWAVES + F.wave, NGW = F.G * NWAVES, lane = F.lane;
    const float g0 = F.hnorm[2 * lane], g1 = F.hnorm[2 * lane + 1];
    for (int item = gw; item < M * 4; item += NGW) {
        const int m = item >> 2, h = item & 3; const size_t off = (size_t)m * 512 + h * 128 + 2 * lane;
        const float2 a = *(const float2*)(Odir + off), c = *(const float2*)(Odir + (size_t)M * 512 + off);
        const float o0 = a.x + c.x, o1 = a.y + c.y; const float rs = 1.0f / sqrtf(wave_sum(o0 * o0 + o1 * o1) * (1.0f / 128.0f) + EPS);
        const unsigned gw2 = *(const unsigned*)(Gh + off); const float r0 = o0 * rs * g0 * siluf(bflo(gw2)), r1 = o1 * rs * g1 * siluf(bfhi(gw2));
        *(unsigned*)(O + (size_t)m * 1024 + 512 + h * 128 + 2 * lane) = pk2(r0, r1);
    }
}

__device__ __forceinline__ void tab128_init(Frame& F) {
    LAS float* T = (LAS float*)(F.lds + TAB_OFF);
    if (F.tid < 128) { float s, c; sincospif((float)F.tid * (1.0f / 64.0f), &s, &c); T[F.tid] = c; T[128 + F.tid] = s; }
    __syncthreads();
}
__device__ __forceinline__ void p_fnet1_naive(Frame& F, const bf16* U  , float* APR, float* API) {
    const float* TW = (const float*)(F.ws + WS_SMALL + SM_TW);
    LAS float* T = (LAS float*)(F.lds + TAB_OFF);
    LAS float* Us = (LAS float*)(F.lds + RING_OFF);
    LAS float* Zr = Us + 64 * 129 + 64;
    LAS float* Zi = Zr + 64 * 128;
    tab128_init(F);
    const int tid = F.tid, kc = tid & 127, grp = tid >> 7;
    for (int unit = blockIdx.x; unit < 2 * 4 * 128; unit += F.G) {
        const int b = unit >> 9, g = (unit >> 7) & 3, n2 = unit & 127;
        __syncthreads();
        { const int row = tid >> 3, c0 = (tid & 7) * 16; const uint4* p = (const uint4*)(U + (size_t)(b * SEQ + 128 * row + n2) * 512 + g * 128 + c0);
#pragma unroll
          for (int i = 0; i < 2; ++i) { const uint4 w = p[i]; LAS float* d = Us + row * 129 + c0 + 8 * i;
              d[0] = bflo(w.x); d[1] = bfhi(w.x); d[2] = bflo(w.y); d[3] = bfhi(w.y); d[4] = bflo(w.z); d[5] = bfhi(w.z); d[6] = bflo(w.w); d[7] = bfhi(w.w); } }
        __syncthreads();
        { float zr[16], zi[16];
#pragma unroll
          for (int i = 0; i < 16; ++i) { zr[i] = 0.f; zi[i] = 0.f; }
          for (int c = 0; c < 128; ++c) { const int idx = (c * kc) & 127; const float cs = T[idx], sn = T[128 + idx];
#pragma unroll
              for (int i = 0; i < 16; ++i) { const float u = Us[(grp * 16 + i) * 129 + c]; zr[i] += u * cs; zi[i] -= u * sn; } }
#pragma unroll
          for (int i = 0; i < 16; ++i) { Zr[(grp * 16 + i) * 128 + kc] = zr[i]; Zi[(grp * 16 + i) * 128 + kc] = zi[i]; } }
        __syncthreads();
        { float ar[16], ai[16];
#pragma unroll
          for (int i = 0; i < 16; ++i) { ar[i] = 0.f; ai[i] = 0.f; }
          for (int n1 = 0; n1 < 64; ++n1) { const float zr = Zr[n1 * 128 + kc], zi = Zi[n1 * 128 + kc];
#pragma unroll
              for (int i = 0; i < 16; ++i) { const int idx = (2 * n1 * (grp * 16 + i)) & 127; const float cs = T[idx], sn = T[128 + idx]; ar[i] += zr * cs + zi * sn; ai[i] += zi * cs - zr * sn; } }
#pragma unroll
          for (int i = 0; i < 16; ++i) { const int k1 = grp * 16 + i; const float ct = TW[n2 * k1], st = TW[8192 + n2 * k1];
              const size_t o = ((size_t)((b * 4 + g) * 128 + n2) * 64 + k1) * 128 + kc;
              APR[o] = ar[i] * ct + ai[i] * st; API[o] = ai[i] * ct - ar[i] * st; } }
    }
}
__device__ __forceinline__ void p_fnet2_naive(Frame& F, const float* APR, const float* API, bf16* O) {
    LAS float* T = (LAS float*)(F.lds + TAB_OFF);
    LAS float* Ar = (LAS float*)(F.lds + RING_OFF);
    LAS float* Ai = Ar + 128 * 128;
    tab128_init(F);
    const int tid = F.tid, kc = tid & 127, grp = tid >> 7;
    for (int unit = blockIdx.x; unit < 2 * 4 * 64; unit += F.G) {
        const int b = unit >> 8, g = (unit >> 6) & 3, k1 = unit & 63;
        __syncthreads();
        for (int e = tid; e < 128 * 128 / 4; e += NWAVES * 64) { const int n2 = e >> 5, c4 = (e & 31) * 4; const size_t o = ((size_t)((b * 4 + g) * 128 + n2) * 64 + k1) * 128 + c4;
            *(LAS f32x4*)(Ar + n2 * 128 + c4) = *(const f32x4*)(APR + o); *(LAS f32x4*)(Ai + n2 * 128 + c4) = *(const f32x4*)(API + o); }
        __syncthreads();
        float y[32];
#pragma unroll
        for (int i = 0; i < 32; ++i) y[i] = 0.f;
        for (int n2 = 0; n2 < 128; ++n2) { const float ar = Ar[n2 * 128 + kc], ai = Ai[n2 * 128 + kc];
#pragma unroll
            for (int i = 0; i < 32; ++i) { const int idx = (n2 * (grp * 32 + i)) & 127; y[i] += ar * T[idx] + ai * T[128 + idx]; } }
#pragma unroll
        for (int i = 0; i < 32; ++i) { const int k2 = grp * 32 + i; O[(size_t)(b * SEQ + k1 + 64 * k2) * 1024 + g * 128 + kc] = (bf16)f2bf(y[i] * (1.0f / 1024.0f)); }
    }
}

__device__ __forceinline__ void p_qkprep(Frame& F, bf16* QD, bf16* KV, float qscale) {
    const int gw = F.vcu * NWAVES + F.wave, NGW = F.G * NWAVES, lane = F.lane;
    const float invf = powf(10000.0f, -(float)(lane & 15) * (1.0f / 16.0f));
    const float gq = F.qkn[lane], gk = F.qkn[64 + lane];
    for (int m = gw; m < M; m += NGW) {
        const int t = m & 8191; const float pos = (lane < 32) ? (float)(t >> 6) : (float)(t & 63); const float ang = pos * invf; const float cs = cosf(ang), sn = sinf(ang);
#pragma unroll
        for (int hh = 0; hh < 10; ++hh) {
            bf16* p = (hh < 8) ? (QD + (size_t)m * 512 + hh * 64 + lane) : (KV + (size_t)m * 512 + (hh - 8) * 64 + lane);
            const float x = bf2f(*p); const float rs = 1.0f / sqrtf(wave_sum(x * x) * (1.0f / 64.0f) + EPS); const float xn = x * rs * ((hh < 8) ? gq : gk);
            const float xp = __shfl_xor(xn, 16);
            const float r = (lane & 16) ? (xp * sn + xn * cs) : (xn * cs - xp * sn);
            *p = (bf16)f2bf(r * ((hh < 8) ? qscale : 1.0f));
        }
    }
}
__device__ __forceinline__ void p_gqa_naive(Frame& F, const bf16* QD, const bf16* KV, bf16* O) {
    const int gw = F.vcu * NWAVES + F.wave, NGW = F.G * NWAVES, lane = F.lane;
    for (int item = gw; item < M * 8; item += NGW) {
        const int m = item >> 3, hq = item & 7, b = m >> 13, hk = hq >> 2;
        float qf[64];
        { const uint4* qp = (const uint4*)(QD + (size_t)m * 512 + hq * 64);
#pragma unroll
          for (int i = 0; i < 8; ++i) { const uint4 w = qp[i]; qf[8 * i + 0] = bflo(w.x); qf[8 * i + 1] = bfhi(w.x); qf[8 * i + 2] = bflo(w.y); qf[8 * i + 3] = bfhi(w.y);
              qf[8 * i + 4] = bflo(w.z); qf[8 * i + 5] = bfhi(w.z); qf[8 * i + 6] = bflo(w.w); qf[8 * i + 7] = bfhi(w.w); } }
        float mrun = -3.0e38f, srun = 0.f, acc = 0.f;
        const bf16* Kb = KV + (size_t)b * SEQ * 512 + hk * 64; const bf16* Vb = KV + (size_t)b * SEQ * 512 + 128 + hk * 64 + lane;
        for (int kg = 0; kg < SEQ / 64; ++kg) {
            const uint4* kp = (const uint4*)(Kb + (size_t)(kg * 64 + lane) * 512); float dot = 0.f;
#pragma unroll
            for (int i = 0; i < 8; ++i) { const uint4 w = kp[i]; dot += qf[8 * i + 0] * bflo(w.x) + qf[8 * i + 1] * bfhi(w.x) + qf[8 * i + 2] * bflo(w.y) + qf[8 * i + 3] * bfhi(w.y)
                                                                    + qf[8 * i + 4] * bflo(w.z) + qf[8 * i + 5] * bfhi(w.z) + qf[8 * i + 6] * bflo(w.w) + qf[8 * i + 7] * bfhi(w.w); }
            const float mnew = fmaxf(mrun, wave_max(dot)); const float corr = __expf(mrun - mnew); const float p = __expf(dot - mnew);
            srun = srun * corr + wave_sum(p); acc *= corr; mrun = mnew;
#pragma unroll 8
            for (int j = 0; j < 64; ++j) acc += rdlane(p, j) * bf2f(Vb[(size_t)(kg * 64 + j) * 512]);
        }
        O[(size_t)m * 1024 + 512 + hq * 64 + lane] = (bf16)f2bf(acc / srun);
    }
}

#ifndef MK_ONE_LAUNCH
#define MK_ONE_LAUNCH 0
#endif
constexpr int N_PHASES = 18;
struct Args { const float* in[15]; float* out; unsigned char* ws; int ph_lo, ph_hi; };
__global__ void __launch_bounds__(NWAVES * 64, 2) mk_fwd(Args args) {
    extern __shared__ __attribute__((aligned(16))) unsigned char lds[];
    Frame F;
    F.lds = (LAS unsigned char*)lds;
    F.MISC = (volatile LAS unsigned*)(F.lds + MISC_OFF);
    F.tid = threadIdx.x; F.lane = F.tid & 63; F.wave = __builtin_amdgcn_readfirstlane(F.tid >> 6);
    F.G = gridDim.x; { const int bx = blockIdx.x; F.vcu = (F.G % 8 == 0) ? (bx % 8) * (F.G / 8) + bx / 8 : bx; }
    F.ws = args.ws; F.ctl = (gu32*)(args.ws + WS_CTL);
    F.x = args.in[0]; F.c = args.in[1]; F.t5 = args.in[2]; F.lbl = args.in[3]; F.ada_w = args.in[4]; F.ada_b = args.in[5]; F.gains = args.in[6];
    F.ab_in = args.in[7]; F.ab_out = args.in[8]; F.hnorm = args.in[9]; F.cd_in = args.in[10]; F.cd_out = args.in[11]; F.qkn = args.in[12]; F.f_in = args.in[13]; F.f_out = args.in[14];
    F.out = args.out;
    for (int u = F.tid; u < (LDS_BYTES - LDSCTL_OFF) / 4; u += NWAVES * 64) ((LAS unsigned*)(F.lds + LDSCTL_OFF))[u] = 0u;
    __syncthreads();
    XcdBarrier bar; bar.bar = (unsigned*)(F.ctl + CW_BAR); bar.x = 0; bar.st = nullptr;
    if (MK_ONE_LAUNCH) bar = xcd_barrier_post((unsigned*)(F.ctl + CW_BAR), F.MISC + 8);
    const int lo = args.ph_lo, hi = args.ph_hi;
#define IN(k) (lo <= (k) && (k) < hi)
#define SEAM(k) do { if (MK_ONE_LAUNCH && IN(k) && IN((k) + 1)) xcd_barrier(bar); } while (0)
    unsigned char* ws = args.ws;
    float* MOD = (float*)(ws + WS_SMALL + SM_MOD);
    bf16* XN = (bf16*)(ws + WS_XN); bf16* YB = (bf16*)(ws + WS_YB); bf16* Z = (bf16*)(ws + WS_Z);
    bf16* H = Z;
    const float* G0 = F.gains; const float* G1 = F.gains + 4 * 1024;
    float* MOD0 = MOD; float* MOD1 = MOD + 2 * 6144;

    if (IN(0)) { p_adaln(F); } SEAM(0);
    if (IN(1)) { p_weights(F); p_rows(F, F.x, nullptr, nullptr, nullptr, nullptr, MOD0, G0, XN); } SEAM(1);
    if (IN(2)) { pg8::Gemm g{XN, (const bf16*)(ws + WS_WINAB), M, 4096, 1024}; pg8::StaticOrder S; S.init(M, 4096, F.G, (int)blockIdx.x);
        pg8::EpiBf16<0> E{Z, 512, nullptr, 512, SEG, 1.0f};
        pg8::gemm_phase<pg8::EpiBf16<0>, pg8::StaticOrder, true, true>(F.lds + RING_OFF, g, S, E); } SEAM(2);
    if (IN(3)) { p_hgrn_naive(F, Z + 3 * SEG, Z + 4 * SEG, Z + 5 * SEG, Z + 6 * SEG, F.out);
                 p_dilated_naive(F, Z, Z + SEG, Z + 2 * SEG, XN); } SEAM(3);
    if (IN(4)) { p_hgrn_final(F, F.out, Z + 7 * SEG, XN); } SEAM(4);
    if (IN(5)) { pg8::Gemm g{XN, (const bf16*)(ws + WS_WOUTAB), M, 1024, 1024}; pg8::StaticOrder S; S.init(M, 1024, F.G, (int)blockIdx.x);
        pg8::EpiBf16<0> E{YB, 1024, nullptr, 0, 0, 1.0f};
        pg8::gemm_phase<pg8::EpiBf16<0>, pg8::StaticOrder, true, true>(F.lds + RING_OFF, g, S, E); } SEAM(5);
    if (IN(6)) { p_rows(F, F.x, YB, MOD0 + 2048, G0 + 1024, F.out, MOD0 + 3072, G0 + 2048, XN); } SEAM(6);
    if (IN(7)) { pg8::Gemm g{XN, (const bf16*)(ws + WS_WF1), M, 2 * FFH, 1024}; pg8::StaticOrder S; S.init(M, 2 * FFH, F.G, (int)blockIdx.x);
        pg8::EpiSwiGLU E{H, FFH};
        pg8::gemm_phase<pg8::EpiSwiGLU, pg8::StaticOrder, true, true>(F.lds + RING_OFF, g, S, E); } SEAM(7);
    if (IN(8)) { pg8::Gemm g{H, (const bf16*)(ws + WS_WF2), M, 1024, FFH}; pg8::StaticOrder S; S.init(M, 1024, F.G, (int)blockIdx.x);
        pg8::EpiBf16<0> E{YB, 1024, nullptr, 0, 0, 1.0f};
        pg8::gemm_phase<pg8::EpiBf16<0>, pg8::StaticOrder, true, true>(F.lds + RING_OFF, g, S, E); } SEAM(8);
    if (IN(9)) { p_rows(F, F.out, YB, MOD0 + 5120, G0 + 3072, F.out, MOD1, G1, XN); } SEAM(9);
    if (IN(10)) { pg8::Gemm g{XN, (const bf16*)(ws + WS_WINCD), M, 1280, 1024}; pg8::StaticOrder S; S.init(M, 1280, F.G, (int)blockIdx.x);
        pg8::EpiBf16<0> E{Z, 512, nullptr, 512, SEG, 1.0f};
        pg8::gemm_phase<pg8::EpiBf16<0>, pg8::StaticOrder, true, true>(F.lds + RING_OFF, g, S, E); } SEAM(10);
    bf16* MIX1 = Z + 4 * SEG;
    float* APR = (float*)(ws + WS_XN); float* API = APR + (size_t)2 * 4 * 128 * 64 * 128;
    if (IN(11)) { p_qkprep(F, Z + SEG, Z + 2 * SEG, 0.125f); p_fnet1_naive(F, Z, APR, API); } SEAM(11);
    if (IN(12)) { p_fnet2_naive(F, APR, API, MIX1); p_gqa_naive(F, Z + SEG, Z + 2 * SEG, MIX1); } SEAM(12);
    if (IN(13)) { pg8::Gemm g{MIX1, (const bf16*)(ws + WS_WOUTCD), M, 1024, 1024}; pg8::StaticOrder S; S.init(M, 1024, F.G, (int)blockIdx.x);
        pg8::EpiBf16<0> E{YB, 1024, nullptr, 0, 0, 1.0f};
        pg8::gemm_phase<pg8::EpiBf16<0>, pg8::StaticOrder, true, true>(F.lds + RING_OFF, g, S, E); } SEAM(13);
    if (IN(14)) { p_rows(F, F.out, YB, MOD1 + 2048, G1 + 1024, F.out, MOD1 + 3072, G1 + 2048, XN); } SEAM(14);
    if (IN(15)) { pg8::Gemm g{XN, (const bf16*)(ws + WS_WF1 + WF1_BYTES), M, 2 * FFH, 1024}; pg8::StaticOrder S; S.init(M, 2 * FFH, F.G, (int)blockIdx.x);
        pg8::EpiSwiGLU E{H, FFH};
        pg8::gemm_phase<pg8::EpiSwiGLU, pg8::StaticOrder, true, true>(F.lds + RING_OFF, g, S, E); } SEAM(15);
    if (IN(16)) { pg8::Gemm g{H, (const bf16*)(ws + WS_WF2 + WF2_BYTES), M, 1024, FFH}; pg8::StaticOrder S; S.init(M, 1024, F.G, (int)blockIdx.x);
        pg8::EpiBf16<0> E{YB, 1024, nullptr, 0, 0, 1.0f};
        pg8::gemm_phase<pg8::EpiBf16<0>, pg8::StaticOrder, true, true>(F.lds + RING_OFF, g, S, E); } SEAM(16);
    if (IN(17)) { p_rows(F, F.out, YB, MOD1 + 5120, G1 + 3072, F.out, nullptr, nullptr, nullptr); }
#undef IN
#undef SEAM
}

extern "C" void kernel_launch(void* const* d_in, const int* in_sizes, int n_in, void* d_out, int out_size, void* d_ws, size_t ws_size, hipStream_t stream) {
    static int grid = 0;
    if (grid == 0) {
        if (n_in != 15 || in_sizes[0] != M * D || out_size != M * D || ws_size < WS_END) { fprintf(stderr, "kernel_launch: unexpected shapes (n_in %d, in0 %d, out %d, ws %zu)\n", n_in, n_in > 0 ? in_sizes[0] : -1, out_size, ws_size); grid = -1; return; }
        int dev = 0, cus = 0;
        if (hipGetDevice(&dev) != hipSuccess || hipDeviceGetAttribute(&cus, hipDeviceAttributeMultiprocessorCount, dev) != hipSuccess) { grid = -1; return; }
        if (hipFuncSetAttribute((const void*)mk_fwd, hipFuncAttributeMaxDynamicSharedMemorySize, LDS_BYTES) != hipSuccess) { fprintf(stderr, "kernel_launch: hipFuncSetAttribute failed\n"); grid = -1; return; }
        (void)hipGetLastError();
        grid = cus;
    }
    if (grid < 0) return;
    if (hipMemsetAsync((char*)d_ws + WS_CTL, 0, CTL_ZERO_BYTES, stream) != hipSuccess) return;
    Args a{};
    for (int i = 0; i < 15; ++i) a.in[i] = (const float*)d_in[i];
    a.out = (float*)d_out; a.ws = (unsigned char*)d_ws;
#if MK_ONE_LAUNCH
    a.ph_lo = 0; a.ph_hi = N_PHASES;
    hipLaunchKernelGGL(mk_fwd, dim3(grid), dim3(NWAVES * 64), LDS_BYTES, stream, a);
#else
    for (int p = 0; p < N_PHASES; ++p) { a.ph_lo = p; a.ph_hi = p + 1; hipLaunchKernelGGL(mk_fwd, dim3(grid), dim3(NWAVES * 64), LDS_BYTES, stream, a); }
#endif
}
```

```cpp
#include <hip/hip_runtime.h>
#include <cstdio>
#include <cstdint>
namespace pg8 {
#define PG8_LAS __attribute__((address_space(3)))
typedef unsigned short bf16_t;
typedef short bf16x8 __attribute__((ext_vector_type(8)));
typedef float f32x4 __attribute__((ext_vector_type(4)));
typedef unsigned u32x4 __attribute__((ext_vector_type(4)));
constexpr int BM = 256, BK = 64, HALF = 128, HTB = HALF * BK * 2  , STAGE_BYTES = 8 * HTB, NXCD = 8, WGM = 8;

__host__ __device__ __forceinline__ int lds_byte(int r, int c) { const int st = (r >> 4) * 2 + (c >> 5), rr = r & 15, cc = c & 31, ob = rr * 64 + cc * 2; return st * 1024 + (ob ^ (((ob >> 9) & 1) << 5)); }
__host__ __device__ __forceinline__ void stage_rc(int b, int& R, int& C) { const int st = b / 1024, sb = b % 1024, swz = sb ^ (((sb >> 9) & 1) << 5); R = (st >> 1) * 16 + swz / 64; C = (st & 1) * 32 + (swz % 64) / 2; }
__host__ __device__ __forceinline__ int perm32(int rho) { const int n = rho >> 4, i = rho & 15; return 8 * (i >> 2) + 4 * n + (i & 3); }

struct Unit { int pm, pn; };
struct Gemm { const bf16_t* A; const bf16_t* Bt; int M, N, K; };

struct StaticOrder {
    int nM, nN, nwg, G, c;
    __host__ __device__ void init(int M, int N, int G_, int c_) { nM = M / BM; nN = N / BM; nwg = nM * nN; G = G_; c = c_; }
    __host__ __device__ bool next(int i, Unit& u) const {
        const long L = (long)i * G + c; if (L >= nwg) return false;
        int wgid = (int)L; { const int q = nwg / NXCD, r = nwg % NXCD, xcd = wgid % NXCD, off = wgid / NXCD; wgid = (xcd < r ? xcd * (q + 1) : r * (q + 1) + (xcd - r) * q) + off; }
        const int nig = WGM * nN, gid = wgid / nig, fm = gid * WGM, gsz = (nM - fm) < WGM ? (nM - fm) : WGM;
        u.pm = fm + ((wgid % nig) % gsz); u.pn = (wgid % nig) / gsz; return true;
    }
    __device__ __forceinline__ void a_ready(const Unit&) const {}
    __device__ __forceinline__ void done(const Unit&) const {}
};

__device__ __forceinline__ unsigned cvt_pk_bf16(float lo, float hi) { unsigned r; asm volatile("v_cvt_pk_bf16_f32 %0, %1, %2" : "=v"(r) : "v"(lo), "v"(hi)); return r; }
typedef float f32x2 __attribute__((ext_vector_type(2)));
__device__ __forceinline__ f32x2 gelu_pk(f32x2 v) {
    const f32x2 av = __builtin_elementwise_abs(v), d = av * 0.2316418882f + 1.0f;
    f32x2 t; t.x = __builtin_amdgcn_rcpf(d.x); t.y = __builtin_amdgcn_rcpf(d.y);
    f32x2 q = t * 0.5307027145f + (-0.7265760135f); q = q * t + 0.7107068705f; q = q * t + (-0.142248368f); q = q * t + 0.127414796f; q = q * t;
    const f32x2 s = (v * v) * (-0.72134752044f);
    f32x2 e; e.x = __builtin_amdgcn_exp2f(s.x); e.y = __builtin_amdgcn_exp2f(s.y);
    const f32x2 m = v * (q * e), r = v - m;
    f32x2 o; o.x = v.x < 0.f ? m.x : r.x; o.y = v.y < 0.f ? m.y : r.y; return o;
}

template <int ACT  > struct EpiBf16 {
    static constexpr bool PERM = true, AFTER_DRAIN = false; static_assert(ACT == 0 || ACT == 1, "EpiBf16: ACT is 0 (none) or 1 (gelu_pk)");
    bf16_t* O; int ldc; const float* bias; int split_cols; size_t split_stride; float scale0;
    __device__ __forceinline__ void operator()(const f32x4 (&acc)[2][2][4][2], const Unit& u, int wr, int wc, int fr, int fq) const {
        const int row0 = u.pm * BM + wr * 64 + fr; int colt = u.pn * BM; bf16_t* base = O;
        float sc = 1.f; if (split_cols) { const int t = colt / split_cols; base += (size_t)t * split_stride; colt -= t * split_cols; if (t == 0) sc = scale0; }
        const int col0 = colt + wc * 32 + 8 * fq, bcol0 = u.pn * BM + wc * 32 + 8 * fq;
        f32x4 bv[2][2];
#pragma unroll
        for (int bj = 0; bj < 2; ++bj)
#pragma unroll
            for (int n = 0; n < 2; ++n) bv[bj][n] = bias ? *(const f32x4*)(bias + bcol0 + bj * HALF + 4 * n) : (f32x4){0.f, 0.f, 0.f, 0.f};
#pragma unroll
        for (int ai = 0; ai < 2; ++ai)
#pragma unroll
            for (int m = 0; m < 4; ++m) { bf16_t* rowp = base + (size_t)(row0 + ai * HALF + m * 16) * ldc + col0;
#pragma unroll
                for (int bj = 0; bj < 2; ++bj) { f32x4 v0 = acc[ai][bj][m][0] + bv[bj][0], v1 = acc[ai][bj][m][1] + bv[bj][1];
                    if (ACT == 1) { f32x2 a = gelu_pk((f32x2){v0[0], v0[1]}), b = gelu_pk((f32x2){v0[2], v0[3]}), c = gelu_pk((f32x2){v1[0], v1[1]}), d = gelu_pk((f32x2){v1[2], v1[3]});
                        v0 = (f32x4){a.x, a.y, b.x, b.y}; v1 = (f32x4){c.x, c.y, d.x, d.y}; }
                    v0 = v0 * sc; v1 = v1 * sc; u32x4 w; w.x = cvt_pk_bf16(v0[0], v0[1]); w.y = cvt_pk_bf16(v0[2], v0[3]); w.z = cvt_pk_bf16(v1[0], v1[1]); w.w = cvt_pk_bf16(v1[2], v1[3]);
                    *(u32x4*)(rowp + bj * HALF) = w; } }
    }
};
template <class Epi, class Sched, bool ALIGN_EPI = false, bool SP2 = false>
__device__ __forceinline__ void gemm_phase(PG8_LAS unsigned char* lds, const Gemm g, const Sched& S, const Epi& E) {
    const int tid = threadIdx.x, wid = __builtin_amdgcn_readfirstlane(tid >> 6), lane = tid & 63, wr = wid >> 2, wc = wid & 3, fr = lane & 15, fq = lane >> 4;
    const int K = g.K, nt = K / BK;
    unsigned voffA[2], voffB[2];
#pragma unroll
    for (int i = 0; i < 2; ++i) { int R, C; stage_rc(tid * 16 + i * 8192, R, C); const int Rb = Epi::PERM ? ((R & ~31) + perm32(R & 31)) : R;
        voffA[i] = (unsigned)(R * K + C) * 2u; voffB[i] = (unsigned)(Rb * K + C) * 2u; }
    const size_t kstep = (size_t)(BK * 2);
    const size_t hstep = (size_t)HALF * K * 2;
    const size_t tstep = 2 * hstep;
    const unsigned ldsw = (unsigned)wid * 1024u;
    const int aoff = lds_byte(wr * 64 + fr, fq * 8), boff = lds_byte(wc * 32 + fr, fq * 8);
#define PG8_SA(b, h) (((b) * 2 + (h)) * HTB)
#define PG8_SB(b, h) ((4 + (b) * 2 + (h)) * HTB)
#define PG8_STAGE(bufoff, gbase, voff) do { _Pragma("unroll") for (int _i = 0; _i < 2; ++_i) \
        __builtin_amdgcn_global_load_lds((const unsigned*)((const char*)(gbase) + (voff)[_i]), (PG8_LAS unsigned*)(lds + (bufoff) + ldsw + _i * 8192), 16, 0, 0); } while (0)
#define PG8_LDA(dst, b, h) do { _Pragma("unroll") for (int m = 0; m < 4; ++m) _Pragma("unroll") for (int k = 0; k < 2; ++k) dst[m][k] = *(const PG8_LAS bf16x8*)(lds + PG8_SA(b, h) + aoff + m * 2048 + k * 1024); } while (0)
#define PG8_LDB(dst, b, h) do { _Pragma("unroll") for (int n = 0; n < 2; ++n) _Pragma("unroll") for (int k = 0; k < 2; ++k) dst[n][k] = *(const PG8_LAS bf16x8*)(lds + PG8_SB(b, h) + boff + n * 2048 + k * 1024); } while (0)
#define PG8_MMA(ai, bj, At, Bt) do { __builtin_amdgcn_s_setprio(1); _Pragma("unroll") for (int m = 0; m < 4; ++m) _Pragma("unroll") for (int n = 0; n < 2; ++n) _Pragma("unroll") for (int k = 0; k < 2; ++k) \
        acc[ai][bj][m][n] = __builtin_amdgcn_mfma_f32_16x16x32_bf16(Bt[n][k], At[m][k], acc[ai][bj][m][n], 0, 0, 0); __builtin_amdgcn_s_setprio(0); } while (0)
#define PG8_WAIT_V(n) asm volatile("s_waitcnt vmcnt(" #n ")" ::: "memory")
#define PG8_WAIT_L(n) asm volatile("s_waitcnt lgkmcnt(" #n ")" ::: "memory")
#define PG8_BAR __builtin_amdgcn_s_barrier()
#define PG8_SCHED __builtin_amdgcn_sched_barrier(0)
    Unit cur, nxt; int ui = 0;
    if (!S.next(0, cur)) return;
    f32x4 acc[2][2][4][2];
#pragma unroll
    for (int a = 0; a < 2; ++a)
#pragma unroll
        for (int b = 0; b < 2; ++b)
#pragma unroll
            for (int m = 0; m < 4; ++m)
#pragma unroll
                for (int n = 0; n < 2; ++n) acc[a][b][m][n] = (f32x4){0.f, 0.f, 0.f, 0.f};
    bf16x8 At[4][2], B0[2][2], B1[2][2];
    const char* cA = (const char*)g.A + (size_t)cur.pm * tstep; const char* cB = (const char*)g.Bt + (size_t)cur.pn * tstep;
    S.a_ready(cur);
    if constexpr (SP2) {
        PG8_STAGE(PG8_SB(0, 0), cB, voffB); PG8_STAGE(PG8_SB(0, 1), cB + hstep, voffB); PG8_STAGE(PG8_SA(0, 0), cA, voffA); PG8_STAGE(PG8_SA(0, 1), cA + hstep, voffA);
        if (wr == 1) PG8_BAR;
        PG8_WAIT_V(2); PG8_BAR;
        PG8_STAGE(PG8_SB(1, 0), cB + kstep, voffB); PG8_STAGE(PG8_SA(1, 0), cA + kstep, voffA); PG8_STAGE(PG8_SB(1, 1), cB + hstep + kstep, voffB);
        PG8_WAIT_V(6); PG8_BAR;
    } else {
        PG8_STAGE(PG8_SB(0, 0), cB, voffB); PG8_STAGE(PG8_SA(0, 0), cA, voffA); PG8_STAGE(PG8_SB(0, 1), cB + hstep, voffB); PG8_STAGE(PG8_SA(0, 1), cA + hstep, voffA);
        if (wr == 1) PG8_BAR;
        PG8_WAIT_V(4); PG8_BAR;
        PG8_STAGE(PG8_SB(1, 0), cB + kstep, voffB); PG8_STAGE(PG8_SA(1, 0), cA + kstep, voffA); PG8_STAGE(PG8_SB(1, 1), cB + hstep + kstep, voffB);
        PG8_WAIT_V(6); PG8_BAR;
    }
    for (;;) {
        const bool has_next = S.next(ui + 1, nxt);
        const char* nA = has_next ? (const char*)g.A + (size_t)nxt.pm * tstep : cA; const char* nB = has_next ? (const char*)g.Bt + (size_t)nxt.pn * tstep : cB;
        for (int t = 0; t < nt; t += 2) {
            const bool last = (t == nt - 2);
            const char* a1 = cA + (size_t)(t + 1) * kstep;
            const char* a2 = last ? nA : cA + (size_t)(t + 2) * kstep; const char* b2 = last ? nB : cB + (size_t)(t + 2) * kstep;
            const char* a3 = a2 + kstep; const char* b3 = b2 + kstep;
            if (last && has_next) S.a_ready(nxt);
            if constexpr (SP2) {
            PG8_LDB(B0, 0, 0); PG8_LDB(B1, 0, 1); PG8_SCHED; PG8_LDA(At, 0, 0); PG8_STAGE(PG8_SA(1, 1), a1 + hstep, voffA);
            PG8_WAIT_V(8); PG8_WAIT_L(0); PG8_BAR; PG8_MMA(0, 0, At, B0); PG8_MMA(0, 1, At, B1); PG8_BAR; PG8_SCHED;
            PG8_LDA(At, 0, 1); PG8_STAGE(PG8_SB(0, 0), b2, voffB); PG8_STAGE(PG8_SB(0, 1), b2 + hstep, voffB); PG8_STAGE(PG8_SA(0, 0), a2, voffA);
            PG8_WAIT_V(8); PG8_WAIT_L(0); PG8_BAR; PG8_MMA(1, 0, At, B0); PG8_MMA(1, 1, At, B1); PG8_BAR; PG8_SCHED;
            PG8_LDB(B0, 1, 0); PG8_LDB(B1, 1, 1); PG8_SCHED; PG8_LDA(At, 1, 0); PG8_STAGE(PG8_SA(0, 1), a2 + hstep, voffA);
            PG8_WAIT_V(8); PG8_WAIT_L(0); PG8_BAR; PG8_MMA(0, 0, At, B0); PG8_MMA(0, 1, At, B1); PG8_BAR; PG8_SCHED;
            PG8_LDA(At, 1, 1); PG8_STAGE(PG8_SB(1, 0), b3, voffB); PG8_STAGE(PG8_SB(1, 1), b3 + hstep, voffB); PG8_STAGE(PG8_SA(1, 0), a3, voffA);
            PG8_WAIT_V(8); PG8_WAIT_L(0); PG8_BAR; PG8_MMA(1, 0, At, B0); PG8_MMA(1, 1, At, B1); PG8_BAR; PG8_SCHED;
            } else {
            PG8_LDB(B0, 0, 0); PG8_SCHED; PG8_LDA(At, 0, 0); PG8_STAGE(PG8_SA(1, 1), a1 + hstep, voffA);
            PG8_WAIT_L(8); PG8_BAR; PG8_WAIT_L(0); PG8_MMA(0, 0, At, B0); PG8_BAR; PG8_SCHED;
            PG8_LDB(B1, 0, 1); PG8_STAGE(PG8_SB(0, 0), b2, voffB);
            PG8_BAR; PG8_WAIT_L(0); PG8_MMA(0, 1, At, B1); PG8_BAR;
            PG8_LDA(At, 0, 1); PG8_STAGE(PG8_SA(0, 0), a2, voffA);
            PG8_BAR; PG8_WAIT_L(0); PG8_MMA(1, 0, At, B0); PG8_BAR; PG8_SCHED;
            PG8_STAGE(PG8_SB(0, 1), b2 + hstep, voffB);
            PG8_WAIT_V(6); PG8_BAR; PG8_MMA(1, 1, At, B1); PG8_BAR;
            PG8_LDB(B0, 1, 0); PG8_SCHED; PG8_LDA(At, 1, 0); PG8_STAGE(PG8_SA(0, 1), a2 + hstep, voffA);
            PG8_WAIT_L(8); PG8_BAR; PG8_WAIT_L(0); PG8_MMA(0, 0, At, B0); PG8_BAR; PG8_SCHED;
            PG8_LDB(B1, 1, 1); PG8_STAGE(PG8_SB(1, 0), b3, voffB);
            PG8_BAR; PG8_WAIT_L(0); PG8_MMA(0, 1, At, B1); PG8_BAR;
            PG8_LDA(At, 1, 1); PG8_STAGE(PG8_SA(1, 0), a3, voffA);
            PG8_BAR; PG8_WAIT_L(0); PG8_MMA(1, 0, At, B0); PG8_BAR; PG8_SCHED;
            PG8_STAGE(PG8_SB(1, 1), b3 + hstep, voffB);
            PG8_WAIT_V(6); PG8_BAR; PG8_MMA(1, 1, At, B1); PG8_BAR;
            }
        }
        if constexpr (ALIGN_EPI) { if (wr == 0) PG8_BAR; }
        if constexpr (!Epi::AFTER_DRAIN) { E(acc, cur, wr, wc, fr, fq); S.done(cur); }
        if (!has_next) break;
#pragma unroll
        for (int a = 0; a < 2; ++a)
#pragma unroll
            for (int b = 0; b < 2; ++b)
#pragma unroll
                for (int m = 0; m < 4; ++m)
#pragma unroll
                    for (int n = 0; n < 2; ++n) acc[a][b][m][n] = (f32x4){0.f, 0.f, 0.f, 0.f};
        cur = nxt; cA = nA; cB = nB; ++ui;
        if constexpr (ALIGN_EPI) { if (wr == 1) PG8_BAR; }
    }
    PG8_WAIT_V(0);
    if constexpr (!ALIGN_EPI) { if (wr == 0) PG8_BAR; }
    PG8_BAR;
    if constexpr (Epi::AFTER_DRAIN) { E.fused(acc, cur, wr, wc, fr, fq, lds, wid, lane); S.done(cur); }
#undef PG8_SA
#undef PG8_SB
#undef PG8_STAGE
#undef PG8_LDA
#undef PG8_LDB
#undef PG8_MMA
#undef PG8_WAIT_V
#undef PG8_WAIT_L
#undef PG8_BAR
#undef PG8_SCHED
}
}
#define GAS __attribute__((address_space(1)))
#define LAS __attribute__((address_space(3)))
typedef unsigned short bf16;
typedef unsigned v4u __attribute__((ext_vector_type(4)));
typedef float f32x4 __attribute__((ext_vector_type(4)));
typedef short bf16x8 __attribute__((ext_vector_type(8)));
typedef GAS unsigned gu32;
typedef GAS unsigned long long gu64;
#define RLX_AGENT __ATOMIC_RELAXED, __HIP_MEMORY_SCOPE_AGENT
#define LDS_WAIT() asm volatile("s_waitcnt lgkmcnt(0)" ::: "memory")
#define VM_WAIT() asm volatile("s_waitcnt vmcnt(0)" ::: "memory")
__device__ __forceinline__ unsigned long long rt() { return __builtin_amdgcn_s_memrealtime(); }
__device__ __forceinline__ unsigned f2bf(float f) { unsigned u = __builtin_bit_cast(unsigned, f); return (u + 0x7fffu + ((u >> 16) & 1u)) >> 16; }
__device__ __forceinline__ unsigned pk2(float lo, float hi) { return f2bf(lo) | (f2bf(hi) << 16); }
#define XB_TMO      128
#define XB_XCNT(j)  (256  + 64 * (j))
#define XB_XSUB(j)  (1280 + 64 * (j))
#define XB_XGEN(j)  (2304 + 64 * (j))
#define XB_TOP      3328
#define XB_TOPGEN   3392
#define XCD_BAR_WORDS 3456
#define XB_SPIN_CAP (1u << 18)

__device__ __forceinline__ unsigned xb_ld(unsigned* p)              { return __hip_atomic_load(p, __ATOMIC_RELAXED, __HIP_MEMORY_SCOPE_AGENT); }
__device__ __forceinline__ unsigned xb_add(unsigned* p, unsigned v) { return __hip_atomic_fetch_add(p, v, __ATOMIC_RELAXED, __HIP_MEMORY_SCOPE_AGENT); }
__device__ __forceinline__ unsigned xb_xcc_id() { return (unsigned)__builtin_amdgcn_s_getreg((3 << 11) | 20) & 0xFu; }
#define XB_SPIN(cond, bar) do { unsigned _sp = 0; while (cond) { __builtin_amdgcn_s_sleep(1); \
    if ((++_sp & 255u) == 0u) { if (xb_ld(&(bar)[XB_TMO])) break; if (_sp > XB_SPIN_CAP) { atomicAdd(&(bar)[XB_TMO], 1u); break; } } } } while (0)

struct XcdBarrier {
    unsigned* bar; unsigned x;
    volatile LAS unsigned* st;
};

__device__ __forceinline__ XcdBarrier xcd_barrier_post(unsigned* bar, volatile LAS unsigned* st) {
    XcdBarrier b; b.bar = bar; b.x = xb_xcc_id(); b.st = st;
    if (threadIdx.x == 0) (void)xb_add(&bar[XB_XCNT(b.x)], 1u);
    return b;
}
__device__ __forceinline__ void xcd_barrier_complete(unsigned* bar, unsigned x, unsigned& nloc, unsigned& nx) {
    const unsigned G = gridDim.x * gridDim.y * gridDim.z;
    unsigned sum, cnt, mine, sp = 0u;
    for (;;) {
        sum = 0u; cnt = 0u; mine = 0u;
#pragma unroll
        for (unsigned j = 0; j < 16; ++j) { const unsigned c = xb_ld(&bar[XB_XCNT(j)]); sum += c; cnt += (c > 0u) ? 1u : 0u; mine = (j == x) ? c : mine; }
        if (sum == G) break;
        __builtin_amdgcn_s_sleep(1);
        if ((++sp & 255u) == 0u) { if (xb_ld(&bar[XB_TMO])) break; if (sp > XB_SPIN_CAP) { atomicAdd(&bar[XB_TMO], 1u); break; } }
    }
    nloc = mine > 0u ? mine : 1u; nx = cnt > 0u ? cnt : 1u;
}

__device__ __forceinline__ void xcd_barrier(const XcdBarrier& b) {
    asm volatile("s_waitcnt vmcnt(0)" ::: "memory");
    __syncthreads();
    if (threadIdx.x == 0) {
        unsigned* bar = b.bar;
        __builtin_amdgcn_s_waitcnt(0);
        unsigned nloc = b.st[0], nx = b.st[1];
        if (nloc == 0u) { xcd_barrier_complete(bar, b.x, nloc, nx); b.st[0] = nloc; b.st[1] = nx; }
        const unsigned old = xb_add(&bar[XB_XSUB(b.x)], 1u);
        const unsigned gen = old / nloc;
        if (old + 1u == (gen + 1u) * nloc) {
            __builtin_amdgcn_fence(__ATOMIC_RELEASE, "agent");
            asm volatile("s_waitcnt vmcnt(0)" ::: "memory");
            const unsigned og = xb_add(&bar[XB_TOP], 1u);
            const unsigned tg = og / nx;
            if (og + 1u == (tg + 1u) * nx) xb_add(&bar[XB_TOPGEN], 1u);
            else XB_SPIN(xb_ld(&bar[XB_TOPGEN]) == tg, bar);
            __builtin_amdgcn_fence(__ATOMIC_ACQUIRE, "agent");
            xb_add(&bar[XB_XGEN(b.x)], 1u);
            asm volatile("s_waitcnt vmcnt(0)" ::: "memory");
        } else {
            XB_SPIN(xb_ld(&bar[XB_XGEN(b.x)]) == gen, bar);
            __builtin_amdgcn_fence(__ATOMIC_ACQUIRE, "agent");
            asm volatile("s_waitcnt vmcnt(0)" ::: "memory");
        }
    }
    __syncthreads();
}

namespace pg8 {
struct EpiSwiGLU {
    static constexpr bool PERM = true, AFTER_DRAIN = false;
    bf16_t* O; int ldc;
    __device__ __forceinline__ void operator()(const f32x4 (&acc)[2][2][4][2], const Unit& u, int wr, int wc, int fr, int fq) const {
        const int row0 = u.pm * BM + wr * 64 + fr; const int col0 = u.pn * HALF + wc * 32 + 8 * fq;
#pragma unroll
        for (int ai = 0; ai < 2; ++ai)
#pragma unroll
            for (int m = 0; m < 4; ++m) { bf16_t* rowp = O + (size_t)(row0 + ai * HALF + m * 16) * ldc + col0;
                float r[8];
#pragma unroll
                for (int n = 0; n < 2; ++n)
#pragma unroll
                    for (int i = 0; i < 4; ++i) { const float g = acc[ai][0][m][n][i], up = acc[ai][1][m][n][i];
                        const float e = __builtin_amdgcn_exp2f(-g * 1.4426950408889634f); r[n * 4 + i] = g * __builtin_amdgcn_rcpf(1.0f + e) * up; }
                u32x4 w; w.x = cvt_pk_bf16(r[0], r[1]); w.y = cvt_pk_bf16(r[2], r[3]); w.z = cvt_pk_bf16(r[4], r[5]); w.w = cvt_pk_bf16(r[6], r[7]);
                *(u32x4*)rowp = w; }
    }
};
}

constexpr int NWAVES = 8;
constexpr int BATCH = 2, SEQ = 8192, D = 1024, M = BATCH * SEQ, FFH = 2816;
constexpr float EPS = 1e-6f;
constexpr int NKEY = 387, NKEYP = 392;

constexpr size_t MiB = 1u << 20, HMiB = 1u << 19;
constexpr size_t WS_CTL = 0, CTL_ZERO_BYTES = 1 * MiB;
constexpr size_t WS_SMALL = 1 * MiB;
constexpr size_t SM_MOD = 0;
constexpr size_t SM_BIAST = 131072;
constexpr size_t SM_LB = 147456;
constexpr size_t SM_TW = 262144;
constexpr size_t WS_WINAB = 2 * MiB, WS_WOUTAB = 10 * MiB, WS_WINCD = 12 * MiB, WS_WOUTCD = 14 * MiB + HMiB;
constexpr size_t WS_WF1 = 16 * MiB + HMiB, WF1_BYTES = 11 * MiB, WS_WF2 = 38 * MiB + HMiB, WF2_BYTES = 5 * MiB + HMiB;
constexpr size_t WS_XN = 50 * MiB, WS_YB = 82 * MiB, WS_Z = 114 * MiB, WS_END = 242 * MiB;
constexpr size_t SEG = (size_t)M * 512;
constexpr int CW_BAR = 4096;

constexpr int RING_OFF = 0, RING_BYTES = 131072;
constexpr int TAB_OFF = RING_BYTES;
constexpr int LDSCTL_OFF = RING_BYTES + 1024, MISC_OFF = LDSCTL_OFF + 320;
constexpr int LDS_BYTES = 147456;

__device__ __forceinline__ float bf2f(unsigned short h) { return __builtin_bit_cast(float, (unsigned)h << 16); }
__device__ __forceinline__ float bflo(unsigned w) { return __builtin_bit_cast(float, w << 16); }
__device__ __forceinline__ float bfhi(unsigned w) { return __builtin_bit_cast(float, w & 0xffff0000u); }
__device__ __forceinline__ float wave_sum(float v) {
#pragma unroll
    for (int o = 1; o < 64; o <<= 1) v += __shfl_xor(v, o);
    return v;
}
__device__ __forceinline__ float wave_max(float v) {
#pragma unroll
    for (int o = 1; o < 64; o <<= 1) v = fmaxf(v, __shfl_xor(v, o));
    return v;
}
__device__ __forceinline__ float rdlane(float v, int j) { return __builtin_bit_cast(float, __builtin_amdgcn_readlane(__builtin_bit_cast(int, v), j)); }
__device__ __forceinline__ float siluf(float g) { return g / (1.0f + __expf(-g)); }

struct Frame {
    LAS unsigned char* lds;
    volatile LAS unsigned* MISC;
    gu32* ctl;
    int tid, lane, wave, vcu, G;
    const float *x, *c, *t5, *lbl, *ada_w, *ada_b, *gains, *ab_in, *ab_out, *hnorm, *cd_in, *cd_out, *qkn, *f_in, *f_out;
    float* out;
    unsigned char* ws;
};

__device__ __forceinline__ void p_adaln(Frame& F) {
    LAS float* red = (LAS float*)(F.lds + RING_OFF);
    float* MOD = (float*)(F.ws + WS_SMALL + SM_MOD);
    const int r4 = F.lane >> 4, c4 = F.lane & 15;
    for (int task = blockIdx.x; task < 192; task += F.G) {
        const int l = task / 96, cg = task % 96;
        const float* W = F.ada_w + (size_t)l * 1024 * 6144 + cg * 64 + 4 * c4;
        f32x4 a0 = {0.f, 0.f, 0.f, 0.f}, a1 = {0.f, 0.f, 0.f, 0.f};
#pragma unroll 4
        for (int i = 0; i < 32; ++i) {
            const int row = 128 * F.wave + 4 * i + r4;
            const f32x4 wv = *(const f32x4*)(W + (size_t)row * 6144);
            const float c0 = F.c[row], c1 = F.c[1024 + row];
            a0 += siluf(c0) * wv; a1 += siluf(c1) * wv;
        }
#pragma unroll
        for (int i = 0; i < 4; ++i) { a0[i] += __shfl_xor(a0[i], 16); a0[i] += __shfl_xor(a0[i], 32); a1[i] += __shfl_xor(a1[i], 16); a1[i] += __shfl_xor(a1[i], 32); }
        if (r4 == 0) {
#pragma unroll
            for (int i = 0; i < 4; ++i) { red[(F.wave * 2 + 0) * 64 + 4 * c4 + i] = a0[i]; red[(F.wave * 2 + 1) * 64 + 4 * c4 + i] = a1[i]; }
        }
        __syncthreads();
        if (F.tid < 128) { const int b = F.tid >> 6, col = F.tid & 63; float s = 0.f;
#pragma unroll
            for (int w = 0; w < 8; ++w) s += red[(w * 2 + b) * 64 + col];
            MOD[(l * 2 + b) * 6144 + cg * 64 + col] = s + F.ada_b[l * 6144 + cg * 64 + col]; }
        __syncthreads();
    }
    if ((int)blockIdx.x == F.G - 1) {
        float* BT = (float*)(F.ws + WS_SMALL + SM_BIAST);
        for (int idx = F.tid; idx < NKEY; idx += NWAVES * 64) {
            const int r = idx / 129, j = idx - r * 129 - 64, d = (r == 0) ? 1 : (r == 1) ? 4 : 16, rel = j * d, n = rel < 0 ? -rel : rel;
            int large = 8 + (int)(log((double)(n > 1 ? n : 1) / 8.0) / log(128.0) * 8.0); if (large > 15) large = 15;
            const int bucket = (rel > 0 ? 16 : 0) + (n < 8 ? n : large);
#pragma unroll
            for (int h = 0; h < 8; ++h) BT[h * NKEYP + idx] = F.t5[bucket * 8 + h];
        }
    }
    if ((int)blockIdx.x == F.G - 2) {
        float* LB = (float*)(F.ws + WS_SMALL + SM_LB);
        for (int i = F.tid; i < 1024; i += NWAVES * 64) {
            const float l0 = F.lbl[i], l1 = F.lbl[1024 + i], l2 = F.lbl[2048 + i]; const float mx = fmaxf(l0, fmaxf(l1, l2));
            const float e0 = expf(l0 - mx), e1 = expf(l1 - mx), e2 = expf(l2 - mx); LB[i] = e0 / (e0 + e1 + e2);
        }
    }
    if ((int)blockIdx.x >= F.G - 18 && (int)blockIdx.x < F.G - 2) {
        float* TW = (float*)(F.ws + WS_SMALL + SM_TW);
        const int j = ((int)blockIdx.x - (F.G - 18)) * 512 + F.tid;
        const double a = (double)j * (6.283185307179586476925286766559 / 8192.0);
        TW[j] = (float)cos(a); TW[8192 + j] = (float)sin(a);
    }
}

__device__ __forceinline__ void transpose_item(const float* W, int K, int N, bf16* WT, int dest_row0, int k0, int n0, LAS float* scr, int lane) {
#pragma unroll 8
    for (int i = 0; i < 32; ++i) { const int kk = 2 * i + (lane >> 5); scr[kk * 33 + (lane & 31)] = W[(size_t)(k0 + kk) * N + n0 + (lane & 31)]; }
    LDS_WAIT(); asm volatile("" ::: "memory");
    const int c = lane & 7;
#pragma unroll
    for (int j = 0; j < 4; ++j) { const int n = (lane >> 3) + 8 * j; const LAS float* s = scr + (8 * c) * 33 + n;
        v4u o; o.x = pk2(s[0 * 33], s[1 * 33]); o.y = pk2(s[2 * 33], s[3 * 33]); o.z = pk2(s[4 * 33], s[5 * 33]); o.w = pk2(s[6 * 33], s[7 * 33]);
        *(GAS v4u*)(WT + (size_t)(dest_row0 + n) * K + k0 + 8 * c) = o; }
    LDS_WAIT(); asm volatile("" ::: "memory");
}
__device__ __forceinline__ void p_weights(Frame& F) {
    LAS float* scr = (LAS float*)(F.lds + RING_OFF + F.wave * 16384);
    const int gw = F.vcu * NWAVES + F.wave, NGW = F.G * NWAVES;
    constexpr int I_ABI = 16 * 128, I_ABO = 16 * 32, I_CDI = 16 * 40, I_CDO = 16 * 32, I_F1 = 16 * 176, I_F2 = 44 * 32;
    constexpr int NITEMS = I_ABI + I_ABO + I_CDI + I_CDO + 2 * I_F1 + 2 * I_F2;
    for (int it = gw; it < NITEMS; it += NGW) {
        int r = it;
        if (r < I_ABI) { const int nb = 128, kb = r / nb, n0 = 32 * (r % nb); transpose_item(F.ab_in, 1024, 4096, (bf16*)(F.ws + WS_WINAB), n0, 64 * kb, n0, scr, F.lane); continue; } r -= I_ABI;
        if (r < I_ABO) { const int nb = 32, kb = r / nb, n0 = 32 * (r % nb); transpose_item(F.ab_out, 1024, 1024, (bf16*)(F.ws + WS_WOUTAB), n0, 64 * kb, n0, scr, F.lane); continue; } r -= I_ABO;
        if (r < I_CDI) { const int nb = 40, kb = r / nb, n0 = 32 * (r % nb); transpose_item(F.cd_in, 1024, 1280, (bf16*)(F.ws + WS_WINCD), n0, 64 * kb, n0, scr, F.lane); continue; } r -= I_CDI;
        if (r < I_CDO) { const int nb = 32, kb = r / nb, n0 = 32 * (r % nb); transpose_item(F.cd_out, 1024, 1024, (bf16*)(F.ws + WS_WOUTCD), n0, 64 * kb, n0, scr, F.lane); continue; } r -= I_CDO;
        if (r < 2 * I_F1) { const int l = r / I_F1; r -= l * I_F1; const int nb = 176, kb = r / nb, n0 = 32 * (r % nb);
            const int up = n0 >= FFH ? 1 : 0, j = n0 - up * FFH, drow = 256 * (j >> 7) + 128 * up + (j & 127);
            transpose_item(F.f_in + (size_t)l * 1024 * 5632, 1024, 5632, (bf16*)(F.ws + WS_WF1 + l * WF1_BYTES), drow, 64 * kb, n0, scr, F.lane); continue; } r -= 2 * I_F1;
        { const int l = r / I_F2; r -= l * I_F2; const int nb = 32, kb = r / nb, n0 = 32 * (r % nb);
            transpose_item(F.f_out + (size_t)l * FFH * 1024, FFH, 1024, (bf16*)(F.ws + WS_WF2 + l * WF2_BYTES), n0, 64 * kb, n0, scr, F.lane); }
    }
}
__device__ __forceinline__ void p_rows(Frame& F, const float* xin, const bf16* y, const float* gate_mod  , const float* gain_post,
                                       float* xout, const float* mod_next  , const float* gain_pre, bf16* xn) {
    const int gw = F.vcu * NWAVES + F.wave, NGW = F.G * NWAVES;
    for (int b = 0; b < BATCH; ++b) {
        f32x4 A1[4], A2[4], B2[4];
#pragma unroll
        for (int j = 0; j < 4; ++j) { const int col = 4 * F.lane + 256 * j;
            if (y) { const f32x4 g = *(const f32x4*)(gate_mod + b * 6144 + col), gp = *(const f32x4*)(gain_post + col); A1[j] = g * gp; } else A1[j] = (f32x4){0.f, 0.f, 0.f, 0.f};
            if (mod_next) { const f32x4 sh = *(const f32x4*)(mod_next + b * 6144 + col), sc = *(const f32x4*)(mod_next + b * 6144 + 1024 + col), gp = *(const f32x4*)(gain_pre + col);
                A2[j] = gp * (sc + 1.0f); B2[j] = sh; } else { A2[j] = (f32x4){0.f, 0.f, 0.f, 0.f}; B2[j] = A2[j]; } }
        for (int m = b * SEQ + gw; m < (b + 1) * SEQ; m += NGW) {
            f32x4 v[4];
#pragma unroll
            for (int j = 0; j < 4; ++j) v[j] = *(const f32x4*)(xin + (size_t)m * D + 4 * F.lane + 256 * j);
            if (y) {
                f32x4 yv[4]; float ss = 0.f;
#pragma unroll
                for (int j = 0; j < 4; ++j) { const uint2 w = *(const uint2*)(y + (size_t)m * D + 4 * F.lane + 256 * j);
                    yv[j] = (f32x4){bflo(w.x), bfhi(w.x), bflo(w.y), bfhi(w.y)}; ss += (yv[j].x * yv[j].x + yv[j].y * yv[j].y) + (yv[j].z * yv[j].z + yv[j].w * yv[j].w); }
                const float rs = 1.0f / sqrtf(wave_sum(ss) * (1.0f / D) + EPS);
#pragma unroll
                for (int j = 0; j < 4; ++j) v[j] = v[j] + A1[j] * (yv[j] * rs);
            }
            if (xout) {
#pragma unroll
                for (int j = 0; j < 4; ++j) *(f32x4*)(xout + (size_t)m * D + 4 * F.lane + 256 * j) = v[j];
            }
            if (mod_next) {
                float ss = 0.f;
#pragma unroll
                for (int j = 0; j < 4; ++j) ss += (v[j].x * v[j].x + v[j].y * v[j].y) + (v[j].z * v[j].z + v[j].w * v[j].w);
                const float rs = 1.0f / sqrtf(wave_sum(ss) * (1.0f / D) + EPS);
#pragma unroll
                for (int j = 0; j < 4; ++j) { const f32x4 h = (v[j] * rs) * A2[j] + B2[j];
                    uint2 w; w.x = pk2(h.x, h.y); w.y = pk2(h.z, h.w); *(uint2*)(xn + (size_t)m * D + 4 * F.lane + 256 * j) = w; }
            }
        }
    }
}

__device__ __forceinline__ void p_dilated_naive(Frame& F, const bf16* Q, const bf16* K, const bf16* V, bf16* O  ) {
    const float* BT = (const float*)(F.ws + WS_SMALL + SM_BIAST);
    const int gw = F.vcu * NWAVES + F.wave, NGW = F.G * NWAVES, lane = F.lane;
    for (int item = gw; item < M * 8; item += NGW) {
        const int m = item >> 3, h = item & 7, b = m >> 13, t = m & 8191;
        float qf[64];
        { const uint4* qp = (const uint4*)(Q + (size_t)m * 512 + h * 64);
#pragma unroll
          for (int i = 0; i < 8; ++i) { const uint4 w = qp[i]; qf[8 * i + 0] = bflo(w.x); qf[8 * i + 1] = bfhi(w.x); qf[8 * i + 2] = bflo(w.y); qf[8 * i + 3] = bfhi(w.y);
              qf[8 * i + 4] = bflo(w.z); qf[8 * i + 5] = bfhi(w.z); qf[8 * i + 6] = bflo(w.w); qf[8 * i + 7] = bfhi(w.w); } }
        float lg[7]; int posv[7]; float mx = -3.0e38f;
#pragma unroll
        for (int g = 0; g < 7; ++g) {
            const int idx = g * 64 + lane; float l = -3.0e38f; int pos = t;
            if (idx < NKEY) { const int r = idx / 129, j = idx - r * 129 - 64, d = (r == 0) ? 1 : (r == 1) ? 4 : 16; pos = t + j * d;
                if (pos >= 0 && pos < SEQ) { const uint4* kp = (const uint4*)(K + (size_t)(b * SEQ + pos) * 512 + h * 64); float dot = 0.f;
#pragma unroll
                    for (int i = 0; i < 8; ++i) { const uint4 w = kp[i]; dot += qf[8 * i + 0] * bflo(w.x) + qf[8 * i + 1] * bfhi(w.x) + qf[8 * i + 2] * bflo(w.y) + qf[8 * i + 3] * bfhi(w.y)
                                                                            + qf[8 * i + 4] * bflo(w.z) + qf[8 * i + 5] * bfhi(w.z) + qf[8 * i + 6] * bflo(w.w) + qf[8 * i + 7] * bfhi(w.w); }
                    l = dot * 0.125f + BT[h * NKEYP + idx]; } else pos = t; }
            lg[g] = l; posv[g] = pos; mx = fmaxf(mx, l);
        }
        mx = wave_max(mx);
        float s = 0.f;
#pragma unroll
        for (int g = 0; g < 7; ++g) { lg[g] = (lg[g] > -1.0e38f) ? __expf(lg[g] - mx) : 0.f; s += lg[g]; }
        s = wave_sum(s);
        float acc = 0.f; const bf16* Vb = V + (size_t)b * SEQ * 512 + h * 64 + lane;
#pragma unroll
        for (int g = 0; g < 7; ++g) { const int n = (g < 6) ? 64 : (NKEY - 384);
            for (int j = 0; j < n; ++j) { const float pj = rdlane(lg[g], j); const int pos = __builtin_amdgcn_readlane(posv[g], j);
                if (pj != 0.f) acc += pj * bf2f(Vb[(size_t)pos * 512]); } }
        O[(size_t)m * 1024 + h * 64 + lane] = (bf16)f2bf(acc / s);
    }
}

__device__ __forceinline__ void p_hgrn_naive(Frame& F, const bf16* Qh, const bf16* Ff, const bf16* Fb, const bf16* Ih, float* Odir) {
    const float* LB = (const float*)(F.ws + WS_SMALL + SM_LB);
    constexpr int TT = 32;
    LAS float* qs = (LAS float*)(F.lds + RING_OFF);
    LAS float* fa = qs + TT * 128;
    LAS float* vv = fa + TT * 128;
    const int tid = F.tid, lane = F.lane, vi = lane & 1, kq = lane >> 1;
    for (int item = blockIdx.x; item < 128; item += F.G) {
        const int chain = item >> 3, vs = item & 7, dir = chain >> 3, b = (chain >> 2) & 1, h = chain & 3;
        const bf16* Fp = dir ? Fb : Ff;
        float S[4] = {0.f, 0.f, 0.f, 0.f};
        const int vcol = h * 128 + vs * 16 + F.wave * 2 + vi;
        for (int s0 = 0; s0 < SEQ; s0 += TT) {
            __syncthreads();
            { const int tt = tid >> 4, k0 = (tid & 15) * 8; const int t = dir ? (SEQ - 1 - (s0 + tt)) : (s0 + tt); const size_t row = (size_t)(b * SEQ + t) * 512 + h * 128 + k0;
              const uint4 qw = *(const uint4*)(Qh + row), fw = *(const uint4*)(Fp + row);
              const unsigned qa[4] = {qw.x, qw.y, qw.z, qw.w}, fb_[4] = {fw.x, fw.y, fw.z, fw.w};
#pragma unroll
              for (int i = 0; i < 4; ++i) {
                  const float lb0 = LB[dir * 512 + h * 128 + k0 + 2 * i], lb1 = LB[dir * 512 + h * 128 + k0 + 2 * i + 1];
                  qs[tt * 128 + k0 + 2 * i] = bflo(qa[i]) * 0.08838834764831845f; qs[tt * 128 + k0 + 2 * i + 1] = bfhi(qa[i]) * 0.08838834764831845f;
                  fa[tt * 128 + k0 + 2 * i] = lb0 + (1.0f - lb0) / (1.0f + __expf(-bflo(fb_[i]))); fa[tt * 128 + k0 + 2 * i + 1] = lb1 + (1.0f - lb1) / (1.0f + __expf(-bfhi(fb_[i]))); }
              if (tid < TT * 16) { const int tv = tid >> 4, vc = tid & 15; const int t2 = dir ? (SEQ - 1 - (s0 + tv)) : (s0 + tv);
                  vv[tv * 16 + vc] = bf2f(Ih[(size_t)(b * SEQ + t2) * 512 + h * 128 + vs * 16 + vc]); } }
            __syncthreads();
#pragma unroll 4
            for (int tt = 0; tt < TT; ++tt) {
                const f32x4 f4 = *(const LAS f32x4*)(fa + tt * 128 + 4 * kq), q4 = *(const LAS f32x4*)(qs + tt * 128 + 4 * kq); const float v = vv[tt * 16 + F.wave * 2 + vi];
                float o = 0.f;
#pragma unroll
                for (int i = 0; i < 4; ++i) { S[i] = f4[i] * S[i] + (1.0f - f4[i]) * v; o += q4[i] * S[i]; }
                o += __shfl_xor(o, 2); o += __shfl_xor(o, 4); o += __shfl_xor(o, 8); o += __shfl_xor(o, 16); o += __shfl_xor(o, 32);
                if (kq == 0) { const int t = dir ? (SEQ - 1 - (s0 + tt)) : (s0 + tt); Odir[((size_t)dir * M + (size_t)(b * SEQ + t)) * 512 + vcol] = o; }
            }
        }
    }
}
__device__ __forceinline__ void p_hgrn_final(Frame& F, const float* Odir, const bf16* Gh, bf16* O) {
    const int gw = F.vcu * NWAVES + F.wave, NGW = F.G * NWAVES, lane = F.lane;
    const float g0 = F.hnorm[2 * lane], g1 = F.hnorm[2 * lane + 1];
    for (int item = gw; item < M * 4; item += NGW) {
        const int m = item >> 2, h = item & 3; const size_t off = (size_t)m * 512 + h * 128 + 2 * lane;
        const float2 a = *(const float2*)(Odir + off), c = *(const float2*)(Odir + (size_t)M * 512 + off);
        const float o0 = a.x + c.x, o1 = a.y + c.y; const float rs = 1.0f / sqrtf(wave_sum(o0 * o0 + o1 * o1) * (1.0f / 128.0f) + EPS);
        const unsigned gw2 = *(const unsigned*)(Gh + off); const float r0 = o0 * rs * g0 * siluf(bflo(gw2)), r1 = o1 * rs * g1 * siluf(bfhi(gw2));
        *(unsigned*)(O + (size_t)m * 1024 + 512 + h * 128 + 2 * lane) = pk2(r0, r1);
    }
}

__device__ __forceinline__ void tab128_init(Frame& F) {
    LAS float* T = (LAS float*)(F.lds + TAB_OFF);
    if (F.tid < 128) { float s, c; sincospif((float)F.tid * (1.0f / 64.0f), &s, &c); T[F.tid] = c; T[128 + F.tid] = s; }
    __syncthreads();
}
__device__ __forceinline__ void p_fnet1_naive(Frame& F, const bf16* U  , float* APR, float* API) {
    const float* TW = (const float*)(F.ws + WS_SMALL + SM_TW);
    LAS float* T = (LAS float*)(F.lds + TAB_OFF);
    LAS float* Us = (LAS float*)(F.lds + RING_OFF);
    LAS float* Zr = Us + 64 * 129 + 64;
    LAS float* Zi = Zr + 64 * 128;
    tab128_init(F);
    const int tid = F.tid, kc = tid & 127, grp = tid >> 7;
    for (int unit = blockIdx.x; unit < 2 * 4 * 128; unit += F.G) {
        const int b = unit >> 9, g = (unit >> 7) & 3, n2 = unit & 127;
        __syncthreads();
        { const int row = tid >> 3, c0 = (tid & 7) * 16; const uint4* p = (const uint4*)(U + (size_t)(b * SEQ + 128 * row + n2) * 512 + g * 128 + c0);
#pragma unroll
          for (int i = 0; i < 2; ++i) { const uint4 w = p[i]; LAS float* d = Us + row * 129 + c0 + 8 * i;
              d[0] = bflo(w.x); d[1] = bfhi(w.x); d[2] = bflo(w.y); d[3] = bfhi(w.y); d[4] = bflo(w.z); d[5] = bfhi(w.z); d[6] = bflo(w.w); d[7] = bfhi(w.w); } }
        __syncthreads();
        { float zr[16], zi[16];
#pragma unroll
          for (int i = 0; i < 16; ++i) { zr[i] = 0.f; zi[i] = 0.f; }
          for (int c = 0; c < 128; ++c) { const int idx = (c * kc) & 127; const float cs = T[idx], sn = T[128 + idx];
#pragma unroll
              for (int i = 0; i < 16; ++i) { const float u = Us[(grp * 16 + i) * 129 + c]; zr[i] += u * cs; zi[i] -= u * sn; } }
#pragma unroll
          for (int i = 0; i < 16; ++i) { Zr[(grp * 16 + i) * 128 + kc] = zr[i]; Zi[(grp * 16 + i) * 128 + kc] = zi[i]; } }
        __syncthreads();
        { float ar[16], ai[16];
#pragma unroll
          for (int i = 0; i < 16; ++i) { ar[i] = 0.f; ai[i] = 0.f; }
          for (int n1 = 0; n1 < 64; ++n1) { const float zr = Zr[n1 * 128 + kc], zi = Zi[n1 * 128 + kc];
#pragma unroll
              for (int i = 0; i < 16; ++i) { const int idx = (2 * n1 * (grp * 16 + i)) & 127; const float cs = T[idx], sn = T[128 + idx]; ar[i] += zr * cs + zi * sn; ai[i] += zi * cs - zr * sn; } }
#pragma unroll
          for (int i = 0; i < 16; ++i) { const int k1 = grp * 16 + i; const float ct = TW[n2 * k1], st = TW[8192 + n2 * k1];
              const size_t o = ((size_t)((b * 4 + g) * 128 + n2) * 64 + k1) * 128 + kc;
              APR[o] = ar[i] * ct + ai[i] * st; API[o] = ai[i] * ct - ar[i] * st; } }
    }
}
__device__ __forceinline__ void p_fnet2_naive(Frame& F, const float* APR, const float* API, bf16* O) {
    LAS float* T = (LAS float*)(F.lds + TAB_OFF);
    LAS float* Ar = (LAS float*)(F.lds + RING_OFF);
    LAS float* Ai = Ar + 128 * 128;
    tab128_init(F);
    const int tid = F.tid, kc = tid & 127, grp = tid >> 7;
    for (int unit = blockIdx.x; unit < 2 * 4 * 64; unit += F.G) {
        const int b = unit >> 8, g = (unit >> 6) & 3, k1 = unit & 63;
        __syncthreads();
        for (int e = tid; e < 128 * 128 / 4; e += NWAVES * 64) { const int n2 = e >> 5, c4 = (e & 31) * 4; const size_t o = ((size_t)((b * 4 + g) * 128 + n2) * 64 + k1) * 128 + c4;
            *(LAS f32x4*)(Ar + n2 * 128 + c4) = *(const f32x4*)(APR + o); *(LAS f32x4*)(Ai + n2 * 128 + c4) = *(const f32x4*)(API + o); }
        __syncthreads();
        float y[32];
#pragma unroll
        for (int i = 0; i < 32; ++i) y[i] = 0.f;
        for (int n2 = 0; n2 < 128; ++n2) { const float ar = Ar[n2 * 128 + kc], ai = Ai[n2 * 128 + kc];
#pragma unroll
            for (int i = 0; i < 32; ++i) { const int idx = (n2 * (grp * 32 + i)) & 127; y[i] += ar * T[idx] + ai * T[128 + idx]; } }
#pragma unroll
        for (int i = 0; i < 32; ++i) { const int k2 = grp * 32 + i; O[(size_t)(b * SEQ + k1 + 64 * k2) * 1024 + g * 128 + kc] = (bf16)f2bf(y[i] * (1.0f / 1024.0f)); }
    }
}

__device__ __forceinline__ void p_qkprep(Frame& F, bf16* QD, bf16* KV, float qscale) {
    const int gw = F.vcu * NWAVES + F.wave, NGW = F.G * NWAVES, lane = F.lane;
    const float invf = powf(10000.0f, -(float)(lane & 15) * (1.0f / 16.0f));
    const float gq = F.qkn[lane], gk = F.qkn[64 + lane];
    for (int m = gw; m < M; m += NGW) {
        const int t = m & 8191; const float pos = (lane < 32) ? (float)(t >> 6) : (float)(t & 63); const float ang = pos * invf; const float cs = cosf(ang), sn = sinf(ang);
#pragma unroll
        for (int hh = 0; hh < 10; ++hh) {
            bf16* p = (hh < 8) ? (QD + (size_t)m * 512 + hh * 64 + lane) : (KV + (size_t)m * 512 + (hh - 8) * 64 + lane);
            const float x = bf2f(*p); const float rs = 1.0f / sqrtf(wave_sum(x * x) * (1.0f / 64.0f) + EPS); const float xn = x * rs * ((hh < 8) ? gq : gk);
            const float xp = __shfl_xor(xn, 16);
            const float r = (lane & 16) ? (xp * sn + xn * cs) : (xn * cs - xp * sn);
            *p = (bf16)f2bf(r * ((hh < 8) ? qscale : 1.0f));
        }
    }
}
__device__ __forceinline__ void p_gqa_naive(Frame& F, const bf16* QD, const bf16* KV, bf16* O) {
    const int gw = F.vcu * NWAVES + F.wave, NGW = F.G * NWAVES, lane = F.lane;
    for (int item = gw; item < M * 8; item += NGW) {
        const int m = item >> 3, hq = item & 7, b = m >> 13, hk = hq >> 2;
        float qf[64];
        { const uint4* qp = (const uint4*)(QD + (size_t)m * 512 + hq * 64);
#pragma unroll
          for (int i = 0; i < 8; ++i) { const uint4 w = qp[i]; qf[8 * i + 0] = bflo(w.x); qf[8 * i + 1] = bfhi(w.x); qf[8 * i + 2] = bflo(w.y); qf[8 * i + 3] = bfhi(w.y);
              qf[8 * i + 4] = bflo(w.z); qf[8 * i + 5] = bfhi(w.z); qf[8 * i + 6] = bflo(w.w); qf[8 * i + 7] = bfhi(w.w); } }
        float mrun = -3.0e38f, srun = 0.f, acc = 0.f;
        const bf16* Kb = KV + (size_t)b * SEQ * 512 + hk * 64; const bf16* Vb = KV + (size_t)b * SEQ * 512 + 128 + hk * 64 + lane;
        for (int kg = 0; kg < SEQ / 64; ++kg) {
            const uint4* kp = (const uint4*)(Kb + (size_t)(kg * 64 + lane) * 512); float dot = 0.f;
#pragma unroll
            for (int i = 0; i < 8; ++i) { const uint4 w = kp[i]; dot += qf[8 * i + 0] * bflo(w.x) + qf[8 * i + 1] * bfhi(w.x) + qf[8 * i + 2] * bflo(w.y) + qf[8 * i + 3] * bfhi(w.y)
                                                                    + qf[8 * i + 4] * bflo(w.z) + qf[8 * i + 5] * bfhi(w.z) + qf[8 * i + 6] * bflo(w.w) + qf[8 * i + 7] * bfhi(w.w); }
            const float mnew = fmaxf(mrun, wave_max(dot)); const float corr = __expf(mrun - mnew); const float p = __expf(dot - mnew);
            srun = srun * corr + wave_sum(p); acc *= corr; mrun = mnew;
#pragma unroll 8
            for (int j = 0; j < 64; ++j) acc += rdlane(p, j) * bf2f(Vb[(size_t)(kg * 64 + j) * 512]);
        }
        O[(size_t)m * 1024 + 512 + hq * 64 + lane] = (bf16)f2bf(acc / srun);
    }
}

#ifndef MK_ONE_LAUNCH
#define MK_ONE_LAUNCH 1
#endif
constexpr int N_PHASES = 18;
struct Args { const float* in[15]; float* out; unsigned char* ws; int ph_lo, ph_hi; };
__global__ void __launch_bounds__(NWAVES * 64, 2) mk_fwd(Args args) {
    extern __shared__ __attribute__((aligned(16))) unsigned char lds[];
    Frame F;
    F.lds = (LAS unsigned char*)lds;
    F.MISC = (volatile LAS unsigned*)(F.lds + MISC_OFF);
    F.tid = threadIdx.x; F.lane = F.tid & 63; F.wave = __builtin_amdgcn_readfirstlane(F.tid >> 6);
    F.G = gridDim.x; { const int bx = blockIdx.x; F.vcu = (F.G % 8 == 0) ? (bx % 8) * (F.G / 8) + bx / 8 : bx; }
    F.ws = args.ws; F.ctl = (gu32*)(args.ws + WS_CTL);
    F.x = args.in[0]; F.c = args.in[1]; F.t5 = args.in[2]; F.lbl = args.in[3]; F.ada_w = args.in[4]; F.ada_b = args.in[5]; F.gains = args.in[6];
    F.ab_in = args.in[7]; F.ab_out = args.in[8]; F.hnorm = args.in[9]; F.cd_in = args.in[10]; F.cd_out = args.in[11]; F.qkn = args.in[12]; F.f_in = args.in[13]; F.f_out = args.in[14];
    F.out = args.out;
    for (int u = F.tid; u < (LDS_BYTES - LDSCTL_OFF) / 4; u += NWAVES * 64) ((LAS unsigned*)(F.lds + LDSCTL_OFF))[u] = 0u;
    __syncthreads();
    XcdBarrier bar; bar.bar = (unsigned*)(F.ctl + CW_BAR); bar.x = 0; bar.st = nullptr;
    if (MK_ONE_LAUNCH) bar = xcd_barrier_post((unsigned*)(F.ctl + CW_BAR), F.MISC + 8);
    const int lo = args.ph_lo, hi = args.ph_hi;
#define IN(k) (lo <= (k) && (k) < hi)
#define SEAM(k) do { if (MK_ONE_LAUNCH && IN(k) && IN((k) + 1)) xcd_barrier(bar); } while (0)
    unsigned char* ws = args.ws;
    float* MOD = (float*)(ws + WS_SMALL + SM_MOD);
    bf16* XN = (bf16*)(ws + WS_XN); bf16* YB = (bf16*)(ws + WS_YB); bf16* Z = (bf16*)(ws + WS_Z);
    bf16* H = Z;
    const float* G0 = F.gains; const float* G1 = F.gains + 4 * 1024;
    float* MOD0 = MOD; float* MOD1 = MOD + 2 * 6144;

    if (IN(0)) { p_adaln(F); } SEAM(0);
    if (IN(1)) { p_weights(F); p_rows(F, F.x, nullptr, nullptr, nullptr, nullptr, MOD0, G0, XN); } SEAM(1);
    if (IN(2)) { pg8::Gemm g{XN, (const bf16*)(ws + WS_WINAB), M, 4096, 1024}; pg8::StaticOrder S; S.init(M, 4096, F.G, (int)blockIdx.x);
        pg8::EpiBf16<0> E{Z, 512, nullptr, 512, SEG, 1.0f};
        pg8::gemm_phase<pg8::EpiBf16<0>, pg8::StaticOrder, true, true>(F.lds + RING_OFF, g, S, E); } SEAM(2);
    if (IN(3)) { p_hgrn_naive(F, Z + 3 * SEG, Z + 4 * SEG, Z + 5 * SEG, Z + 6 * SEG, F.out);
                 p_dilated_naive(F, Z, Z + SEG, Z + 2 * SEG, XN); } SEAM(3);
    if (IN(4)) { p_hgrn_final(F, F.out, Z + 7 * SEG, XN); } SEAM(4);
    if (IN(5)) { pg8::Gemm g{XN, (const bf16*)(ws + WS_WOUTAB), M, 1024, 1024}; pg8::StaticOrder S; S.init(M, 1024, F.G, (int)blockIdx.x);
        pg8::EpiBf16<0> E{YB, 1024, nullptr, 0, 0, 1.0f};
        pg8::gemm_phase<pg8::EpiBf16<0>, pg8::StaticOrder, true, true>(F.lds + RING_OFF, g, S, E); } SEAM(5);
    if (IN(6)) { p_rows(F, F.x, YB, MOD0 + 2048, G0 + 1024, F.out, MOD0 + 3072, G0 + 2048, XN); } SEAM(6);
    if (IN(7)) { pg8::Gemm g{XN, (const bf16*)(ws + WS_WF1), M, 2 * FFH, 1024}; pg8::StaticOrder S; S.init(M, 2 * FFH, F.G, (int)blockIdx.x);
        pg8::EpiSwiGLU E{H, FFH};
        pg8::gemm_phase<pg8::EpiSwiGLU, pg8::StaticOrder, true, true>(F.lds + RING_OFF, g, S, E); } SEAM(7);
    if (IN(8)) { pg8::Gemm g{H, (const bf16*)(ws + WS_WF2), M, 1024, FFH}; pg8::StaticOrder S; S.init(M, 1024, F.G, (int)blockIdx.x);
        pg8::EpiBf16<0> E{YB, 1024, nullptr, 0, 0, 1.0f};
        pg8::gemm_phase<pg8::EpiBf16<0>, pg8::StaticOrder, true, true>(F.lds + RING_OFF, g, S, E); } SEAM(8);
    if (IN(9)) { p_rows(F, F.out, YB, MOD0 + 5120, G0 + 3072, F.out, MOD1, G1, XN); } SEAM(9);
    if (IN(10)) { pg8::Gemm g{XN, (const bf16*)(ws + WS_WINCD), M, 1280, 1024}; pg8::StaticOrder S; S.init(M, 1280, F.G, (int)blockIdx.x);
        pg8::EpiBf16<0> E{Z, 512, nullptr, 512, SEG, 1.0f};
        pg8::gemm_phase<pg8::EpiBf16<0>, pg8::StaticOrder, true, true>(F.lds + RING_OFF, g, S, E); } SEAM(10);
    bf16* MIX1 = Z + 4 * SEG;
    float* APR = (float*)(ws + WS_XN); float* API = APR + (size_t)2 * 4 * 128 * 64 * 128;
    if (IN(11)) { p_qkprep(F, Z + SEG, Z + 2 * SEG, 0.125f); p_fnet1_naive(F, Z, APR, API); } SEAM(11);
    if (IN(12)) { p_fnet2_naive(F, APR, API, MIX1); p_gqa_naive(F, Z + SEG, Z + 2 * SEG, MIX1); } SEAM(12);
    if (IN(13)) { pg8::Gemm g{MIX1, (const bf16*)(ws + WS_WOUTCD), M, 1024, 1024}; pg8::StaticOrder S; S.init(M, 1024, F.G, (int)blockIdx.x);
        pg8::EpiBf16<0> E{YB, 1024, nullptr, 0, 0, 1.0f};
        pg8::gemm_phase<pg8::EpiBf16<0>, pg8::StaticOrder, true, true>(F.lds + RING_OFF, g, S, E); } SEAM(13);
    if (IN(14)) { p_rows(F, F.out, YB, MOD1 + 2048, G1 + 1024, F.out, MOD1 + 3072, G1 + 2048, XN); } SEAM(14);
    if (IN(15)) { pg8::Gemm g{XN, (const bf16*)(ws + WS_WF1 + WF1_BYTES), M, 2 * FFH, 1024}; pg8::StaticOrder S; S.init(M, 2 * FFH, F.G, (int)blockIdx.x);
        pg8::EpiSwiGLU E{H, FFH};
        pg8::gemm_phase<pg8::EpiSwiGLU, pg8::StaticOrder, true, true>(F.lds + RING_OFF, g, S, E); } SEAM(15);
    if (IN(16)) { pg8::Gemm g{H, (const bf16*)(ws + WS_WF2 + WF2_BYTES), M, 1024, FFH}; pg8::StaticOrder S; S.init(M, 1024, F.G, (int)blockIdx.x);
        pg8::EpiBf16<0> E{YB, 1024, nullptr, 0, 0, 1.0f};
        pg8::gemm_phase<pg8::EpiBf16<0>, pg8::StaticOrder, true, true>(F.lds + RING_OFF, g, S, E); } SEAM(16);
    if (IN(17)) { p_rows(F, F.out, YB, MOD1 + 5120, G1 + 3072, F.out, nullptr, nullptr, nullptr); }
#undef IN
#undef SEAM
}

extern "C" void kernel_launch(void* const* d_in, const int* in_sizes, int n_in, void* d_out, int out_size, void* d_ws, size_t ws_size, hipStream_t stream) {
    static int grid = 0;
    if (grid == 0) {
        if (n_in != 15 || in_sizes[0] != M * D || out_size != M * D || ws_size < WS_END) { fprintf(stderr, "kernel_launch: unexpected shapes (n_in %d, in0 %d, out %d, ws %zu)\n", n_in, n_in > 0 ? in_sizes[0] : -1, out_size, ws_size); grid = -1; return; }
        int dev = 0, cus = 0;
        if (hipGetDevice(&dev) != hipSuccess || hipDeviceGetAttribute(&cus, hipDeviceAttributeMultiprocessorCount, dev) != hipSuccess) { grid = -1; return; }
        if (hipFuncSetAttribute((const void*)mk_fwd, hipFuncAttributeMaxDynamicSharedMemorySize, LDS_BYTES) != hipSuccess) { fprintf(stderr, "kernel_launch: hipFuncSetAttribute failed\n"); grid = -1; return; }
        (void)hipGetLastError();
        grid = cus;
    }
    if (grid < 0) return;
    if (hipMemsetAsync((char*)d_ws + WS_CTL, 0, CTL_ZERO_BYTES, stream) != hipSuccess) return;
    Args a{};
    for (int i = 0; i < 15; ++i) a.in[i] = (const float*)d_in[i];
    a.out = (float*)d_out; a.ws = (unsigned char*)d_ws;
#if MK_ONE_LAUNCH
    a.ph_lo = 0; a.ph_hi = N_PHASES;
    hipLaunchKernelGGL(mk_fwd, dim3(grid), dim3(NWAVES * 64), LDS_BYTES, stream, a);
#else
    for (int p = 0; p < N_PHASES; ++p) { a.ph_lo = p; a.ph_hi = p + 1; hipLaunchKernelGGL(mk_fwd, dim3(grid), dim3(NWAVES * 64), LDS_BYTES, stream, a); }
#endif
}
```

```cpp
#include <hip/hip_runtime.h>
#include <cstdio>
#include <cstdint>
namespace pg8 {
#define PG8_LAS __attribute__((address_space(3)))
typedef unsigned short bf16_t;
typedef short bf16x8 __attribute__((ext_vector_type(8)));
typedef float f32x4 __attribute__((ext_vector_type(4)));
typedef unsigned u32x4 __attribute__((ext_vector_type(4)));
constexpr int BM = 256, BK = 64, HALF = 128, HTB = HALF * BK * 2  , STAGE_BYTES = 8 * HTB, NXCD = 8, WGM = 8;

__host__ __device__ __forceinline__ int lds_byte(int r, int c) { const int st = (r >> 4) * 2 + (c >> 5), rr = r & 15, cc = c & 31, ob = rr * 64 + cc * 2; return st * 1024 + (ob ^ (((ob >> 9) & 1) << 5)); }
__host__ __device__ __forceinline__ void stage_rc(int b, int& R, int& C) { const int st = b / 1024, sb = b % 1024, swz = sb ^ (((sb >> 9) & 1) << 5); R = (st >> 1) * 16 + swz / 64; C = (st & 1) * 32 + (swz % 64) / 2; }
__host__ __device__ __forceinline__ int perm32(int rho) { const int n = rho >> 4, i = rho & 15; return 8 * (i >> 2) + 4 * n + (i & 3); }

struct Unit { int pm, pn; };
struct Gemm { const bf16_t* A; const bf16_t* Bt; int M, N, K; };

struct StaticOrder {
    int nM, nN, nwg, G, c;
    __host__ __device__ void init(int M, int N, int G_, int c_) { nM = M / BM; nN = N / BM; nwg = nM * nN; G = G_; c = c_; }
    __host__ __device__ bool next(int i, Unit& u) const {
        const long L = (long)i * G + c; if (L >= nwg) return false;
        int wgid = (int)L; { const int q = nwg / NXCD, r = nwg % NXCD, xcd = wgid % NXCD, off = wgid / NXCD; wgid = (xcd < r ? xcd * (q + 1) : r * (q + 1) + (xcd - r) * q) + off; }
        const int nig = WGM * nN, gid = wgid / nig, fm = gid * WGM, gsz = (nM - fm) < WGM ? (nM - fm) : WGM;
        u.pm = fm + ((wgid % nig) % gsz); u.pn = (wgid % nig) / gsz; return true;
    }
    __device__ __forceinline__ void a_ready(const Unit&) const {}
    __device__ __forceinline__ void done(const Unit&) const {}
};

__device__ __forceinline__ unsigned cvt_pk_bf16(float lo, float hi) { unsigned r; asm volatile("v_cvt_pk_bf16_f32 %0, %1, %2" : "=v"(r) : "v"(lo), "v"(hi)); return r; }
typedef float f32x2 __attribute__((ext_vector_type(2)));
__device__ __forceinline__ f32x2 gelu_pk(f32x2 v) {
    const f32x2 av = __builtin_elementwise_abs(v), d = av * 0.2316418882f + 1.0f;
    f32x2 t; t.x = __builtin_amdgcn_rcpf(d.x); t.y = __builtin_amdgcn_rcpf(d.y);
    f32x2 q = t * 0.5307027145f + (-0.7265760135f); q = q * t + 0.7107068705f; q = q * t + (-0.142248368f); q = q * t + 0.127414796f; q = q * t;
    const f32x2 s = (v * v) * (-0.72134752044f);
    f32x2 e; e.x = __builtin_amdgcn_exp2f(s.x); e.y = __builtin_amdgcn_exp2f(s.y);
    const f32x2 m = v * (q * e), r = v - m;
    f32x2 o; o.x = v.x < 0.f ? m.x : r.x; o.y = v.y < 0.f ? m.y : r.y; return o;
}

template <int ACT  > struct EpiBf16 {
    static constexpr bool PERM = true, AFTER_DRAIN = false; static_assert(ACT == 0 || ACT == 1, "EpiBf16: ACT is 0 (none) or 1 (gelu_pk)");
    bf16_t* O; int ldc; const float* bias; int split_cols; size_t split_stride; float scale0;
    __device__ __forceinline__ void operator()(const f32x4 (&acc)[2][2][4][2], const Unit& u, int wr, int wc, int fr, int fq) const {
        const int row0 = u.pm * BM + wr * 64 + fr; int colt = u.pn * BM; bf16_t* base = O;
        float sc = 1.f; if (split_cols) { const int t = colt / split_cols; base += (size_t)t * split_stride; colt -= t * split_cols; if (t == 0) sc = scale0; }
        const int col0 = colt + wc * 32 + 8 * fq, bcol0 = u.pn * BM + wc * 32 + 8 * fq;
        f32x4 bv[2][2];
#pragma unroll
        for (int bj = 0; bj < 2; ++bj)
#pragma unroll
            for (int n = 0; n < 2; ++n) bv[bj][n] = bias ? *(const f32x4*)(bias + bcol0 + bj * HALF + 4 * n) : (f32x4){0.f, 0.f, 0.f, 0.f};
#pragma unroll
        for (int ai = 0; ai < 2; ++ai)
#pragma unroll
            for (int m = 0; m < 4; ++m) { bf16_t* rowp = base + (size_t)(row0 + ai * HALF + m * 16) * ldc + col0;
#pragma unroll
                for (int bj = 0; bj < 2; ++bj) { f32x4 v0 = acc[ai][bj][m][0] + bv[bj][0], v1 = acc[ai][bj][m][1] + bv[bj][1];
                    if (ACT == 1) { f32x2 a = gelu_pk((f32x2){v0[0], v0[1]}), b = gelu_pk((f32x2){v0[2], v0[3]}), c = gelu_pk((f32x2){v1[0], v1[1]}), d = gelu_pk((f32x2){v1[2], v1[3]});
                        v0 = (f32x4){a.x, a.y, b.x, b.y}; v1 = (f32x4){c.x, c.y, d.x, d.y}; }
                    v0 = v0 * sc; v1 = v1 * sc; u32x4 w; w.x = cvt_pk_bf16(v0[0], v0[1]); w.y = cvt_pk_bf16(v0[2], v0[3]); w.z = cvt_pk_bf16(v1[0], v1[1]); w.w = cvt_pk_bf16(v1[2], v1[3]);
                    *(u32x4*)(rowp + bj * HALF) = w; } }
    }
};
template <class Epi, class Sched, bool ALIGN_EPI = false, bool SP2 = false>
__device__ __forceinline__ void gemm_phase(PG8_LAS unsigned char* lds, const Gemm g, const Sched& S, const Epi& E) {
    const int tid = threadIdx.x, wid = __builtin_amdgcn_readfirstlane(tid >> 6), lane = tid & 63, wr = wid >> 2, wc = wid & 3, fr = lane & 15, fq = lane >> 4;
    const int K = g.K, nt = K / BK;
    unsigned voffA[2], voffB[2];
#pragma unroll
    for (int i = 0; i < 2; ++i) { int R, C; stage_rc(tid * 16 + i * 8192, R, C); const int Rb = Epi::PERM ? ((R & ~31) + perm32(R & 31)) : R;
        voffA[i] = (unsigned)(R * K + C) * 2u; voffB[i] = (unsigned)(Rb * K + C) * 2u; }
    const size_t kstep = (size_t)(BK * 2);
    const size_t hstep = (size_t)HALF * K * 2;
    const size_t tstep = 2 * hstep;
    const unsigned ldsw = (unsigned)wid * 1024u;
    const int aoff = lds_byte(wr * 64 + fr, fq * 8), boff = lds_byte(wc * 32 + fr, fq * 8);
#define PG8_SA(b, h) (((b) * 2 + (h)) * HTB)
#define PG8_SB(b, h) ((4 + (b) * 2 + (h)) * HTB)
#define PG8_STAGE(bufoff, gbase, voff) do { _Pragma("unroll") for (int _i = 0; _i < 2; ++_i) \
        __builtin_amdgcn_global_load_lds((const unsigned*)((const char*)(gbase) + (voff)[_i]), (PG8_LAS unsigned*)(lds + (bufoff) + ldsw + _i * 8192), 16, 0, 0); } while (0)
#define PG8_LDA(dst, b, h) do { _Pragma("unroll") for (int m = 0; m < 4; ++m) _Pragma("unroll") for (int k = 0; k < 2; ++k) dst[m][k] = *(const PG8_LAS bf16x8*)(lds + PG8_SA(b, h) + aoff + m * 2048 + k * 1024); } while (0)
#define PG8_LDB(dst, b, h) do { _Pragma("unroll") for (int n = 0; n < 2; ++n) _Pragma("unroll") for (int k = 0; k < 2; ++k) dst[n][k] = *(const PG8_LAS bf16x8*)(lds + PG8_SB(b, h) + boff + n * 2048 + k * 1024); } while (0)
#define PG8_MMA(ai, bj, At, Bt) do { __builtin_amdgcn_s_setprio(1); _Pragma("unroll") for (int m = 0; m < 4; ++m) _Pragma("unroll") for (int n = 0; n < 2; ++n) _Pragma("unroll") for (int k = 0; k < 2; ++k) \
        acc[ai][bj][m][n] = __builtin_amdgcn_mfma_f32_16x16x32_bf16(Bt[n][k], At[m][k], acc[ai][bj][m][n], 0, 0, 0); __builtin_amdgcn_s_setprio(0); } while (0)
#define PG8_WAIT_V(n) asm volatile("s_waitcnt vmcnt(" #n ")" ::: "memory")
#define PG8_WAIT_L(n) asm volatile("s_waitcnt lgkmcnt(" #n ")" ::: "memory")
#define PG8_BAR __builtin_amdgcn_s_barrier()
#define PG8_SCHED __builtin_amdgcn_sched_barrier(0)
    Unit cur, nxt; int ui = 0;
    if (!S.next(0, cur)) return;
    f32x4 acc[2][2][4][2];
#pragma unroll
    for (int a = 0; a < 2; ++a)
#pragma unroll
        for (int b = 0; b < 2; ++b)
#pragma unroll
            for (int m = 0; m < 4; ++m)
#pragma unroll
                for (int n = 0; n < 2; ++n) acc[a][b][m][n] = (f32x4){0.f, 0.f, 0.f, 0.f};
    bf16x8 At[4][2], B0[2][2], B1[2][2];
    const char* cA = (const char*)g.A + (size_t)cur.pm * tstep; const char* cB = (const char*)g.Bt + (size_t)cur.pn * tstep;
    S.a_ready(cur);
    if constexpr (SP2) {
        PG8_STAGE(PG8_SB(0, 0), cB, voffB); PG8_STAGE(PG8_SB(0, 1), cB + hstep, voffB); PG8_STAGE(PG8_SA(0, 0), cA, voffA); PG8_STAGE(PG8_SA(0, 1), cA + hstep, voffA);
        if (wr == 1) PG8_BAR;
        PG8_WAIT_V(2); PG8_BAR;
        PG8_STAGE(PG8_SB(1, 0), cB + kstep, voffB); PG8_STAGE(PG8_SA(1, 0), cA + kstep, voffA); PG8_STAGE(PG8_SB(1, 1), cB + hstep + kstep, voffB);
        PG8_WAIT_V(6); PG8_BAR;
    } else {
        PG8_STAGE(PG8_SB(0, 0), cB, voffB); PG8_STAGE(PG8_SA(0, 0), cA, voffA); PG8_STAGE(PG8_SB(0, 1), cB + hstep, voffB); PG8_STAGE(PG8_SA(0, 1), cA + hstep, voffA);
        if (wr == 1) PG8_BAR;
        PG8_WAIT_V(4); PG8_BAR;
        PG8_STAGE(PG8_SB(1, 0), cB + kstep, voffB); PG8_STAGE(PG8_SA(1, 0), cA + kstep, voffA); PG8_STAGE(PG8_SB(1, 1), cB + hstep + kstep, voffB);
        PG8_WAIT_V(6); PG8_BAR;
    }
    for (;;) {
        const bool has_next = S.next(ui + 1, nxt);
        const char* nA = has_next ? (const char*)g.A + (size_t)nxt.pm * tstep : cA; const char* nB = has_next ? (const char*)g.Bt + (size_t)nxt.pn * tstep : cB;
        for (int t = 0; t < nt; t += 2) {
            const bool last = (t == nt - 2);
            const char* a1 = cA + (size_t)(t + 1) * kstep;
            const char* a2 = last ? nA : cA + (size_t)(t + 2) * kstep; const char* b2 = last ? nB : cB + (size_t)(t + 2) * kstep;
            const char* a3 = a2 + kstep; const char* b3 = b2 + kstep;
            if (last && has_next) S.a_ready(nxt);
            if constexpr (SP2) {
            PG8_LDB(B0, 0, 0); PG8_LDB(B1, 0, 1); PG8_SCHED; PG8_LDA(At, 0, 0); PG8_STAGE(PG8_SA(1, 1), a1 + hstep, voffA);
            PG8_WAIT_V(8); PG8_WAIT_L(0); PG8_BAR; PG8_MMA(0, 0, At, B0); PG8_MMA(0, 1, At, B1); PG8_BAR; PG8_SCHED;
            PG8_LDA(At, 0, 1); PG8_STAGE(PG8_SB(0, 0), b2, voffB); PG8_STAGE(PG8_SB(0, 1), b2 + hstep, voffB); PG8_STAGE(PG8_SA(0, 0), a2, voffA);
            PG8_WAIT_V(8); PG8_WAIT_L(0); PG8_BAR; PG8_MMA(1, 0, At, B0); PG8_MMA(1, 1, At, B1); PG8_BAR; PG8_SCHED;
            PG8_LDB(B0, 1, 0); PG8_LDB(B1, 1, 1); PG8_SCHED; PG8_LDA(At, 1, 0); PG8_STAGE(PG8_SA(0, 1), a2 + hstep, voffA);
            PG8_WAIT_V(8); PG8_WAIT_L(0); PG8_BAR; PG8_MMA(0, 0, At, B0); PG8_MMA(0, 1, At, B1); PG8_BAR; PG8_SCHED;
            PG8_LDA(At, 1, 1); PG8_STAGE(PG8_SB(1, 0), b3, voffB); PG8_STAGE(PG8_SB(1, 1), b3 + hstep, voffB); PG8_STAGE(PG8_SA(1, 0), a3, voffA);
            PG8_WAIT_V(8); PG8_WAIT_L(0); PG8_BAR; PG8_MMA(1, 0, At, B0); PG8_MMA(1, 1, At, B1); PG8_BAR; PG8_SCHED;
            } else {
            PG8_LDB(B0, 0, 0); PG8_SCHED; PG8_LDA(At, 0, 0); PG8_STAGE(PG8_SA(1, 1), a1 + hstep, voffA);
            PG8_WAIT_L(8); PG8_BAR; PG8_WAIT_L(0); PG8_MMA(0, 0, At, B0); PG8_BAR; PG8_SCHED;
            PG8_LDB(B1, 0, 1); PG8_STAGE(PG8_SB(0, 0), b2, voffB);
            PG8_BAR; PG8_WAIT_L(0); PG8_MMA(0, 1, At, B1); PG8_BAR;
            PG8_LDA(At, 0, 1); PG8_STAGE(PG8_SA(0, 0), a2, voffA);
            PG8_BAR; PG8_WAIT_L(0); PG8_MMA(1, 0, At, B0); PG8_BAR; PG8_SCHED;
            PG8_STAGE(PG8_SB(0, 1), b2 + hstep, voffB);
            PG8_WAIT_V(6); PG8_BAR; PG8_MMA(1, 1, At, B1); PG8_BAR;
            PG8_LDB(B0, 1, 0); PG8_SCHED; PG8_LDA(At, 1, 0); PG8_STAGE(PG8_SA(0, 1), a2 + hstep, voffA);
            PG8_WAIT_L(8); PG8_BAR; PG8_WAIT_L(0); PG8_MMA(0, 0, At, B0); PG8_BAR; PG8_SCHED;
            PG8_LDB(B1, 1, 1); PG8_STAGE(PG8_SB(1, 0), b3, voffB);
            PG8_BAR; PG8_WAIT_L(0); PG8_MMA(0, 1, At, B1); PG8_BAR;
            PG8_LDA(At, 1, 1); PG8_STAGE(PG8_SA(1, 0), a3, voffA);
            PG8_BAR; PG8_WAIT_L(0); PG8_MMA(1, 0, At, B0); PG8_BAR; PG8_SCHED;
            PG8_STAGE(PG8_SB(1, 1), b3 + hstep, voffB);
            PG8_WAIT_V(6); PG8_BAR; PG8_MMA(1, 1, At, B1); PG8_BAR;
            }
        }
        if constexpr (ALIGN_EPI) { if (wr == 0) PG8_BAR; }
        if constexpr (!Epi::AFTER_DRAIN) { E(acc, cur, wr, wc, fr, fq); S.done(cur); }
        if (!has_next) break;
#pragma unroll
        for (int a = 0; a < 2; ++a)
#pragma unroll
            for (int b = 0; b < 2; ++b)
#pragma unroll
                for (int m = 0; m < 4; ++m)
#pragma unroll
                    for (int n = 0; n < 2; ++n) acc[a][b][m][n] = (f32x4){0.f, 0.f, 0.f, 0.f};
        cur = nxt; cA = nA; cB = nB; ++ui;
        if constexpr (ALIGN_EPI) { if (wr == 1) PG8_BAR; }
    }
    PG8_WAIT_V(0);
    if constexpr (!ALIGN_EPI) { if (wr == 0) PG8_BAR; }
    PG8_BAR;
    if constexpr (Epi::AFTER_DRAIN) { E.fused(acc, cur, wr, wc, fr, fq, lds, wid, lane); S.done(cur); }
#undef PG8_SA
#undef PG8_SB
#undef PG8_STAGE
#undef PG8_LDA
#undef PG8_LDB
#undef PG8_MMA
#undef PG8_WAIT_V
#undef PG8_WAIT_L
#undef PG8_BAR
#undef PG8_SCHED
}
}
#include <hip/hip_bf16.h>
#include <cmath>
namespace attn_body {
using bf16=__hip_bfloat16;
using bf16x8=__attribute__((ext_vector_type(8)))short;
using s16x4=__attribute__((ext_vector_type(4)))short;
using f32x16=__attribute__((ext_vector_type(16)))float;
using u32x4=__attribute__((ext_vector_type(4)))unsigned;
constexpr int BATCH=2,NHEAD=8,NKVH=2,SEQ=8192,D=64,QP=512,KP=512,VP=512,OP=1024;
constexpr int NW=8,QBLK=32,QB=QBLK*NW,KVBLK=64,NQB=SEQ/QB;
constexpr int ATTN_UNIT_ROWS=QB;
__device__ __forceinline__ int crow(int r,int hi){return (r&3)+8*(r>>2)+4*hi;}
#define SBAR() __builtin_amdgcn_sched_barrier(0)
__device__ __forceinline__ void cmask(f32x16&p0,f32x16&p1,int jb,int qrel,int hi){
  const float NEG=-INFINITY; int kb=64*jb+4*hi;
  #pragma unroll
  for(int r=0;r<16;++r){int kv=kb+(r&3)+8*(r>>2); if(kv>qrel)p0[r]=NEG; if(kv+32>qrel)p1[r]=NEG;}
}

constexpr int NSLOT=3, SLOTB=8192;
constexpr int LDS_K=0, LDS_V=NSLOT*SLOTB, LDS_WS=2*NSLOT*SLOTB, LDS_OST=LDS_WS+NW*64*4, LDS_BYTES=LDS_OST+NW*4096;
constexpr float C2=0.125f*1.4426950408889634f;
__device__ __forceinline__ void glds16(const void*gsrc,unsigned lds_dst){unsigned keep;
  asm volatile("s_mov_b32 %0, m0\n\ts_mov_b32 m0, %2\n\ts_nop 0\n\tglobal_load_lds_dwordx4 %1, off\n\ts_mov_b32 m0, %0":"=&s"(keep):"v"(gsrc),"s"(lds_dst):"memory");}
__device__ __forceinline__ float max3f(float a,float b,float c){float r;asm("v_max3_f32 %0, %1, %2, %3":"=v"(r):"v"(a),"v"(b),"v"(c));return r;}
__device__ __forceinline__ float max2f(float a,float b){float r;asm("v_max_f32_e32 %0, %1, %2":"=v"(r):"v"(a),"v"(b));return r;}
__device__ __forceinline__ float fadd_s(float a,float b){float r;asm("v_add_f32_e32 %0, %1, %2":"=v"(r):"v"(a),"v"(b));return r;}
__device__ __forceinline__ float fsub_s(float a,float b){float r;asm("v_sub_f32_e32 %0, %1, %2":"=v"(r):"v"(a),"v"(b));return r;}
typedef float f32x2_t __attribute__((ext_vector_type(2))); typedef __bf16 bf16x2_t __attribute__((ext_vector_type(2)));
__device__ __forceinline__ unsigned cvtpk_s(float lo,float hi){f32x2_t v={lo,hi};bf16x2_t b=__builtin_convertvector(v,bf16x2_t);return __builtin_bit_cast(unsigned,b);}
#define WAIT_BAR(N) asm volatile("s_waitcnt vmcnt(" #N ") lgkmcnt(0)\n\ts_barrier":::"memory")

__device__ __forceinline__ void qkt(f32x16&p0,f32x16&p1,const char*Kslot,const bf16x8*qr,const f32x16&negm,int r32,int hi){
  const char*kb=Kslot+hi*1024+r32*16;
  #pragma unroll
  for(int d0=0;d0<4;++d0){
    const bf16x8 b0=*reinterpret_cast<const bf16x8*>(kb+d0*2048);
    const bf16x8 b1=*reinterpret_cast<const bf16x8*>(kb+d0*2048+512);
    if(d0==0){p0=__builtin_amdgcn_mfma_f32_32x32x16_bf16(b0,qr[0],negm,0,0,0);p1=__builtin_amdgcn_mfma_f32_32x32x16_bf16(b1,qr[0],negm,0,0,0);}
    else{p0=__builtin_amdgcn_mfma_f32_32x32x16_bf16(b0,qr[d0],p0,0,0,0);p1=__builtin_amdgcn_mfma_f32_32x32x16_bf16(b1,qr[d0],p1,0,0,0);}}
}
typedef __attribute__((address_space(3))) const char* lds_cptr;
typedef short v4i16_t __attribute__((ext_vector_type(4)));
__device__ __forceinline__ void kload8(bf16x8*kf,lds_cptr kp){
  kf[0]=*(const __attribute__((address_space(3))) bf16x8*)(kp);      kf[1]=*(const __attribute__((address_space(3))) bf16x8*)(kp+512);
  kf[2]=*(const __attribute__((address_space(3))) bf16x8*)(kp+2048); kf[3]=*(const __attribute__((address_space(3))) bf16x8*)(kp+2560);
  kf[4]=*(const __attribute__((address_space(3))) bf16x8*)(kp+4096); kf[5]=*(const __attribute__((address_space(3))) bf16x8*)(kp+4608);
  kf[6]=*(const __attribute__((address_space(3))) bf16x8*)(kp+6144); kf[7]=*(const __attribute__((address_space(3))) bf16x8*)(kp+6656);
}
__device__ __forceinline__ void kload2(bf16x8*kf,lds_cptr kp,int j){ kf[2*j]=*(const __attribute__((address_space(3))) bf16x8*)(kp+j*2048); kf[2*j+1]=*(const __attribute__((address_space(3))) bf16x8*)(kp+j*2048+512); }
__device__ __forceinline__ s16x4 vtr(lds_cptr p){ return __builtin_bit_cast(s16x4,__builtin_amdgcn_ds_read_tr16_b64_v4i16((__attribute__((address_space(3))) v4i16_t*)p)); }
__device__ __forceinline__ float rowmax(const f32x16&p0,const f32x16&p1){
  float a=max3f(p0[0],p0[1],p1[0]),b=max3f(p0[2],p0[3],p1[1]);a=max3f(a,p1[2],p1[3]);
  #pragma unroll
  for(int r=4;r<16;r+=4){a=max3f(a,p0[r],p0[r+1]);b=max3f(b,p0[r+2],p0[r+3]);a=max3f(a,p1[r],p1[r+1]);b=max3f(b,p1[r+2],p1[r+3]);}
  const float m=max2f(a,b);
  auto rr=__builtin_amdgcn_permlane32_swap(__float_as_uint(m),__float_as_uint(m),false,false);
  return max2f(__uint_as_float(rr[0]),__uint_as_float(rr[1]));
}
__device__ __forceinline__ void pv(f32x16*o,int vb,bf16x8 pa0,bf16x8 pa1,bf16x8 pa2,bf16x8 pa3){
  #pragma unroll
  for(int d0=0;d0<2;++d0){s16x4 lo[4],hi[4];
    #pragma unroll
    for(int ks=0;ks<4;++ks){
      asm volatile("ds_read_b64_tr_b16 %0,%1 offset:%c2":"=&v"(lo[ks]):"v"(vb),"i"(d0*4096+ks*1024):"memory");
      asm volatile("ds_read_b64_tr_b16 %0,%1 offset:%c2":"=&v"(hi[ks]):"v"(vb),"i"(d0*4096+ks*1024+512):"memory");}
    asm volatile("s_waitcnt lgkmcnt(0)":::"memory");SBAR();
    #define PK(k) (bf16x8){lo[k][0],lo[k][1],lo[k][2],lo[k][3],hi[k][0],hi[k][1],hi[k][2],hi[k][3]}
    o[d0]=__builtin_amdgcn_mfma_f32_32x32x16_bf16(pa0,PK(0),o[d0],0,0,0);
    o[d0]=__builtin_amdgcn_mfma_f32_32x32x16_bf16(pa1,PK(1),o[d0],0,0,0);
    o[d0]=__builtin_amdgcn_mfma_f32_32x32x16_bf16(pa2,PK(2),o[d0],0,0,0);
    o[d0]=__builtin_amdgcn_mfma_f32_32x32x16_bf16(pa3,PK(3),o[d0],0,0,0);
    #undef PK
  }
}

#ifndef ATTN_STORE16
#define ATTN_STORE16(p,v) (*(u32x4*)(p)=(v))
#endif
template<int THRL> __device__ __forceinline__ void attn_unit(int b,int h,int qb,const bf16*Q,const bf16*__restrict__ K,const bf16*__restrict__ V,bf16*O,char*shm){
  const int tid=threadIdx.x,lane=tid&63,r32=lane&31,hi=lane>>5; const int wid=__builtin_amdgcn_readfirstlane(tid>>6);
  const long rowbase=(long)b*SEQ; const int q0=qb*QB;
  const bf16*Qw=Q+(rowbase+q0+wid*QBLK)*QP+h*D; const int hk=h>>2;
  const bf16*Kh=K+rowbase*KP+hk*D,*Vh=V+rowbase*VP+hk*D;
  const unsigned lds0=(unsigned)(uintptr_t)shm;
  float*wsf=(float*)(shm+LDS_WS)+wid*64;
  const bf16*ksrc=Kh+(long)lane*KP+wid*8;
  const bf16*vsrc=Vh+(long)(16*(wid&3)+(lane>>2))*VP+(wid>>2)*32+(lane&3)*8;
  const unsigned kdst=lds0+LDS_K+wid*1024, vdst=lds0+LDS_V+wid*1024;
  #define DMA_K(t,slot) glds16(ksrc+(long)(t)*KVBLK*KP,(unsigned)__builtin_amdgcn_readfirstlane(kdst+(slot)))
  #define DMA_V(t,slot) glds16(vsrc+(long)(t)*KVBLK*VP,(unsigned)__builtin_amdgcn_readfirstlane(vdst+(slot)))
  const int vb0=(int)(lds0+LDS_V)+((lane>>4)&1)*32+(lane&3)*8+(4*hi+((lane&15)>>2))*64;
  const char*Kbase=shm+LDS_K; bf16x8 kf[8];
  const lds_cptr shm3=(lds_cptr)shm; const lds_cptr kp0=shm3+LDS_K+hi*1024+r32*16; const lds_cptr vp0=shm3+LDS_V+((lane>>4)&1)*32+(lane&3)*8+(4*hi+((lane&15)>>2))*64;
  const int NT=SEQ/KVBLK;
  DMA_K(0,0);DMA_V(0,0);DMA_K(1,SLOTB);
  bf16x8 qr[4];
  #pragma unroll
  for(int d0=0;d0<4;++d0)qr[d0]=*reinterpret_cast<const bf16x8*>(&Qw[(long)r32*QP+d0*16+hi*8]);
  float mhat=0.f,l_reg=0.f;f32x16 o[2];o[0]=f32x16{};o[1]=f32x16{};f32x16 negm=f32x16{};asm volatile("":"+v"(negm));

  #define CMASK(P0,P1,t) do{}while(0)
  bool resc=false;
  #define START(P0,P1) do{ const float rm=rowmax(P0,P1); resc=false; \
    { const float dl=rm; mhat=fadd_s(mhat,dl); \
      _Pragma("unroll") for(int r=0;r<16;++r){P0[r]=fsub_s(P0[r],dl);P1[r]=fsub_s(P1[r],dl);} \
      _Pragma("unroll") for(int r=0;r<16;++r)negm[r]=-mhat; asm volatile("":"+v"(negm)); } \
    _Pragma("unroll") for(int r=0;r<16;++r)P0[r]=__builtin_amdgcn_exp2f(P0[r]); }while(0)
  #define RESC() do{ if(resc){ asm volatile("s_waitcnt lgkmcnt(0)":::"memory"); \
      _Pragma("unroll") for(int d_=0;d_<2;++d_) _Pragma("unroll") for(int r=0;r<16;++r)o[d_][r]*=wsf[crow(r,hi)]; } }while(0)
  f32x16 pA0,pA1,pB0,pB1;
  int sl_prev=0,sl_cur=0,sl_next=SLOTB;
  #define ROT() do{sl_prev=sl_cur;sl_cur=sl_next;sl_next=(sl_next==(NSLOT-1)*SLOTB)?0:sl_next+SLOTB;}while(0)
  DMA_K(2,2*SLOTB);
  WAIT_BAR(3);
  qkt(pA0,pA1,Kbase,qr,negm,r32,hi);asm volatile("s_nop 15\n\ts_nop 7":"+v"(pA0),"+v"(pA1));CMASK(pA0,pA1,0);
  START(pA0,pA1);
  _Pragma("unroll") for(int r=0;r<16;++r)pA1[r]=__builtin_amdgcn_exp2f(pA1[r]);
  WAIT_BAR(0);
  DMA_K(3,0);DMA_V(1,SLOTB);
  ROT();
  kload8(kf,kp0+sl_cur);
  WAIT_BAR(2);
  s16x4 vlo[8],vhi[8]; u32x4 pw0,pw1,pw2,pw3;
  #define PKW(P,B) cvtpk_s(P[B],P[B+1])
  #define PAF(k) __builtin_bit_cast(bf16x8,pw##k)
  #define VFR(i) (bf16x8){vlo[i][0],vlo[i][1],vlo[i][2],vlo[i][3],vhi[i][0],vhi[i][1],vhi[i][2],vhi[i][3]}
  #define PIN(x) asm volatile("":"+v"(x))
  #define MX3(a,b,c) __builtin_fmaxf(__builtin_fmaxf((a),(b)),(c))
  #define GAPA(MF,A0,A1,A2,A3,W0,W1,PW) do{ MF; sacc+=A0; sacc+=A1; sacc+=A2; sacc+=A3; PIN(sacc); W0; W1; PIN(PW); SBAR(); }while(0)
  #define EX(v) __builtin_amdgcn_exp2f(v)
  #define GAPB(MF,X,B) do{ MF; X[B]=EX(X[B]); X[B+1]=EX(X[B+1]); X[B+2]=EX(X[B+2]); X[B+3]=EX(X[B+3]); PIN(X); SBAR(); }while(0)
  #define VRD(i) do{ vlo[i]=vtr(vp_+(((i)>>2)*4096+((i)&3)*1024)); vhi[i]=vtr(vp_+(((i)>>2)*4096+((i)&3)*1024+512)); }while(0)
  #define KRD(G,j) do{ if(G){ kload2(kf,kp0+sl_next,j); SBAR(); } }while(0)
  #define STEP(C0,C1,P0,P1,t,GK,GV,GL) do{ SBAR(); \
    const lds_cptr vp_=vp0+sl_prev; \
    VRD(0); SBAR(); float sacc=(P0[0]+P0[1]); \
    GAPA(C0=__builtin_amdgcn_mfma_f32_32x32x16_bf16(kf[0],qr[0],negm,0,0,0), P0[2],P0[3],P0[4],P0[5],     pw0[0]=PKW(P0,0), pw0[1]=PKW(P0,2), pw0); \
    VRD(4); SBAR(); GAPA(C1=__builtin_amdgcn_mfma_f32_32x32x16_bf16(kf[1],qr[0],negm,0,0,0), P0[6],P0[7],P0[8],P0[9],     pw0[2]=PKW(P0,4), pw0[3]=PKW(P0,6), pw0); \
    VRD(1); SBAR(); GAPA(C0=__builtin_amdgcn_mfma_f32_32x32x16_bf16(kf[2],qr[1],C0,0,0,0),   P0[10],P0[11],P0[12],P0[13], pw1[0]=PKW(P0,8), pw1[1]=PKW(P0,10), pw1); \
    VRD(5); SBAR(); GAPA(C1=__builtin_amdgcn_mfma_f32_32x32x16_bf16(kf[3],qr[1],C1,0,0,0),   P0[14],P0[15],P1[0],P1[1],   pw1[2]=PKW(P0,12),pw1[3]=PKW(P0,14), pw1); \
    VRD(2); SBAR(); GAPA(C0=__builtin_amdgcn_mfma_f32_32x32x16_bf16(kf[4],qr[2],C0,0,0,0),   P1[2],P1[3],P1[4],P1[5],     pw2[0]=PKW(P1,0), pw2[1]=PKW(P1,2), pw2); \
    VRD(6); SBAR(); GAPA(C1=__builtin_amdgcn_mfma_f32_32x32x16_bf16(kf[5],qr[2],C1,0,0,0),   P1[6],P1[7],P1[8],P1[9],     pw2[2]=PKW(P1,4), pw2[3]=PKW(P1,6), pw2); \
    VRD(3); SBAR(); GAPA(C0=__builtin_amdgcn_mfma_f32_32x32x16_bf16(kf[6],qr[3],C0,0,0,0),   P1[10],P1[11],P1[12],P1[13], pw3[0]=PKW(P1,8), pw3[1]=PKW(P1,10), pw3); \
    VRD(7); SBAR(); GAPA(C1=__builtin_amdgcn_mfma_f32_32x32x16_bf16(kf[7],qr[3],C1,0,0,0),   P1[14],P1[15],0.f,0.f,       pw3[2]=PKW(P1,12),pw3[3]=PKW(P1,14), pw3); \
    l_reg+=sacc; \
    if(GK){DMA_K((t)+3,sl_cur);} if(GV){DMA_V((t)+1,sl_next);} \
    CMASK(C0,C1,t); \
    { float a=MX3(C0[0],C0[1],C1[0]),b=MX3(C0[2],C0[3],C1[1]); a=MX3(a,C1[2],C1[3]); \
      _Pragma("unroll") for(int r=4;r<16;r+=4){a=MX3(a,C0[r],C0[r+1]);b=MX3(b,C0[r+2],C0[r+3]);a=MX3(a,C1[r],C1[r+1]);b=MX3(b,C1[r+2],C1[r+3]);} \
      float rm=__builtin_fmaxf(a,b); { auto rr=__builtin_amdgcn_permlane32_swap(__float_as_uint(rm),__float_as_uint(rm),false,false); rm=__builtin_fmaxf(__uint_as_float(rr[0]),__uint_as_float(rr[1])); } \
      resc=false; \
      if(__builtin_expect(__any(rm>(float)THRL),0)){ const float dl=__builtin_fmaxf(rm,0.f); mhat+=dl; \
        _Pragma("unroll") for(int r=0;r<16;++r){C0[r]-=dl;C1[r]-=dl;} \
        _Pragma("unroll") for(int r=0;r<16;++r)negm[r]=-mhat; asm volatile("":"+v"(negm)); \
        const float f=__builtin_amdgcn_exp2f(-dl); l_reg*=f; if(hi==0)wsf[r32]=f; resc=true; } } \
    SBAR(); \
    GAPB(o[0]=__builtin_amdgcn_mfma_f32_32x32x16_bf16(PAF(0),VFR(0),o[0],0,0,0), C0,0); \
    GAPB(o[1]=__builtin_amdgcn_mfma_f32_32x32x16_bf16(PAF(0),VFR(4),o[1],0,0,0), C0,4); \
    KRD(GL,0); GAPB(o[0]=__builtin_amdgcn_mfma_f32_32x32x16_bf16(PAF(1),VFR(1),o[0],0,0,0), C0,8); \
    KRD(GL,1); GAPB(o[1]=__builtin_amdgcn_mfma_f32_32x32x16_bf16(PAF(1),VFR(5),o[1],0,0,0), C0,12); \
    KRD(GL,2); GAPB(o[0]=__builtin_amdgcn_mfma_f32_32x32x16_bf16(PAF(2),VFR(2),o[0],0,0,0), C1,0); \
    KRD(GL,3); GAPB(o[1]=__builtin_amdgcn_mfma_f32_32x32x16_bf16(PAF(2),VFR(6),o[1],0,0,0), C1,4); \
    GAPB(o[0]=__builtin_amdgcn_mfma_f32_32x32x16_bf16(PAF(3),VFR(3),o[0],0,0,0), C1,8); \
    GAPB(o[1]=__builtin_amdgcn_mfma_f32_32x32x16_bf16(PAF(3),VFR(7),o[1],0,0,0), C1,12); \
    }while(0)
  int t=1;
  #undef CMASK
  #define CMASK(P0,P1,t) do{}while(0)
  for(;t+5<NT;t+=2){
    STEP(pB0,pB1,pA0,pA1,t,true,true,true);     WAIT_BAR(2); RESC(); ROT();
    STEP(pA0,pA1,pB0,pB1,t+1,true,true,true);   WAIT_BAR(2); RESC(); ROT();
  }
  #undef CMASK
  #define CMASK(P0,P1,t) do{}while(0)
  #define ENDW(tt) do{ if((tt)+3<NT){WAIT_BAR(2);} else if((tt)+2<NT){WAIT_BAR(1);} else {WAIT_BAR(0);} }while(0)
  for(;t+1<NT;t+=2){
    STEP(pB0,pB1,pA0,pA1,t,(t+3<NT),(t+1<NT),(t+1<NT));       ENDW(t);   RESC(); ROT();
    STEP(pA0,pA1,pB0,pB1,t+1,(t+4<NT),(t+2<NT),(t+2<NT));     ENDW(t+1); RESC(); ROT();
  }
  STEP(pB0,pB1,pA0,pA1,NT-1,false,false,false); RESC();
  { float sacc=pB0[0]+pB0[1]; _Pragma("unroll") for(int r=2;r<16;++r)sacc+=pB0[r]; _Pragma("unroll") for(int r=0;r<16;++r)sacc+=pB1[r]; l_reg+=sacc;
    pw0=(u32x4){PKW(pB0,0),PKW(pB0,2),PKW(pB0,4),PKW(pB0,6)};pw1=(u32x4){PKW(pB0,8),PKW(pB0,10),PKW(pB0,12),PKW(pB0,14)};pw2=(u32x4){PKW(pB1,0),PKW(pB1,2),PKW(pB1,4),PKW(pB1,6)};pw3=(u32x4){PKW(pB1,8),PKW(pB1,10),PKW(pB1,12),PKW(pB1,14)};
    SBAR(); pv(o,vb0+sl_cur,PAF(0),PAF(1),PAF(2),PAF(3)); }
  #undef PKW
  #undef PAF
  #undef VFR
  #undef PIN
  #undef MX3
  #undef GAPA
  #undef GAPB
  #undef EX
  #undef VRD
  #undef KRD
  #undef STEP
  #undef ENDW
  {auto rr=__builtin_amdgcn_permlane32_swap(__float_as_uint(l_reg),__float_as_uint(l_reg),false,false);l_reg=__uint_as_float(rr[0])+__uint_as_float(rr[1]);}
  if(hi==0)wsf[32+r32]=l_reg;asm volatile("s_waitcnt lgkmcnt(0)":::"memory");
  float rli[16];
  #pragma unroll
  for(int r=0;r<16;++r)rli[r]=__builtin_amdgcn_rcpf(wsf[32+crow(r,hi)]);
  bf16*Ow=O+(rowbase+q0+wid*QBLK)*OP+h*D;
  { bf16*stg=(bf16*)(shm+LDS_OST)+wid*2048;
    #pragma unroll
    for(int r=0;r<16;++r){const int orow=crow(r,hi);
      #pragma unroll
      for(int d0=0;d0<2;++d0)stg[orow*64+d0*32+r32]=__float2bfloat16(o[d0][r]*rli[r]);}
    asm volatile("s_waitcnt lgkmcnt(0)":::"memory");
    #pragma unroll
    for(int i=0;i<4;++i){const int row=i*8+(lane>>3),ch=lane&7; const u32x4 v=*(const u32x4*)(stg+row*64+ch*8); ATTN_STORE16(Ow+(long)row*OP+ch*8,v);} }
  asm volatile("s_waitcnt lgkmcnt(0)\n\ts_barrier":::"memory");
  #undef DMA_K
  #undef DMA_V
  #undef CMASK
  #undef START
  #undef RESC
  #undef ROT
}
constexpr int ATTN_LDS_BYTES=LDS_BYTES;
struct AttnTensors { const bf16* Q; const bf16* K; const bf16* V; bf16* O; };
struct AttnUnit { int bh; int qb; };
struct StaticOrder {
  int vcu;
  __device__ __forceinline__ explicit StaticOrder(int vcu_):vcu(vcu_){}
  __device__ __forceinline__ bool next(int i,AttnUnit&u)const{ if(i>=2)return false; const int p=vcu>>6, li=vcu&63, un=li*2+i; u.bh=(p>>1)*NHEAD+(p&1)*4+(un>>5); u.qb=un&31; return true; }
  __device__ __forceinline__ void a_ready(const AttnUnit&)const{}
  __device__ __forceinline__ void done(const AttnUnit&)const{}
};
template<class Sched,int THRL=8> __device__ __forceinline__ void attn_phase(char*lds,const AttnTensors&T,const Sched&S){
  AttnUnit u;
  for(int i=0;S.next(i,u);++i){ S.a_ready(u); attn_unit<THRL>(u.bh/NHEAD,u.bh%NHEAD,u.qb,T.Q,T.K,T.V,T.O,lds); S.done(u); }
}
#undef SBAR
#undef WAIT_BAR
}
#define GAS __attribute__((address_space(1)))
#define LAS __attribute__((address_space(3)))
typedef unsigned short bf16;
typedef unsigned v4u __attribute__((ext_vector_type(4)));
typedef float f32x4 __attribute__((ext_vector_type(4)));
typedef short bf16x8 __attribute__((ext_vector_type(8)));
typedef GAS unsigned gu32;
typedef GAS unsigned long long gu64;
#define RLX_AGENT __ATOMIC_RELAXED, __HIP_MEMORY_SCOPE_AGENT
#define LDS_WAIT() asm volatile("s_waitcnt lgkmcnt(0)" ::: "memory")
#define VM_WAIT() asm volatile("s_waitcnt vmcnt(0)" ::: "memory")
__device__ __forceinline__ unsigned long long rt() { return __builtin_amdgcn_s_memrealtime(); }
__device__ __forceinline__ unsigned f2bf(float f) { unsigned u = __builtin_bit_cast(unsigned, f); return (u + 0x7fffu + ((u >> 16) & 1u)) >> 16; }
__device__ __forceinline__ unsigned pk2(float lo, float hi) { return f2bf(lo) | (f2bf(hi) << 16); }
#define XB_TMO      128
#define XB_XCNT(j)  (256  + 64 * (j))
#define XB_XSUB(j)  (1280 + 64 * (j))
#define XB_XGEN(j)  (2304 + 64 * (j))
#define XB_TOP      3328
#define XB_TOPGEN   3392
#define XCD_BAR_WORDS 3456
#define XB_SPIN_CAP (1u << 18)

__device__ __forceinline__ unsigned xb_ld(unsigned* p)              { return __hip_atomic_load(p, __ATOMIC_RELAXED, __HIP_MEMORY_SCOPE_AGENT); }
__device__ __forceinline__ unsigned xb_add(unsigned* p, unsigned v) { return __hip_atomic_fetch_add(p, v, __ATOMIC_RELAXED, __HIP_MEMORY_SCOPE_AGENT); }
__device__ __forceinline__ unsigned xb_xcc_id() { return (unsigned)__builtin_amdgcn_s_getreg((3 << 11) | 20) & 0xFu; }
#define XB_SPIN(cond, bar) do { unsigned _sp = 0; while (cond) { __builtin_amdgcn_s_sleep(1); \
    if ((++_sp & 255u) == 0u) { if (xb_ld(&(bar)[XB_TMO])) break; if (_sp > XB_SPIN_CAP) { atomicAdd(&(bar)[XB_TMO], 1u); break; } } } } while (0)

struct XcdBarrier {
    unsigned* bar; unsigned x;
    volatile LAS unsigned* st;
};

__device__ __forceinline__ XcdBarrier xcd_barrier_post(unsigned* bar, volatile LAS unsigned* st) {
    XcdBarrier b; b.bar = bar; b.x = xb_xcc_id(); b.st = st;
    if (threadIdx.x == 0) (void)xb_add(&bar[XB_XCNT(b.x)], 1u);
    return b;
}
__device__ __forceinline__ void xcd_barrier_complete(unsigned* bar, unsigned x, unsigned& nloc, unsigned& nx) {
    const unsigned G = gridDim.x * gridDim.y * gridDim.z;
    unsigned sum, cnt, mine, sp = 0u;
    for (;;) {
        sum = 0u; cnt = 0u; mine = 0u;
#pragma unroll
        for (unsigned j = 0; j < 16; ++j) { const unsigned c = xb_ld(&bar[XB_XCNT(j)]); sum += c; cnt += (c > 0u) ? 1u : 0u; mine = (j == x) ? c : mine; }
        if (sum == G) break;
        __builtin_amdgcn_s_sleep(1);
        if ((++sp & 255u) == 0u) { if (xb_ld(&bar[XB_TMO])) break; if (sp > XB_SPIN_CAP) { atomicAdd(&bar[XB_TMO], 1u); break; } }
    }
    nloc = mine > 0u ? mine : 1u; nx = cnt > 0u ? cnt : 1u;
}

__device__ __forceinline__ void xcd_barrier(const XcdBarrier& b) {
    asm volatile("s_waitcnt vmcnt(0)" ::: "memory");
    __syncthreads();
    if (threadIdx.x == 0) {
        unsigned* bar = b.bar;
        __builtin_amdgcn_s_waitcnt(0);
        unsigned nloc = b.st[0], nx = b.st[1];
        if (nloc == 0u) { xcd_barrier_complete(bar, b.x, nloc, nx); b.st[0] = nloc; b.st[1] = nx; }
        const unsigned old = xb_add(&bar[XB_XSUB(b.x)], 1u);
        const unsigned gen = old / nloc;
        if (old + 1u == (gen + 1u) * nloc) {
            __builtin_amdgcn_fence(__ATOMIC_RELEASE, "agent");
            asm volatile("s_waitcnt vmcnt(0)" ::: "memory");
            const unsigned og = xb_add(&bar[XB_TOP], 1u);
            const unsigned tg = og / nx;
            if (og + 1u == (tg + 1u) * nx) xb_add(&bar[XB_TOPGEN], 1u);
            else XB_SPIN(xb_ld(&bar[XB_TOPGEN]) == tg, bar);
            __builtin_amdgcn_fence(__ATOMIC_ACQUIRE, "agent");
            xb_add(&bar[XB_XGEN(b.x)], 1u);
            asm volatile("s_waitcnt vmcnt(0)" ::: "memory");
        } else {
            XB_SPIN(xb_ld(&bar[XB_XGEN(b.x)]) == gen, bar);
            __builtin_amdgcn_fence(__ATOMIC_ACQUIRE, "agent");
            asm volatile("s_waitcnt vmcnt(0)" ::: "memory");
        }
    }
    __syncthreads();
}

namespace pg8 {
struct EpiSwiGLU {
    static constexpr bool PERM = true, AFTER_DRAIN = false;
    bf16_t* O; int ldc;
    __device__ __forceinline__ void operator()(const f32x4 (&acc)[2][2][4][2], const Unit& u, int wr, int wc, int fr, int fq) const {
        const int row0 = u.pm * BM + wr * 64 + fr; const int col0 = u.pn * HALF + wc * 32 + 8 * fq;
#pragma unroll
        for (int ai = 0; ai < 2; ++ai)
#pragma unroll
            for (int m = 0; m < 4; ++m) { bf16_t* rowp = O + (size_t)(row0 + ai * HALF + m * 16) * ldc + col0;
                float r[8];
#pragma unroll
                for (int n = 0; n < 2; ++n)
#pragma unroll
                    for (int i = 0; i < 4; ++i) { const float g = acc[ai][0][m][n][i], up = acc[ai][1][m][n][i];
                        const float e = __builtin_amdgcn_exp2f(-g * 1.4426950408889634f); r[n * 4 + i] = g * __builtin_amdgcn_rcpf(1.0f + e) * up; }
                u32x4 w; w.x = cvt_pk_bf16(r[0], r[1]); w.y = cvt_pk_bf16(r[2], r[3]); w.z = cvt_pk_bf16(r[4], r[5]); w.w = cvt_pk_bf16(r[6], r[7]);
                *(u32x4*)rowp = w; }
    }
};
}

constexpr int NWAVES = 8;
constexpr int BATCH = 2, SEQ = 8192, D = 1024, M = BATCH * SEQ, FFH = 2816;
constexpr float EPS = 1e-6f;
constexpr int NKEY = 387, NKEYP = 392;

constexpr size_t MiB = 1u << 20, HMiB = 1u << 19;
constexpr size_t WS_CTL = 0, CTL_ZERO_BYTES = 1 * MiB;
constexpr size_t WS_SMALL = 1 * MiB;
constexpr size_t SM_MOD = 0;
constexpr size_t SM_BIAST = 131072;
constexpr size_t SM_LB = 147456;
constexpr size_t SM_TW = 262144;
constexpr size_t WS_WINAB = 2 * MiB, WS_WOUTAB = 10 * MiB, WS_WINCD = 12 * MiB, WS_WOUTCD = 14 * MiB + HMiB;
constexpr size_t WS_WF1 = 16 * MiB + HMiB, WF1_BYTES = 11 * MiB, WS_WF2 = 38 * MiB + HMiB, WF2_BYTES = 5 * MiB + HMiB;
constexpr size_t WS_XN = 50 * MiB, WS_YB = 82 * MiB, WS_Z = 114 * MiB, WS_END = 242 * MiB;
constexpr size_t SEG = (size_t)M * 512;
constexpr int CW_BAR = 4096;

constexpr int RING_OFF = 0, RING_BYTES = 131072;
constexpr int TAB_OFF = RING_BYTES;
constexpr int LDSCTL_OFF = RING_BYTES + 1024, MISC_OFF = LDSCTL_OFF + 320;
constexpr int LDS_BYTES = 147456;

__device__ __forceinline__ float bf2f(unsigned short h) { return __builtin_bit_cast(float, (unsigned)h << 16); }
__device__ __forceinline__ float bflo(unsigned w) { return __builtin_bit_cast(float, w << 16); }
__device__ __forceinline__ float bfhi(unsigned w) { return __builtin_bit_cast(float, w & 0xffff0000u); }
__device__ __forceinline__ float wave_sum(float v) {
#pragma unroll
    for (int o = 1; o < 64; o <<= 1) v += __shfl_xor(v, o);
    return v;
}
__device__ __forceinline__ float wave_max(float v) {
#pragma unroll
    for (int o = 1; o < 64; o <<= 1) v = fmaxf(v, __shfl_xor(v, o));
    return v;
}
__device__ __forceinline__ float rdlane(float v, int j) { return __builtin_bit_cast(float, __builtin_amdgcn_readlane(__builtin_bit_cast(int, v), j)); }
__device__ __forceinline__ float siluf(float g) { return g / (1.0f + __expf(-g)); }

struct Frame {
    LAS unsigned char* lds;
    volatile LAS unsigned* MISC;
    gu32* ctl;
    int tid, lane, wave, vcu, G;
    const float *x, *c, *t5, *lbl, *ada_w, *ada_b, *gains, *ab_in, *ab_out, *hnorm, *cd_in, *cd_out, *qkn, *f_in, *f_out;
    float* out;
    unsigned char* ws;
};

__device__ __forceinline__ void p_adaln(Frame& F) {
    LAS float* red = (LAS float*)(F.lds + RING_OFF);
    float* MOD = (float*)(F.ws + WS_SMALL + SM_MOD);
    const int r4 = F.lane >> 4, c4 = F.lane & 15;
    for (int task = blockIdx.x; task < 192; task += F.G) {
        const int l = task / 96, cg = task % 96;
        const float* W = F.ada_w + (size_t)l * 1024 * 6144 + cg * 64 + 4 * c4;
        f32x4 a0 = {0.f, 0.f, 0.f, 0.f}, a1 = {0.f, 0.f, 0.f, 0.f};
#pragma unroll 4
        for (int i = 0; i < 32; ++i) {
            const int row = 128 * F.wave + 4 * i + r4;
            const f32x4 wv = *(const f32x4*)(W + (size_t)row * 6144);
            const float c0 = F.c[row], c1 = F.c[1024 + row];
            a0 += siluf(c0) * wv; a1 += siluf(c1) * wv;
        }
#pragma unroll
        for (int i = 0; i < 4; ++i) { a0[i] += __shfl_xor(a0[i], 16); a0[i] += __shfl_xor(a0[i], 32); a1[i] += __shfl_xor(a1[i], 16); a1[i] += __shfl_xor(a1[i], 32); }
        if (r4 == 0) {
#pragma unroll
            for (int i = 0; i < 4; ++i) { red[(F.wave * 2 + 0) * 64 + 4 * c4 + i] = a0[i]; red[(F.wave * 2 + 1) * 64 + 4 * c4 + i] = a1[i]; }
        }
        __syncthreads();
        if (F.tid < 128) { const int b = F.tid >> 6, col = F.tid & 63; float s = 0.f;
#pragma unroll
            for (int w = 0; w < 8; ++w) s += red[(w * 2 + b) * 64 + col];
            MOD[(l * 2 + b) * 6144 + cg * 64 + col] = s + F.ada_b[l * 6144 + cg * 64 + col]; }
        __syncthreads();
    }
    if ((int)blockIdx.x == F.G - 1) {
        float* BT = (float*)(F.ws + WS_SMALL + SM_BIAST);
        for (int idx = F.tid; idx < NKEY; idx += NWAVES * 64) {
            const int r = idx / 129, j = idx - r * 129 - 64, d = (r == 0) ? 1 : (r == 1) ? 4 : 16, rel = j * d, n = rel < 0 ? -rel : rel;
            int large = 8 + (int)(log((double)(n > 1 ? n : 1) / 8.0) / log(128.0) * 8.0); if (large > 15) large = 15;
            const int bucket = (rel > 0 ? 16 : 0) + (n < 8 ? n : large);
#pragma unroll
            for (int h = 0; h < 8; ++h) BT[h * NKEYP + idx] = F.t5[bucket * 8 + h];
        }
    }
    if ((int)blockIdx.x == F.G - 2) {
        float* LB = (float*)(F.ws + WS_SMALL + SM_LB);
        for (int i = F.tid; i < 1024; i += NWAVES * 64) {
            const float l0 = F.lbl[i], l1 = F.lbl[1024 + i], l2 = F.lbl[2048 + i]; const float mx = fmaxf(l0, fmaxf(l1, l2));
            const float e0 = expf(l0 - mx), e1 = expf(l1 - mx), e2 = expf(l2 - mx); LB[i] = e0 / (e0 + e1 + e2);
        }
    }
    if ((int)blockIdx.x >= F.G - 18 && (int)blockIdx.x < F.G - 2) {
        float* TW = (float*)(F.ws + WS_SMALL + SM_TW);
        const int j = ((int)blockIdx.x - (F.G - 18)) * 512 + F.tid;
        const double a = (double)j * (6.283185307179586476925286766559 / 8192.0);
        TW[j] = (float)cos(a); TW[8192 + j] = (float)sin(a);
    }
}

__device__ __forceinline__ void transpose_item(const float* W, int K, int N, bf16* WT, int dest_row0, int k0, int n0, LAS float* scr, int lane) {
#pragma unroll 8
    for (int i = 0; i < 32; ++i) { const int kk = 2 * i + (lane >> 5); scr[kk * 33 + (lane & 31)] = W[(size_t)(k0 + kk) * N + n0 + (lane & 31)]; }
    LDS_WAIT(); asm volatile("" ::: "memory");
    const int c = lane & 7;
#pragma unroll
    for (int j = 0; j < 4; ++j) { const int n = (lane >> 3) + 8 * j; const LAS float* s = scr + (8 * c) * 33 + n;
        v4u o; o.x = pk2(s[0 * 33], s[1 * 33]); o.y = pk2(s[2 * 33], s[3 * 33]); o.z = pk2(s[4 * 33], s[5 * 33]); o.w = pk2(s[6 * 33], s[7 * 33]);
        *(GAS v4u*)(WT + (size_t)(dest_row0 + n) * K + k0 + 8 * c) = o; }
    LDS_WAIT(); asm volatile("" ::: "memory");
}
__device__ __forceinline__ void p_weights(Frame& F) {
    LAS float* scr = (LAS float*)(F.lds + RING_OFF + F.wave * 16384);
    const int gw = F.vcu * NWAVES + F.wave, NGW = F.G * NWAVES;
    constexpr int I_ABI = 16 * 128, I_ABO = 16 * 32, I_CDI = 16 * 40, I_CDO = 16 * 32, I_F1 = 16 * 176, I_F2 = 44 * 32;
    constexpr int NITEMS = I_ABI + I_ABO + I_CDI + I_CDO + 2 * I_F1 + 2 * I_F2;
    for (int it = gw; it < NITEMS; it += NGW) {
        int r = it;
        if (r < I_ABI) { const int nb = 128, kb = r / nb, n0 = 32 * (r % nb); transpose_item(F.ab_in, 1024, 4096, (bf16*)(F.ws + WS_WINAB), n0, 64 * kb, n0, scr, F.lane); continue; } r -= I_ABI;
        if (r < I_ABO) { const int nb = 32, kb = r / nb, n0 = 32 * (r % nb); transpose_item(F.ab_out, 1024, 1024, (bf16*)(F.ws + WS_WOUTAB), n0, 64 * kb, n0, scr, F.lane); continue; } r -= I_ABO;
        if (r < I_CDI) { const int nb = 40, kb = r / nb, n0 = 32 * (r % nb); transpose_item(F.cd_in, 1024, 1280, (bf16*)(F.ws + WS_WINCD), n0, 64 * kb, n0, scr, F.lane); continue; } r -= I_CDI;
        if (r < I_CDO) { const int nb = 32, kb = r / nb, n0 = 32 * (r % nb); transpose_item(F.cd_out, 1024, 1024, (bf16*)(F.ws + WS_WOUTCD), n0, 64 * kb, n0, scr, F.lane); continue; } r -= I_CDO;
        if (r < 2 * I_F1) { const int l = r / I_F1; r -= l * I_F1; const int nb = 176, kb = r / nb, n0 = 32 * (r % nb);
            const int up = n0 >= FFH ? 1 : 0, j = n0 - up * FFH, drow = 256 * (j >> 7) + 128 * up + (j & 127);
            transpose_item(F.f_in + (size_t)l * 1024 * 5632, 1024, 5632, (bf16*)(F.ws + WS_WF1 + l * WF1_BYTES), drow, 64 * kb, n0, scr, F.lane); continue; } r -= 2 * I_F1;
        { const int l = r / I_F2; r -= l * I_F2; const int nb = 32, kb = r / nb, n0 = 32 * (r % nb);
            transpose_item(F.f_out + (size_t)l * FFH * 1024, FFH, 1024, (bf16*)(F.ws + WS_WF2 + l * WF2_BYTES), n0, 64 * kb, n0, scr, F.lane); }
    }
}
__device__ __forceinline__ void p_rows(Frame& F, const float* xin, const bf16* y, const float* gate_mod  , const float* gain_post,
                                       float* xout, const float* mod_next  , const float* gain_pre, bf16* xn) {
    const int gw = F.vcu * NWAVES + F.wave, NGW = F.G * NWAVES;
    for (int b = 0; b < BATCH; ++b) {
        f32x4 A1[4], A2[4], B2[4];
#pragma unroll
        for (int j = 0; j < 4; ++j) { const int col = 4 * F.lane + 256 * j;
            if (y) { const f32x4 g = *(const f32x4*)(gate_mod + b * 6144 + col), gp = *(const f32x4*)(gain_post + col); A1[j] = g * gp; } else A1[j] = (f32x4){0.f, 0.f, 0.f, 0.f};
            if (mod_next) { const f32x4 sh = *(const f32x4*)(mod_next + b * 6144 + col), sc = *(const f32x4*)(mod_next + b * 6144 + 1024 + col), gp = *(const f32x4*)(gain_pre + col);
                A2[j] = gp * (sc + 1.0f); B2[j] = sh; } else { A2[j] = (f32x4){0.f, 0.f, 0.f, 0.f}; B2[j] = A2[j]; } }
        for (int m = b * SEQ + gw; m < (b + 1) * SEQ; m += NGW) {
            f32x4 v[4];
#pragma unroll
            for (int j = 0; j < 4; ++j) v[j] = *(const f32x4*)(xin + (size_t)m * D + 4 * F.lane + 256 * j);
            if (y) {
                f32x4 yv[4]; float ss = 0.f;
#pragma unroll
                for (int j = 0; j < 4; ++j) { const uint2 w = *(const uint2*)(y + (size_t)m * D + 4 * F.lane + 256 * j);
                    yv[j] = (f32x4){bflo(w.x), bfhi(w.x), bflo(w.y), bfhi(w.y)}; ss += (yv[j].x * yv[j].x + yv[j].y * yv[j].y) + (yv[j].z * yv[j].z + yv[j].w * yv[j].w); }
                const float rs = 1.0f / sqrtf(wave_sum(ss) * (1.0f / D) + EPS);
#pragma unroll
                for (int j = 0; j < 4; ++j) v[j] = v[j] + A1[j] * (yv[j] * rs);
            }
            if (xout) {
#pragma unroll
                for (int j = 0; j < 4; ++j) *(f32x4*)(xout + (size_t)m * D + 4 * F.lane + 256 * j) = v[j];
            }
            if (mod_next) {
                float ss = 0.f;
#pragma unroll
                for (int j = 0; j < 4; ++j) ss += (v[j].x * v[j].x + v[j].y * v[j].y) + (v[j].z * v[j].z + v[j].w * v[j].w);
                const float rs = 1.0f / sqrtf(wave_sum(ss) * (1.0f / D) + EPS);
#pragma unroll
                for (int j = 0; j < 4; ++j) { const f32x4 h = (v[j] * rs) * A2[j] + B2[j];
                    uint2 w; w.x = pk2(h.x, h.y); w.y = pk2(h.z, h.w); *(uint2*)(xn + (size_t)m * D + 4 * F.lane + 256 * j) = w; }
            }
        }
    }
}

__device__ __forceinline__ void p_dilated_naive(Frame& F, const bf16* Q, const bf16* K, const bf16* V, bf16* O  ) {
    const float* BT = (const float*)(F.ws + WS_SMALL + SM_BIAST);
    const int gw = F.vcu * NWAVES + F.wave, NGW = F.G * NWAVES, lane = F.lane;
    for (int item = gw; item < M * 8; item += NGW) {
        const int m = item >> 3, h = item & 7, b = m >> 13, t = m & 8191;
        float qf[64];
        { const uint4* qp = (const uint4*)(Q + (size_t)m * 512 + h * 64);
#pragma unroll
          for (int i = 0; i < 8; ++i) { const uint4 w = qp[i]; qf[8 * i + 0] = bflo(w.x); qf[8 * i + 1] = bfhi(w.x); qf[8 * i + 2] = bflo(w.y); qf[8 * i + 3] = bfhi(w.y);
              qf[8 * i + 4] = bflo(w.z); qf[8 * i + 5] = bfhi(w.z); qf[8 * i + 6] = bflo(w.w); qf[8 * i + 7] = bfhi(w.w); } }
        float lg[7]; int posv[7]; float mx = -3.0e38f;
#pragma unroll
        for (int g = 0; g < 7; ++g) {
            const int idx = g * 64 + lane; float l = -3.0e38f; int pos = t;
            if (idx < NKEY) { const int r = idx / 129, j = idx - r * 129 - 64, d = (r == 0) ? 1 : (r == 1) ? 4 : 16; pos = t + j * d;
                if (pos >= 0 && pos < SEQ) { const uint4* kp = (const uint4*)(K + (size_t)(b * SEQ + pos) * 512 + h * 64); float dot = 0.f;
#pragma unroll
                    for (int i = 0; i < 8; ++i) { const uint4 w = kp[i]; dot += qf[8 * i + 0] * bflo(w.x) + qf[8 * i + 1] * bfhi(w.x) + qf[8 * i + 2] * bflo(w.y) + qf[8 * i + 3] * bfhi(w.y)
                                                                            + qf[8 * i + 4] * bflo(w.z) + qf[8 * i + 5] * bfhi(w.z) + qf[8 * i + 6] * bflo(w.w) + qf[8 * i + 7] * bfhi(w.w); }
                    l = dot * 0.125f + BT[h * NKEYP + idx]; } else pos = t; }
            lg[g] = l; posv[g] = pos; mx = fmaxf(mx, l);
        }
        mx = wave_max(mx);
        float s = 0.f;
#pragma unroll
        for (int g = 0; g < 7; ++g) { lg[g] = (lg[g] > -1.0e38f) ? __expf(lg[g] - mx) : 0.f; s += lg[g]; }
        s = wave_sum(s);
        float acc = 0.f; const bf16* Vb = V + (size_t)b * SEQ * 512 + h * 64 + lane;
#pragma unroll
        for (int g = 0; g < 7; ++g) { const int n = (g < 6) ? 64 : (NKEY - 384);
            for (int j = 0; j < n; ++j) { const float pj = rdlane(lg[g], j); const int pos = __builtin_amdgcn_readlane(posv[g], j);
                if (pj != 0.f) acc += pj * bf2f(Vb[(size_t)pos * 512]); } }
        O[(size_t)m * 1024 + h * 64 + lane] = (bf16)f2bf(acc / s);
    }
}

__device__ __forceinline__ void p_hgrn_naive(Frame& F, const bf16* Qh, const bf16* Ff, const bf16* Fb, const bf16* Ih, float* Odir) {
    const float* LB = (const float*)(F.ws + WS_SMALL + SM_LB);
    constexpr int TT = 32;
    LAS float* qs = (LAS float*)(F.lds + RING_OFF);
    LAS float* fa = qs + TT * 128;
    LAS float* vv = fa + TT * 128;
    const int tid = F.tid, lane = F.lane, vi = lane & 1, kq = lane >> 1;
    for (int item = blockIdx.x; item < 128; item += F.G) {
        const int chain = item >> 3, vs = item & 7, dir = chain >> 3, b = (chain >> 2) & 1, h = chain & 3;
        const bf16* Fp = dir ? Fb : Ff;
        float S[4] = {0.f, 0.f, 0.f, 0.f};
        const int vcol = h * 128 + vs * 16 + F.wave * 2 + vi;
        for (int s0 = 0; s0 < SEQ; s0 += TT) {
            __syncthreads();
            { const int tt = tid >> 4, k0 = (tid & 15) * 8; const int t = dir ? (SEQ - 1 - (s0 + tt)) : (s0 + tt); const size_t row = (size_t)(b * SEQ + t) * 512 + h * 128 + k0;
              const uint4 qw = *(const uint4*)(Qh + row), fw = *(const uint4*)(Fp + row);
              const unsigned qa[4] = {qw.x, qw.y, qw.z, qw.w}, fb_[4] = {fw.x, fw.y, fw.z, fw.w};
#pragma unroll
              for (int i = 0; i < 4; ++i) {
                  const float lb0 = LB[dir * 512 + h * 128 + k0 + 2 * i], lb1 = LB[dir * 512 + h * 128 + k0 + 2 * i + 1];
                  qs[tt * 128 + k0 + 2 * i] = bflo(qa[i]) * 0.08838834764831845f; qs[tt * 128 + k0 + 2 * i + 1] = bfhi(qa[i]) * 0.08838834764831845f;
                  fa[tt * 128 + k0 + 2 * i] = lb0 + (1.0f - lb0) / (1.0f + __expf(-bflo(fb_[i]))); fa[tt * 128 + k0 + 2 * i + 1] = lb1 + (1.0f - lb1) / (1.0f + __expf(-bfhi(fb_[i]))); }
              if (tid < TT * 16) { const int tv = tid >> 4, vc = tid & 15; const int t2 = dir ? (SEQ - 1 - (s0 + tv)) : (s0 + tv);
                  vv[tv * 16 + vc] = bf2f(Ih[(size_t)(b * SEQ + t2) * 512 + h * 128 + vs * 16 + vc]); } }
            __syncthreads();
#pragma unroll 4
            for (int tt = 0; tt < TT; ++tt) {
                const f32x4 f4 = *(const LAS f32x4*)(fa + tt * 128 + 4 * kq), q4 = *(const LAS f32x4*)(qs + tt * 128 + 4 * kq); const float v = vv[tt * 16 + F.wave * 2 + vi];
                float o = 0.f;
#pragma unroll
                for (int i = 0; i < 4; ++i) { S[i] = f4[i] * S[i] + (1.0f - f4[i]) * v; o += q4[i] * S[i]; }
                o += __shfl_xor(o, 2); o += __shfl_xor(o, 4); o += __shfl_xor(o, 8); o += __shfl_xor(o, 16); o += __shfl_xor(o, 32);
                if (kq == 0) { const int t = dir ? (SEQ - 1 - (s0 + tt)) : (s0 + tt); Odir[((size_t)dir * M + (size_t)(b * SEQ + t)) * 512 + vcol] = o; }
            }
        }
    }
}
__device__ __forceinline__ void p_hgrn_final(Frame& F, const float* Odir, const bf16* Gh, bf16* O) {
    const int gw = F.vcu * NWAVES + F.wave, NGW = F.G * NWAVES, lane = F.lane;
    const float g0 = F.hnorm[2 * lane], g1 = F.hnorm[2 * lane + 1];
    for (int item = gw; item < M * 4; item += NGW) {
        const int m = item >> 2, h = item & 3; const size_t off = (size_t)m * 512 + h * 128 + 2 * lane;
        const float2 a = *(const float2*)(Odir + off), c = *(const float2*)(Odir + (size_t)M * 512 + off);
        const float o0 = a.x + c.x, o1 = a.y + c.y; const float rs = 1.0f / sqrtf(wave_sum(o0 * o0 + o1 * o1) * (1.0f / 128.0f) + EPS);
        const unsigned gw2 = *(const unsigned*)(Gh + off); const float r0 = o0 * rs * g0 * siluf(bflo(gw2)), r1 = o1 * rs * g1 * siluf(bfhi(gw2));
        *(unsigned*)(O + (size_t)m * 1024 + 512 + h * 128 + 2 * lane) = pk2(r0, r1);
    }
}

__device__ __forceinline__ void tab128_init(Frame& F) {
    LAS float* T = (LAS float*)(F.lds + TAB_OFF);
    if (F.tid < 128) { float s, c; sincospif((float)F.tid * (1.0f / 64.0f), &s, &c); T[F.tid] = c; T[128 + F.tid] = s; }
    __syncthreads();
}
__device__ __forceinline__ void p_fnet1_naive(Frame& F, const bf16* U  , float* APR, float* API) {
    const float* TW = (const float*)(F.ws + WS_SMALL + SM_TW);
    LAS float* T = (LAS float*)(F.lds + TAB_OFF);
    LAS float* Us = (LAS float*)(F.lds + RING_OFF);
    LAS float* Zr = Us + 64 * 129 + 64;
    LAS float* Zi = Zr + 64 * 128;
    tab128_init(F);
    const int tid = F.tid, kc = tid & 127, grp = tid >> 7;
    for (int unit = blockIdx.x; unit < 2 * 4 * 128; unit += F.G) {
        const int b = unit >> 9, g = (unit >> 7) & 3, n2 = unit & 127;
        __syncthreads();
        { const int row = tid >> 3, c0 = (tid & 7) * 16; const uint4* p = (const uint4*)(U + (size_t)(b * SEQ + 128 * row + n2) * 512 + g * 128 + c0);
#pragma unroll
          for (int i = 0; i < 2; ++i) { const uint4 w = p[i]; LAS float* d = Us + row * 129 + c0 + 8 * i;
              d[0] = bflo(w.x); d[1] = bfhi(w.x); d[2] = bflo(w.y); d[3] = bfhi(w.y); d[4] = bflo(w.z); d[5] = bfhi(w.z); d[6] = bflo(w.w); d[7] = bfhi(w.w); } }
        __syncthreads();
        { float zr[16], zi[16];
#pragma unroll
          for (int i = 0; i < 16; ++i) { zr[i] = 0.f; zi[i] = 0.f; }
          for (int c = 0; c < 128; ++c) { const int idx = (c * kc) & 127; const float cs = T[idx], sn = T[128 + idx];
#pragma unroll
              for (int i = 0; i < 16; ++i) { const float u = Us[(grp * 16 + i) * 129 + c]; zr[i] += u * cs; zi[i] -= u * sn; } }
#pragma unroll
          for (int i = 0; i < 16; ++i) { Zr[(grp * 16 + i) * 128 + kc] = zr[i]; Zi[(grp * 16 + i) * 128 + kc] = zi[i]; } }
        __syncthreads();
        { float ar[16], ai[16];
#pragma unroll
          for (int i = 0; i < 16; ++i) { ar[i] = 0.f; ai[i] = 0.f; }
          for (int n1 = 0; n1 < 64; ++n1) { const float zr = Zr[n1 * 128 + kc], zi = Zi[n1 * 128 + kc];
#pragma unroll
              for (int i = 0; i < 16; ++i) { const int idx = (2 * n1 * (grp * 16 + i)) & 127; const float cs = T[idx], sn = T[128 + idx]; ar[i] += zr * cs + zi * sn; ai[i] += zi * cs - zr * sn; } }
#pragma unroll
          for (int i = 0; i < 16; ++i) { const int k1 = grp * 16 + i; const float ct = TW[n2 * k1], st = TW[8192 + n2 * k1];
              const size_t o = ((size_t)((b * 4 + g) * 128 + n2) * 64 + k1) * 128 + kc;
              APR[o] = ar[i] * ct + ai[i] * st; API[o] = ai[i] * ct - ar[i] * st; } }
    }
}
__device__ __forceinline__ void p_fnet2_naive(Frame& F, const float* APR, const float* API, bf16* O) {
    LAS float* T = (LAS float*)(F.lds + TAB_OFF);
    LAS float* Ar = (LAS float*)(F.lds + RING_OFF);
    LAS float* Ai = Ar + 128 * 128;
    tab128_init(F);
    const int tid = F.tid, kc = tid & 127, grp = tid >> 7;
    for (int unit = blockIdx.x; unit < 2 * 4 * 64; unit += F.G) {
        const int b = unit >> 8, g = (unit >> 6) & 3, k1 = unit & 63;
        __syncthreads();
        for (int e = tid; e < 128 * 128 / 4; e += NWAVES * 64) { const int n2 = e >> 5, c4 = (e & 31) * 4; const size_t o = ((size_t)((b * 4 + g) * 128 + n2) * 64 + k1) * 128 + c4;
            *(LAS f32x4*)(Ar + n2 * 128 + c4) = *(const f32x4*)(APR + o); *(LAS f32x4*)(Ai + n2 * 128 + c4) = *(const f32x4*)(API + o); }
        __syncthreads();
        float y[32];
#pragma unroll
        for (int i = 0; i < 32; ++i) y[i] = 0.f;
        for (int n2 = 0; n2 < 128; ++n2) { const float ar = Ar[n2 * 128 + kc], ai = Ai[n2 * 128 + kc];
#pragma unroll
            for (int i = 0; i < 32; ++i) { const int idx = (n2 * (grp * 32 + i)) & 127; y[i] += ar * T[idx] + ai * T[128 + idx]; } }
#pragma unroll
        for (int i = 0; i < 32; ++i) { const int k2 = grp * 32 + i; O[(size_t)(b * SEQ + k1 + 64 * k2) * 1024 + g * 128 + kc] = (bf16)f2bf(y[i] * (1.0f / 1024.0f)); }
    }
}

__device__ __forceinline__ void p_qkprep(Frame& F, bf16* QD, bf16* KV, float qscale) {
    const int gw = F.vcu * NWAVES + F.wave, NGW = F.G * NWAVES, lane = F.lane;
    const float invf = powf(10000.0f, -(float)(lane & 15) * (1.0f / 16.0f));
    const float gq = F.qkn[lane], gk = F.qkn[64 + lane];
    for (int m = gw; m < M; m += NGW) {
        const int t = m & 8191; const float pos = (lane < 32) ? (float)(t >> 6) : (float)(t & 63); const float ang = pos * invf; const float cs = cosf(ang), sn = sinf(ang);
#pragma unroll
        for (int hh = 0; hh < 10; ++hh) {
            bf16* p = (hh < 8) ? (QD + (size_t)m * 512 + hh * 64 + lane) : (KV + (size_t)m * 512 + (hh - 8) * 64 + lane);
            const float x = bf2f(*p); const float rs = 1.0f / sqrtf(wave_sum(x * x) * (1.0f / 64.0f) + EPS); const float xn = x * rs * ((hh < 8) ? gq : gk);
            const float xp = __shfl_xor(xn, 16);
            const float r = (lane & 16) ? (xp * sn + xn * cs) : (xn * cs - xp * sn);
            *p = (bf16)f2bf(r * ((hh < 8) ? qscale : 1.0f));
        }
    }
}
__device__ __forceinline__ void p_gqa_naive(Frame& F, const bf16* QD, const bf16* KV, bf16* O) {
    const int gw = F.vcu * NWAVES + F.wave, NGW = F.G * NWAVES, lane = F.lane;
    for (int item = gw; item < M * 8; item += NGW) {
        const int m = item >> 3, hq = item & 7, b = m >> 13, hk = hq >> 2;
        float qf[64];
        { const uint4* qp = (const uint4*)(QD + (size_t)m * 512 + hq * 64);
#pragma unroll
          for (int i = 0; i < 8; ++i) { const uint4 w = qp[i]; qf[8 * i + 0] = bflo(w.x); qf[8 * i + 1] = bfhi(w.x); qf[8 * i + 2] = bflo(w.y); qf[8 * i + 3] = bfhi(w.y);
              qf[8 * i + 4] = bflo(w.z); qf[8 * i + 5] = bfhi(w.z); qf[8 * i + 6] = bflo(w.w); qf[8 * i + 7] = bfhi(w.w); } }
        float mrun = -3.0e38f, srun = 0.f, acc = 0.f;
        const bf16* Kb = KV + (size_t)b * SEQ * 512 + hk * 64; const bf16* Vb = KV + (size_t)b * SEQ * 512 + 128 + hk * 64 + lane;
        for (int kg = 0; kg < SEQ / 64; ++kg) {
            const uint4* kp = (const uint4*)(Kb + (size_t)(kg * 64 + lane) * 512); float dot = 0.f;
#pragma unroll
            for (int i = 0; i < 8; ++i) { const uint4 w = kp[i]; dot += qf[8 * i + 0] * bflo(w.x) + qf[8 * i + 1] * bfhi(w.x) + qf[8 * i + 2] * bflo(w.y) + qf[8 * i + 3] * bfhi(w.y)
                                                                    + qf[8 * i + 4] * bflo(w.z) + qf[8 * i + 5] * bfhi(w.z) + qf[8 * i + 6] * bflo(w.w) + qf[8 * i + 7] * bfhi(w.w); }
            const float mnew = fmaxf(mrun, wave_max(dot)); const float corr = __expf(mrun - mnew); const float p = __expf(dot - mnew);
            srun = srun * corr + wave_sum(p); acc *= corr; mrun = mnew;
#pragma unroll 8
            for (int j = 0; j < 64; ++j) acc += rdlane(p, j) * bf2f(Vb[(size_t)(kg * 64 + j) * 512]);
        }
        O[(size_t)m * 1024 + 512 + hq * 64 + lane] = (bf16)f2bf(acc / srun);
    }
}

#ifndef MK_ONE_LAUNCH
#define MK_ONE_LAUNCH 1
#endif
constexpr int N_PHASES = 18;
struct Args { const float* in[15]; float* out; unsigned char* ws; int ph_lo, ph_hi; };
__global__ void __launch_bounds__(NWAVES * 64, 2) mk_fwd(Args args) {
    extern __shared__ __attribute__((aligned(16))) unsigned char lds[];
    Frame F;
    F.lds = (LAS unsigned char*)lds;
    F.MISC = (volatile LAS unsigned*)(F.lds + MISC_OFF);
    F.tid = threadIdx.x; F.lane = F.tid & 63; F.wave = __builtin_amdgcn_readfirstlane(F.tid >> 6);
    F.G = gridDim.x; { const int bx = blockIdx.x; F.vcu = (F.G % 8 == 0) ? (bx % 8) * (F.G / 8) + bx / 8 : bx; }
    F.ws = args.ws; F.ctl = (gu32*)(args.ws + WS_CTL);
    F.x = args.in[0]; F.c = args.in[1]; F.t5 = args.in[2]; F.lbl = args.in[3]; F.ada_w = args.in[4]; F.ada_b = args.in[5]; F.gains = args.in[6];
    F.ab_in = args.in[7]; F.ab_out = args.in[8]; F.hnorm = args.in[9]; F.cd_in = args.in[10]; F.cd_out = args.in[11]; F.qkn = args.in[12]; F.f_in = args.in[13]; F.f_out = args.in[14];
    F.out = args.out;
    for (int u = F.tid; u < (LDS_BYTES - LDSCTL_OFF) / 4; u += NWAVES * 64) ((LAS unsigned*)(F.lds + LDSCTL_OFF))[u] = 0u;
    __syncthreads();
    XcdBarrier bar; bar.bar = (unsigned*)(F.ctl + CW_BAR); bar.x = 0; bar.st = nullptr;
    if (MK_ONE_LAUNCH) bar = xcd_barrier_post((unsigned*)(F.ctl + CW_BAR), F.MISC + 8);
    const int lo = args.ph_lo, hi = args.ph_hi;
#define IN(k) (lo <= (k) && (k) < hi)
#define SEAM(k) do { if (MK_ONE_LAUNCH && IN(k) && IN((k) + 1)) xcd_barrier(bar); } while (0)
    unsigned char* ws = args.ws;
    float* MOD = (float*)(ws + WS_SMALL + SM_MOD);
    bf16* XN = (bf16*)(ws + WS_XN); bf16* YB = (bf16*)(ws + WS_YB); bf16* Z = (bf16*)(ws + WS_Z);
    bf16* H = Z;
    const float* G0 = F.gains; const float* G1 = F.gains + 4 * 1024;
    float* MOD0 = MOD; float* MOD1 = MOD + 2 * 6144;

    if (IN(0)) { p_adaln(F); } SEAM(0);
    if (IN(1)) { p_weights(F); p_rows(F, F.x, nullptr, nullptr, nullptr, nullptr, MOD0, G0, XN); } SEAM(1);
    if (IN(2)) { pg8::Gemm g{XN, (const bf16*)(ws + WS_WINAB), M, 4096, 1024}; pg8::StaticOrder S; S.init(M, 4096, F.G, (int)blockIdx.x);
        pg8::EpiBf16<0> E{Z, 512, nullptr, 512, SEG, 1.0f};
        pg8::gemm_phase<pg8::EpiBf16<0>, pg8::StaticOrder, true, true>(F.lds + RING_OFF, g, S, E); } SEAM(2);
    if (IN(3)) { p_hgrn_naive(F, Z + 3 * SEG, Z + 4 * SEG, Z + 5 * SEG, Z + 6 * SEG, F.out);
                 p_dilated_naive(F, Z, Z + SEG, Z + 2 * SEG, XN); } SEAM(3);
    if (IN(4)) { p_hgrn_final(F, F.out, Z + 7 * SEG, XN); } SEAM(4);
    if (IN(5)) { pg8::Gemm g{XN, (const bf16*)(ws + WS_WOUTAB), M, 1024, 1024}; pg8::StaticOrder S; S.init(M, 1024, F.G, (int)blockIdx.x);
        pg8::EpiBf16<0> E{YB, 1024, nullptr, 0, 0, 1.0f};
        pg8::gemm_phase<pg8::EpiBf16<0>, pg8::StaticOrder, true, true>(F.lds + RING_OFF, g, S, E); } SEAM(5);
    if (IN(6)) { p_rows(F, F.x, YB, MOD0 + 2048, G0 + 1024, F.out, MOD0 + 3072, G0 + 2048, XN); } SEAM(6);
    if (IN(7)) { pg8::Gemm g{XN, (const bf16*)(ws + WS_WF1), M, 2 * FFH, 1024}; pg8::StaticOrder S; S.init(M, 2 * FFH, F.G, (int)blockIdx.x);
        pg8::EpiSwiGLU E{H, FFH};
        pg8::gemm_phase<pg8::EpiSwiGLU, pg8::StaticOrder, true, true>(F.lds + RING_OFF, g, S, E); } SEAM(7);
    if (IN(8)) { pg8::Gemm g{H, (const bf16*)(ws + WS_WF2), M, 1024, FFH}; pg8::StaticOrder S; S.init(M, 1024, F.G, (int)blockIdx.x);
        pg8::EpiBf16<0> E{YB, 1024, nullptr, 0, 0, 1.0f};
        pg8::gemm_phase<pg8::EpiBf16<0>, pg8::StaticOrder, true, true>(F.lds + RING_OFF, g, S, E); } SEAM(8);
    if (IN(9)) { p_rows(F, F.out, YB, MOD0 + 5120, G0 + 3072, F.out, MOD1, G1, XN); } SEAM(9);
    if (IN(10)) { pg8::Gemm g{XN, (const bf16*)(ws + WS_WINCD), M, 1280, 1024}; pg8::StaticOrder S; S.init(M, 1280, F.G, (int)blockIdx.x);
        pg8::EpiBf16<0> E{Z, 512, nullptr, 512, SEG, 1.0f};
        pg8::gemm_phase<pg8::EpiBf16<0>, pg8::StaticOrder, true, true>(F.lds + RING_OFF, g, S, E); } SEAM(10);
    bf16* MIX1 = Z + 4 * SEG;
    float* APR = (float*)(ws + WS_XN); float* API = APR + (size_t)2 * 4 * 128 * 64 * 128;
    if (IN(11)) { p_qkprep(F, Z + SEG, Z + 2 * SEG, attn_body::C2); p_fnet1_naive(F, Z, APR, API); } SEAM(11);
    if (IN(12)) { p_fnet2_naive(F, APR, API, MIX1); __syncthreads();
        const attn_body::AttnTensors AT{(const attn_body::bf16*)(Z + SEG), (const attn_body::bf16*)(Z + 2 * SEG), (const attn_body::bf16*)(Z + 2 * SEG + 128), (attn_body::bf16*)(MIX1 + 512)};
        const attn_body::StaticOrder S(F.vcu);
        attn_body::attn_phase<attn_body::StaticOrder>((char*)lds + RING_OFF, AT, S); } SEAM(12);
    if (IN(13)) { pg8::Gemm g{MIX1, (const bf16*)(ws + WS_WOUTCD), M, 1024, 1024}; pg8::StaticOrder S; S.init(M, 1024, F.G, (int)blockIdx.x);
        pg8::EpiBf16<0> E{YB, 1024, nullptr, 0, 0, 1.0f};
        pg8::gemm_phase<pg8::EpiBf16<0>, pg8::StaticOrder, true, true>(F.lds + RING_OFF, g, S, E); } SEAM(13);
    if (IN(14)) { p_rows(F, F.out, YB, MOD1 + 2048, G1 + 1024, F.out, MOD1 + 3072, G1 + 2048, XN); } SEAM(14);
    if (IN(15)) { pg8::Gemm g{XN, (const bf16*)(ws + WS_WF1 + WF1_BYTES), M, 2 * FFH, 1024}; pg8::StaticOrder S; S.init(M, 2 * FFH, F.G, (int)blockIdx.x);
        pg8::EpiSwiGLU E{H, FFH};
        pg8::gemm_phase<pg8::EpiSwiGLU, pg8::StaticOrder, true, true>(F.lds + RING_OFF, g, S, E); } SEAM(15);
    if (IN(16)) { pg8::Gemm g{H, (const bf16*)(ws + WS_WF2 + WF2_BYTES), M, 1024, FFH}; pg8::StaticOrder S; S.init(M, 1024, F.G, (int)blockIdx.x);
        pg8::EpiBf16<0> E{YB, 1024, nullptr, 0, 0, 1.0f};
        pg8::gemm_phase<pg8::EpiBf16<0>, pg8::StaticOrder, true, true>(F.lds + RING_OFF, g, S, E); } SEAM(16);
    if (IN(17)) { p_rows(F, F.out, YB, MOD1 + 5120, G1 + 3072, F.out, nullptr, nullptr, nullptr); }
#undef IN
#undef SEAM
}

extern "C" void kernel_launch(void* const* d_in, const int* in_sizes, int n_in, void* d_out, int out_size, void* d_ws, size_t ws_size, hipStream_t stream) {
    static int grid = 0;
    if (grid == 0) {
        if (n_in != 15 || in_sizes[0] != M * D || out_size != M * D || ws_size < WS_END) { fprintf(stderr, "kernel_launch: unexpected shapes (n_in %d, in0 %d, out %d, ws %zu)\n", n_in, n_in > 0 ? in_sizes[0] : -1, out_size, ws_size); grid = -1; return; }
        int dev = 0, cus = 0;
        if (hipGetDevice(&dev) != hipSuccess || hipDeviceGetAttribute(&cus, hipDeviceAttributeMultiprocessorCount, dev) != hipSuccess) { grid = -1; return; }
        if (hipFuncSetAttribute((const void*)mk_fwd, hipFuncAttributeMaxDynamicSharedMemorySize, LDS_BYTES) != hipSuccess) { fprintf(stderr, "kernel_launch: hipFuncSetAttribute failed\n"); grid = -1; return; }
        (void)hipGetLastError();
        grid = cus;
    }
    if (grid < 0) return;
    if (hipMemsetAsync((char*)d_ws + WS_CTL, 0, CTL_ZERO_BYTES, stream) != hipSuccess) return;
    Args a{};
    for (int i = 0; i < 15; ++i) a.in[i] = (const float*)d_in[i];
    a.out = (float*)d_out; a.ws = (unsigned char*)d_ws;
#if MK_ONE_LAUNCH
    a.ph_lo = 0; a.ph_hi = N_PHASES;
    hipLaunchKernelGGL(mk_fwd, dim3(grid), dim3(NWAVES * 64), LDS_BYTES, stream, a);
#else
    for (int p = 0; p < N_PHASES; ++p) { a.ph_lo = p; a.ph_hi = p + 1; hipLaunchKernelGGL(mk_fwd, dim3(grid), dim3(NWAVES * 64), LDS_BYTES, stream, a); }
#endif
}
```

```cpp
#include <hip/hip_runtime.h>
#include <cstdio>
#include <cstdint>
namespace pg8 {
#define PG8_LAS __attribute__((address_space(3)))
typedef unsigned short bf16_t;
typedef short bf16x8 __attribute__((ext_vector_type(8)));
typedef float f32x4 __attribute__((ext_vector_type(4)));
typedef unsigned u32x4 __attribute__((ext_vector_type(4)));
constexpr int BM = 256, BK = 64, HALF = 128, HTB = HALF * BK * 2  , STAGE_BYTES = 8 * HTB, NXCD = 8, WGM = 8;

__host__ __device__ __forceinline__ int lds_byte(int r, int c) { const int st = (r >> 4) * 2 + (c >> 5), rr = r & 15, cc = c & 31, ob = rr * 64 + cc * 2; return st * 1024 + (ob ^ (((ob >> 9) & 1) << 5)); }
__host__ __device__ __forceinline__ void stage_rc(int b, int& R, int& C) { const int st = b / 1024, sb = b % 1024, swz = sb ^ (((sb >> 9) & 1) << 5); R = (st >> 1) * 16 + swz / 64; C = (st & 1) * 32 + (swz % 64) / 2; }
__host__ __device__ __forceinline__ int perm32(int rho) { const int n = rho >> 4, i = rho & 15; return 8 * (i >> 2) + 4 * n + (i & 3); }

struct Unit { int pm, pn; };
struct Gemm { const bf16_t* A; const bf16_t* Bt; int M, N, K; };

struct StaticOrder {
    int nM, nN, nwg, G, c;
    __host__ __device__ void init(int M, int N, int G_, int c_) { nM = M / BM; nN = N / BM; nwg = nM * nN; G = G_; c = c_; }
    __host__ __device__ bool next(int i, Unit& u) const {
        const long L = (long)i * G + c; if (L >= nwg) return false;
        int wgid = (int)L; { const int q = nwg / NXCD, r = nwg % NXCD, xcd = wgid % NXCD, off = wgid / NXCD; wgid = (xcd < r ? xcd * (q + 1) : r * (q + 1) + (xcd - r) * q) + off; }
        const int nig = WGM * nN, gid = wgid / nig, fm = gid * WGM, gsz = (nM - fm) < WGM ? (nM - fm) : WGM;
        u.pm = fm + ((wgid % nig) % gsz); u.pn = (wgid % nig) / gsz; return true;
    }
    __device__ __forceinline__ void a_ready(const Unit&) const {}
    __device__ __forceinline__ void done(const Unit&) const {}
};

__device__ __forceinline__ unsigned cvt_pk_bf16(float lo, float hi) { unsigned r; asm volatile("v_cvt_pk_bf16_f32 %0, %1, %2" : "=v"(r) : "v"(lo), "v"(hi)); return r; }
typedef float f32x2 __attribute__((ext_vector_type(2)));
__device__ __forceinline__ f32x2 gelu_pk(f32x2 v) {
    const f32x2 av = __builtin_elementwise_abs(v), d = av * 0.2316418882f + 1.0f;
    f32x2 t; t.x = __builtin_amdgcn_rcpf(d.x); t.y = __builtin_amdgcn_rcpf(d.y);
    f32x2 q = t * 0.5307027145f + (-0.7265760135f); q = q * t + 0.7107068705f; q = q * t + (-0.142248368f); q = q * t + 0.127414796f; q = q * t;
    const f32x2 s = (v * v) * (-0.72134752044f);
    f32x2 e; e.x = __builtin_amdgcn_exp2f(s.x); e.y = __builtin_amdgcn_exp2f(s.y);
    const f32x2 m = v * (q * e), r = v - m;
    f32x2 o; o.x = v.x < 0.f ? m.x : r.x; o.y = v.y < 0.f ? m.y : r.y; return o;
}

template <int ACT  > struct EpiBf16 {
    static constexpr bool PERM = true, AFTER_DRAIN = false; static_assert(ACT == 0 || ACT == 1, "EpiBf16: ACT is 0 (none) or 1 (gelu_pk)");
    bf16_t* O; int ldc; const float* bias; int split_cols; size_t split_stride; float scale0;
    __device__ __forceinline__ void operator()(const f32x4 (&acc)[2][2][4][2], const Unit& u, int wr, int wc, int fr, int fq) const {
        const int row0 = u.pm * BM + wr * 64 + fr; int colt = u.pn * BM; bf16_t* base = O;
        float sc = 1.f; if (split_cols) { const int t = colt / split_cols; base += (size_t)t * split_stride; colt -= t * split_cols; if (t == 0) sc = scale0; }
        const int col0 = colt + wc * 32 + 8 * fq, bcol0 = u.pn * BM + wc * 32 + 8 * fq;
        f32x4 bv[2][2];
#pragma unroll
        for (int bj = 0; bj < 2; ++bj)
#pragma unroll
            for (int n = 0; n < 2; ++n) bv[bj][n] = bias ? *(const f32x4*)(bias + bcol0 + bj * HALF + 4 * n) : (f32x4){0.f, 0.f, 0.f, 0.f};
#pragma unroll
        for (int ai = 0; ai < 2; ++ai)
#pragma unroll
            for (int m = 0; m < 4; ++m) { bf16_t* rowp = base + (size_t)(row0 + ai * HALF + m * 16) * ldc + col0;
#pragma unroll
                for (int bj = 0; bj < 2; ++bj) { f32x4 v0 = acc[ai][bj][m][0] + bv[bj][0], v1 = acc[ai][bj][m][1] + bv[bj][1];
                    if (ACT == 1) { f32x2 a = gelu_pk((f32x2){v0[0], v0[1]}), b = gelu_pk((f32x2){v0[2], v0[3]}), c = gelu_pk((f32x2){v1[0], v1[1]}), d = gelu_pk((f32x2){v1[2], v1[3]});
                        v0 = (f32x4){a.x, a.y, b.x, b.y}; v1 = (f32x4){c.x, c.y, d.x, d.y}; }
                    v0 = v0 * sc; v1 = v1 * sc; u32x4 w; w.x = cvt_pk_bf16(v0[0], v0[1]); w.y = cvt_pk_bf16(v0[2], v0[3]); w.z = cvt_pk_bf16(v1[0], v1[1]); w.w = cvt_pk_bf16(v1[2], v1[3]);
                    *(u32x4*)(rowp + bj * HALF) = w; } }
    }
};
template <class Epi, class Sched, bool ALIGN_EPI = false, bool SP2 = false>
__device__ __forceinline__ void gemm_phase(PG8_LAS unsigned char* lds, const Gemm g, const Sched& S, const Epi& E) {
    const int tid = threadIdx.x, wid = __builtin_amdgcn_readfirstlane(tid >> 6), lane = tid & 63, wr = wid >> 2, wc = wid & 3, fr = lane & 15, fq = lane >> 4;
    const int K = g.K, nt = K / BK;
    unsigned voffA[2], voffB[2];
#pragma unroll
    for (int i = 0; i < 2; ++i) { int R, C; stage_rc(tid * 16 + i * 8192, R, C); const int Rb = Epi::PERM ? ((R & ~31) + perm32(R & 31)) : R;
        voffA[i] = (unsigned)(R * K + C) * 2u; voffB[i] = (unsigned)(Rb * K + C) * 2u; }
    const size_t kstep = (size_t)(BK * 2);
    const size_t hstep = (size_t)HALF * K * 2;
    const size_t tstep = 2 * hstep;
    const unsigned ldsw = (unsigned)wid * 1024u;
    const int aoff = lds_byte(wr * 64 + fr, fq * 8), boff = lds_byte(wc * 32 + fr, fq * 8);
#define PG8_SA(b, h) (((b) * 2 + (h)) * HTB)
#define PG8_SB(b, h) ((4 + (b) * 2 + (h)) * HTB)
#define PG8_STAGE(bufoff, gbase, voff) do { _Pragma("unroll") for (int _i = 0; _i < 2; ++_i) \
        __builtin_amdgcn_global_load_lds((const unsigned*)((const char*)(gbase) + (voff)[_i]), (PG8_LAS unsigned*)(lds + (bufoff) + ldsw + _i * 8192), 16, 0, 0); } while (0)
#define PG8_LDA(dst, b, h) do { _Pragma("unroll") for (int m = 0; m < 4; ++m) _Pragma("unroll") for (int k = 0; k < 2; ++k) dst[m][k] = *(const PG8_LAS bf16x8*)(lds + PG8_SA(b, h) + aoff + m * 2048 + k * 1024); } while (0)
#define PG8_LDB(dst, b, h) do { _Pragma("unroll") for (int n = 0; n < 2; ++n) _Pragma("unroll") for (int k = 0; k < 2; ++k) dst[n][k] = *(const PG8_LAS bf16x8*)(lds + PG8_SB(b, h) + boff + n * 2048 + k * 1024); } while (0)
#define PG8_MMA(ai, bj, At, Bt) do { __builtin_amdgcn_s_setprio(1); _Pragma("unroll") for (int m = 0; m < 4; ++m) _Pragma("unroll") for (int n = 0; n < 2; ++n) _Pragma("unroll") for (int k = 0; k < 2; ++k) \
        acc[ai][bj][m][n] = __builtin_amdgcn_mfma_f32_16x16x32_bf16(Bt[n][k], At[m][k], acc[ai][bj][m][n], 0, 0, 0); __builtin_amdgcn_s_setprio(0); } while (0)
#define PG8_WAIT_V(n) asm volatile("s_waitcnt vmcnt(" #n ")" ::: "memory")
#define PG8_WAIT_L(n) asm volatile("s_waitcnt lgkmcnt(" #n ")" ::: "memory")
#define PG8_BAR __builtin_amdgcn_s_barrier()
#define PG8_SCHED __builtin_amdgcn_sched_barrier(0)
    Unit cur, nxt; int ui = 0;
    if (!S.next(0, cur)) return;
    f32x4 acc[2][2][4][2];
#pragma unroll
    for (int a = 0; a < 2; ++a)
#pragma unroll
        for (int b = 0; b < 2; ++b)
#pragma unroll
            for (int m = 0; m < 4; ++m)
#pragma unroll
                for (int n = 0; n < 2; ++n) acc[a][b][m][n] = (f32x4){0.f, 0.f, 0.f, 0.f};
    bf16x8 At[4][2], B0[2][2], B1[2][2];
    const char* cA = (const char*)g.A + (size_t)cur.pm * tstep; const char* cB = (const char*)g.Bt + (size_t)cur.pn * tstep;
    S.a_ready(cur);
    if constexpr (SP2) {
        PG8_STAGE(PG8_SB(0, 0), cB, voffB); PG8_STAGE(PG8_SB(0, 1), cB + hstep, voffB); PG8_STAGE(PG8_SA(0, 0), cA, voffA); PG8_STAGE(PG8_SA(0, 1), cA + hstep, voffA);
        if (wr == 1) PG8_BAR;
        PG8_WAIT_V(2); PG8_BAR;
        PG8_STAGE(PG8_SB(1, 0), cB + kstep, voffB); PG8_STAGE(PG8_SA(1, 0), cA + kstep, voffA); PG8_STAGE(PG8_SB(1, 1), cB + hstep + kstep, voffB);
        PG8_WAIT_V(6); PG8_BAR;
    } else {
        PG8_STAGE(PG8_SB(0, 0), cB, voffB); PG8_STAGE(PG8_SA(0, 0), cA, voffA); PG8_STAGE(PG8_SB(0, 1), cB + hstep, voffB); PG8_STAGE(PG8_SA(0, 1), cA + hstep, voffA);
        if (wr == 1) PG8_BAR;
        PG8_WAIT_V(4); PG8_BAR;
        PG8_STAGE(PG8_SB(1, 0), cB + kstep, voffB); PG8_STAGE(PG8_SA(1, 0), cA + kstep, voffA); PG8_STAGE(PG8_SB(1, 1), cB + hstep + kstep, voffB);
        PG8_WAIT_V(6); PG8_BAR;
    }
    for (;;) {
        const bool has_next = S.next(ui + 1, nxt);
        const char* nA = has_next ? (const char*)g.A + (size_t)nxt.pm * tstep : cA; const char* nB = has_next ? (const char*)g.Bt + (size_t)nxt.pn * tstep : cB;
        for (int t = 0; t < nt; t += 2) {
            const bool last = (t == nt - 2);
            const char* a1 = cA + (size_t)(t + 1) * kstep;
            const char* a2 = last ? nA : cA + (size_t)(t + 2) * kstep; const char* b2 = last ? nB : cB + (size_t)(t + 2) * kstep;
            const char* a3 = a2 + kstep; const char* b3 = b2 + kstep;
            if (last && has_next) S.a_ready(nxt);
            if constexpr (SP2) {
            PG8_LDB(B0, 0, 0); PG8_LDB(B1, 0, 1); PG8_SCHED; PG8_LDA(At, 0, 0); PG8_STAGE(PG8_SA(1, 1), a1 + hstep, voffA);
            PG8_WAIT_V(8); PG8_WAIT_L(0); PG8_BAR; PG8_MMA(0, 0, At, B0); PG8_MMA(0, 1, At, B1); PG8_BAR; PG8_SCHED;
            PG8_LDA(At, 0, 1); PG8_STAGE(PG8_SB(0, 0), b2, voffB); PG8_STAGE(PG8_SB(0, 1), b2 + hstep, voffB); PG8_STAGE(PG8_SA(0, 0), a2, voffA);
            PG8_WAIT_V(8); PG8_WAIT_L(0); PG8_BAR; PG8_MMA(1, 0, At, B0); PG8_MMA(1, 1, At, B1); PG8_BAR; PG8_SCHED;
            PG8_LDB(B0, 1, 0); PG8_LDB(B1, 1, 1); PG8_SCHED; PG8_LDA(At, 1, 0); PG8_STAGE(PG8_SA(0, 1), a2 + hstep, voffA);
            PG8_WAIT_V(8); PG8_WAIT_L(0); PG8_BAR; PG8_MMA(0, 0, At, B0); PG8_MMA(0, 1, At, B1); PG8_BAR; PG8_SCHED;
            PG8_LDA(At, 1, 1); PG8_STAGE(PG8_SB(1, 0), b3, voffB); PG8_STAGE(PG8_SB(1, 1), b3 + hstep, voffB); PG8_STAGE(PG8_SA(1, 0), a3, voffA);
            PG8_WAIT_V(8); PG8_WAIT_L(0); PG8_BAR; PG8_MMA(1, 0, At, B0); PG8_MMA(1, 1, At, B1); PG8_BAR; PG8_SCHED;
            } else {
            PG8_LDB(B0, 0, 0); PG8_SCHED; PG8_LDA(At, 0, 0); PG8_STAGE(PG8_SA(1, 1), a1 + hstep, voffA);
            PG8_WAIT_L(8); PG8_BAR; PG8_WAIT_L(0); PG8_MMA(0, 0, At, B0); PG8_BAR; PG8_SCHED;
            PG8_LDB(B1, 0, 1); PG8_STAGE(PG8_SB(0, 0), b2, voffB);
            PG8_BAR; PG8_WAIT_L(0); PG8_MMA(0, 1, At, B1); PG8_BAR;
            PG8_LDA(At, 0, 1); PG8_STAGE(PG8_SA(0, 0), a2, voffA);
            PG8_BAR; PG8_WAIT_L(0); PG8_MMA(1, 0, At, B0); PG8_BAR; PG8_SCHED;
            PG8_STAGE(PG8_SB(0, 1), b2 + hstep, voffB);
            PG8_WAIT_V(6); PG8_BAR; PG8_MMA(1, 1, At, B1); PG8_BAR;
            PG8_LDB(B0, 1, 0); PG8_SCHED; PG8_LDA(At, 1, 0); PG8_STAGE(PG8_SA(0, 1), a2 + hstep, voffA);
            PG8_WAIT_L(8); PG8_BAR; PG8_WAIT_L(0); PG8_MMA(0, 0, At, B0); PG8_BAR; PG8_SCHED;
            PG8_LDB(B1, 1, 1); PG8_STAGE(PG8_SB(1, 0), b3, voffB);
            PG8_BAR; PG8_WAIT_L(0); PG8_MMA(0, 1, At, B1); PG8_BAR;
            PG8_LDA(At, 1, 1); PG8_STAGE(PG8_SA(1, 0), a3, voffA);
            PG8_BAR; PG8_WAIT_L(0); PG8_MMA(1, 0, At, B0); PG8_BAR; PG8_SCHED;
            PG8_STAGE(PG8_SB(1, 1), b3 + hstep, voffB);
            PG8_WAIT_V(6); PG8_BAR; PG8_MMA(1, 1, At, B1); PG8_BAR;
            }
        }
        if constexpr (ALIGN_EPI) { if (wr == 0) PG8_BAR; }
        if constexpr (!Epi::AFTER_DRAIN) { E(acc, cur, wr, wc, fr, fq); S.done(cur); }
        if (!has_next) break;
#pragma unroll
        for (int a = 0; a < 2; ++a)
#pragma unroll
            for (int b = 0; b < 2; ++b)
#pragma unroll
                for (int m = 0; m < 4; ++m)
#pragma unroll
                    for (int n = 0; n < 2; ++n) acc[a][b][m][n] = (f32x4){0.f, 0.f, 0.f, 0.f};
        cur = nxt; cA = nA; cB = nB; ++ui;
        if constexpr (ALIGN_EPI) { if (wr == 1) PG8_BAR; }
    }
    PG8_WAIT_V(0);
    if constexpr (!ALIGN_EPI) { if (wr == 0) PG8_BAR; }
    PG8_BAR;
    if constexpr (Epi::AFTER_DRAIN) { E.fused(acc, cur, wr, wc, fr, fq, lds, wid, lane); S.done(cur); }
#undef PG8_SA
#undef PG8_SB
#undef PG8_STAGE
#undef PG8_LDA
#undef PG8_LDB
#undef PG8_MMA
#undef PG8_WAIT_V
#undef PG8_WAIT_L
#undef PG8_BAR
#undef PG8_SCHED
}
}
#include <hip/hip_bf16.h>
#include <cmath>
namespace attn_body {
using bf16=__hip_bfloat16;
using bf16x8=__attribute__((ext_vector_type(8)))short;
using s16x4=__attribute__((ext_vector_type(4)))short;
using f32x16=__attribute__((ext_vector_type(16)))float;
using u32x4=__attribute__((ext_vector_type(4)))unsigned;
constexpr int BATCH=2,NHEAD=8,NKVH=2,SEQ=8192,D=64,QP=512,KP=512,VP=512,OP=1024;
constexpr int NW=8,QBLK=32,QB=QBLK*NW,KVBLK=64,NQB=SEQ/QB;
constexpr int ATTN_UNIT_ROWS=QB;
__device__ __forceinline__ int crow(int r,int hi){return (r&3)+8*(r>>2)+4*hi;}
#define SBAR() __builtin_amdgcn_sched_barrier(0)
__device__ __forceinline__ void cmask(f32x16&p0,f32x16&p1,int jb,int qrel,int hi){
  const float NEG=-INFINITY; int kb=64*jb+4*hi;
  #pragma unroll
  for(int r=0;r<16;++r){int kv=kb+(r&3)+8*(r>>2); if(kv>qrel)p0[r]=NEG; if(kv+32>qrel)p1[r]=NEG;}
}

constexpr int NSLOT=3, SLOTB=8192;
constexpr int LDS_K=0, LDS_V=NSLOT*SLOTB, LDS_WS=2*NSLOT*SLOTB, LDS_OST=LDS_WS+NW*64*4, LDS_BYTES=LDS_OST+NW*4096;
constexpr float C2=0.125f*1.4426950408889634f;
__device__ __forceinline__ void glds16(const void*gsrc,unsigned lds_dst){unsigned keep;
  asm volatile("s_mov_b32 %0, m0\n\ts_mov_b32 m0, %2\n\ts_nop 0\n\tglobal_load_lds_dwordx4 %1, off\n\ts_mov_b32 m0, %0":"=&s"(keep):"v"(gsrc),"s"(lds_dst):"memory");}
__device__ __forceinline__ float max3f(float a,float b,float c){float r;asm("v_max3_f32 %0, %1, %2, %3":"=v"(r):"v"(a),"v"(b),"v"(c));return r;}
__device__ __forceinline__ float max2f(float a,float b){float r;asm("v_max_f32_e32 %0, %1, %2":"=v"(r):"v"(a),"v"(b));return r;}
__device__ __forceinline__ float fadd_s(float a,float b){float r;asm("v_add_f32_e32 %0, %1, %2":"=v"(r):"v"(a),"v"(b));return r;}
__device__ __forceinline__ float fsub_s(float a,float b){float r;asm("v_sub_f32_e32 %0, %1, %2":"=v"(r):"v"(a),"v"(b));return r;}
typedef float f32x2_t __attribute__((ext_vector_type(2))); typedef __bf16 bf16x2_t __attribute__((ext_vector_type(2)));
__device__ __forceinline__ unsigned cvtpk_s(float lo,float hi){f32x2_t v={lo,hi};bf16x2_t b=__builtin_convertvector(v,bf16x2_t);return __builtin_bit_cast(unsigned,b);}
#define WAIT_BAR(N) asm volatile("s_waitcnt vmcnt(" #N ") lgkmcnt(0)\n\ts_barrier":::"memory")

__device__ __forceinline__ void qkt(f32x16&p0,f32x16&p1,const char*Kslot,const bf16x8*qr,const f32x16&negm,int r32,int hi){
  const char*kb=Kslot+hi*1024+r32*16;
  #pragma unroll
  for(int d0=0;d0<4;++d0){
    const bf16x8 b0=*reinterpret_cast<const bf16x8*>(kb+d0*2048);
    const bf16x8 b1=*reinterpret_cast<const bf16x8*>(kb+d0*2048+512);
    if(d0==0){p0=__builtin_amdgcn_mfma_f32_32x32x16_bf16(b0,qr[0],negm,0,0,0);p1=__builtin_amdgcn_mfma_f32_32x32x16_bf16(b1,qr[0],negm,0,0,0);}
    else{p0=__builtin_amdgcn_mfma_f32_32x32x16_bf16(b0,qr[d0],p0,0,0,0);p1=__builtin_amdgcn_mfma_f32_32x32x16_bf16(b1,qr[d0],p1,0,0,0);}}
}
typedef __attribute__((address_space(3))) const char* lds_cptr;
typedef short v4i16_t __attribute__((ext_vector_type(4)));
__device__ __forceinline__ void kload8(bf16x8*kf,lds_cptr kp){
  kf[0]=*(const __attribute__((address_space(3))) bf16x8*)(kp);      kf[1]=*(const __attribute__((address_space(3))) bf16x8*)(kp+512);
  kf[2]=*(const __attribute__((address_space(3))) bf16x8*)(kp+2048); kf[3]=*(const __attribute__((address_space(3))) bf16x8*)(kp+2560);
  kf[4]=*(const __attribute__((address_space(3))) bf16x8*)(kp+4096); kf[5]=*(const __attribute__((address_space(3))) bf16x8*)(kp+4608);
  kf[6]=*(const __attribute__((address_space(3))) bf16x8*)(kp+6144); kf[7]=*(const __attribute__((address_space(3))) bf16x8*)(kp+6656);
}
__device__ __forceinline__ void kload2(bf16x8*kf,lds_cptr kp,int j){ kf[2*j]=*(const __attribute__((address_space(3))) bf16x8*)(kp+j*2048); kf[2*j+1]=*(const __attribute__((address_space(3))) bf16x8*)(kp+j*2048+512); }
__device__ __forceinline__ s16x4 vtr(lds_cptr p){ return __builtin_bit_cast(s16x4,__builtin_amdgcn_ds_read_tr16_b64_v4i16((__attribute__((address_space(3))) v4i16_t*)p)); }
__device__ __forceinline__ float rowmax(const f32x16&p0,const f32x16&p1){
  float a=max3f(p0[0],p0[1],p1[0]),b=max3f(p0[2],p0[3],p1[1]);a=max3f(a,p1[2],p1[3]);
  #pragma unroll
  for(int r=4;r<16;r+=4){a=max3f(a,p0[r],p0[r+1]);b=max3f(b,p0[r+2],p0[r+3]);a=max3f(a,p1[r],p1[r+1]);b=max3f(b,p1[r+2],p1[r+3]);}
  const float m=max2f(a,b);
  auto rr=__builtin_amdgcn_permlane32_swap(__float_as_uint(m),__float_as_uint(m),false,false);
  return max2f(__uint_as_float(rr[0]),__uint_as_float(rr[1]));
}
__device__ __forceinline__ void pv(f32x16*o,int vb,bf16x8 pa0,bf16x8 pa1,bf16x8 pa2,bf16x8 pa3){
  #pragma unroll
  for(int d0=0;d0<2;++d0){s16x4 lo[4],hi[4];
    #pragma unroll
    for(int ks=0;ks<4;++ks){
      asm volatile("ds_read_b64_tr_b16 %0,%1 offset:%c2":"=&v"(lo[ks]):"v"(vb),"i"(d0*4096+ks*1024):"memory");
      asm volatile("ds_read_b64_tr_b16 %0,%1 offset:%c2":"=&v"(hi[ks]):"v"(vb),"i"(d0*4096+ks*1024+512):"memory");}
    asm volatile("s_waitcnt lgkmcnt(0)":::"memory");SBAR();
    #define PK(k) (bf16x8){lo[k][0],lo[k][1],lo[k][2],lo[k][3],hi[k][0],hi[k][1],hi[k][2],hi[k][3]}
    o[d0]=__builtin_amdgcn_mfma_f32_32x32x16_bf16(pa0,PK(0),o[d0],0,0,0);
    o[d0]=__builtin_amdgcn_mfma_f32_32x32x16_bf16(pa1,PK(1),o[d0],0,0,0);
    o[d0]=__builtin_amdgcn_mfma_f32_32x32x16_bf16(pa2,PK(2),o[d0],0,0,0);
    o[d0]=__builtin_amdgcn_mfma_f32_32x32x16_bf16(pa3,PK(3),o[d0],0,0,0);
    #undef PK
  }
}

#ifndef ATTN_STORE16
#define ATTN_STORE16(p,v) (*(u32x4*)(p)=(v))
#endif
template<int THRL> __device__ __forceinline__ void attn_unit(int b,int h,int qb,const bf16*Q,const bf16*__restrict__ K,const bf16*__restrict__ V,bf16*O,char*shm){
  const int tid=threadIdx.x,lane=tid&63,r32=lane&31,hi=lane>>5; const int wid=__builtin_amdgcn_readfirstlane(tid>>6);
  const long rowbase=(long)b*SEQ; const int q0=qb*QB;
  const bf16*Qw=Q+(rowbase+q0+wid*QBLK)*QP+h*D; const int hk=h>>2;
  const bf16*Kh=K+rowbase*KP+hk*D,*Vh=V+rowbase*VP+hk*D;
  const unsigned lds0=(unsigned)(uintptr_t)shm;
  float*wsf=(float*)(shm+LDS_WS)+wid*64;
  const bf16*ksrc=Kh+(long)lane*KP+wid*8;
  const bf16*vsrc=Vh+(long)(16*(wid&3)+(lane>>2))*VP+(wid>>2)*32+(lane&3)*8;
  const unsigned kdst=lds0+LDS_K+wid*1024, vdst=lds0+LDS_V+wid*1024;
  #define DMA_K(t,slot) glds16(ksrc+(long)(t)*KVBLK*KP,(unsigned)__builtin_amdgcn_readfirstlane(kdst+(slot)))
  #define DMA_V(t,slot) glds16(vsrc+(long)(t)*KVBLK*VP,(unsigned)__builtin_amdgcn_readfirstlane(vdst+(slot)))
  const int vb0=(int)(lds0+LDS_V)+((lane>>4)&1)*32+(lane&3)*8+(4*hi+((lane&15)>>2))*64;
  const char*Kbase=shm+LDS_K; bf16x8 kf[8];
  const lds_cptr shm3=(lds_cptr)shm; const lds_cptr kp0=shm3+LDS_K+hi*1024+r32*16; const lds_cptr vp0=shm3+LDS_V+((lane>>4)&1)*32+(lane&3)*8+(4*hi+((lane&15)>>2))*64;
  const int NT=SEQ/KVBLK;
  DMA_K(0,0);DMA_V(0,0);DMA_K(1,SLOTB);
  bf16x8 qr[4];
  #pragma unroll
  for(int d0=0;d0<4;++d0)qr[d0]=*reinterpret_cast<const bf16x8*>(&Qw[(long)r32*QP+d0*16+hi*8]);
  float mhat=0.f,l_reg=0.f;f32x16 o[2];o[0]=f32x16{};o[1]=f32x16{};f32x16 negm=f32x16{};asm volatile("":"+v"(negm));

  #define CMASK(P0,P1,t) do{}while(0)
  bool resc=false;
  #define START(P0,P1) do{ const float rm=rowmax(P0,P1); resc=false; \
    { const float dl=rm; mhat=fadd_s(mhat,dl); \
      _Pragma("unroll") for(int r=0;r<16;++r){P0[r]=fsub_s(P0[r],dl);P1[r]=fsub_s(P1[r],dl);} \
      _Pragma("unroll") for(int r=0;r<16;++r)negm[r]=-mhat; asm volatile("":"+v"(negm)); } \
    _Pragma("unroll") for(int r=0;r<16;++r)P0[r]=__builtin_amdgcn_exp2f(P0[r]); }while(0)
  #define RESC() do{ if(resc){ asm volatile("s_waitcnt lgkmcnt(0)":::"memory"); \
      _Pragma("unroll") for(int d_=0;d_<2;++d_) _Pragma("unroll") for(int r=0;r<16;++r)o[d_][r]*=wsf[crow(r,hi)]; } }while(0)
  f32x16 pA0,pA1,pB0,pB1;
  int sl_prev=0,sl_cur=0,sl_next=SLOTB;
  #define ROT() do{sl_prev=sl_cur;sl_cur=sl_next;sl_next=(sl_next==(NSLOT-1)*SLOTB)?0:sl_next+SLOTB;}while(0)
  DMA_K(2,2*SLOTB);
  WAIT_BAR(3);
  qkt(pA0,pA1,Kbase,qr,negm,r32,hi);asm volatile("s_nop 15\n\ts_nop 7":"+v"(pA0),"+v"(pA1));CMASK(pA0,pA1,0);
  START(pA0,pA1);
  _Pragma("unroll") for(int r=0;r<16;++r)pA1[r]=__builtin_amdgcn_exp2f(pA1[r]);
  WAIT_BAR(0);
  DMA_K(3,0);DMA_V(1,SLOTB);
  ROT();
  kload8(kf,kp0+sl_cur);
  WAIT_BAR(2);
  s16x4 vlo[8],vhi[8]; u32x4 pw0,pw1,pw2,pw3;
  #define PKW(P,B) cvtpk_s(P[B],P[B+1])
  #define PAF(k) __builtin_bit_cast(bf16x8,pw##k)
  #define VFR(i) (bf16x8){vlo[i][0],vlo[i][1],vlo[i][2],vlo[i][3],vhi[i][0],vhi[i][1],vhi[i][2],vhi[i][3]}
  #define PIN(x) asm volatile("":"+v"(x))
  #define MX3(a,b,c) __builtin_fmaxf(__builtin_fmaxf((a),(b)),(c))
  #define GAPA(MF,A0,A1,A2,A3,W0,W1,PW) do{ MF; sacc+=A0; sacc+=A1; sacc+=A2; sacc+=A3; PIN(sacc); W0; W1; PIN(PW); SBAR(); }while(0)
  #define EX(v) __builtin_amdgcn_exp2f(v)
  #define GAPB(MF,X,B) do{ MF; X[B]=EX(X[B]); X[B+1]=EX(X[B+1]); X[B+2]=EX(X[B+2]); X[B+3]=EX(X[B+3]); PIN(X); SBAR(); }while(0)
  #define VRD(i) do{ vlo[i]=vtr(vp_+(((i)>>2)*4096+((i)&3)*1024)); vhi[i]=vtr(vp_+(((i)>>2)*4096+((i)&3)*1024+512)); }while(0)
  #define KRD(G,j) do{ if(G){ kload2(kf,kp0+sl_next,j); SBAR(); } }while(0)
  #define STEP(C0,C1,P0,P1,t,GK,GV,GL) do{ SBAR(); \
    const lds_cptr vp_=vp0+sl_prev; \
    VRD(0); SBAR(); float sacc=(P0[0]+P0[1]); \
    GAPA(C0=__builtin_amdgcn_mfma_f32_32x32x16_bf16(kf[0],qr[0],negm,0,0,0), P0[2],P0[3],P0[4],P0[5],     pw0[0]=PKW(P0,0), pw0[1]=PKW(P0,2), pw0); \
    VRD(4); SBAR(); GAPA(C1=__builtin_amdgcn_mfma_f32_32x32x16_bf16(kf[1],qr[0],negm,0,0,0), P0[6],P0[7],P0[8],P0[9],     pw0[2]=PKW(P0,4), pw0[3]=PKW(P0,6), pw0); \
    VRD(1); SBAR(); GAPA(C0=__builtin_amdgcn_mfma_f32_32x32x16_bf16(kf[2],qr[1],C0,0,0,0),   P0[10],P0[11],P0[12],P0[13], pw1[0]=PKW(P0,8), pw1[1]=PKW(P0,10), pw1); \
    VRD(5); SBAR(); GAPA(C1=__builtin_amdgcn_mfma_f32_32x32x16_bf16(kf[3],qr[1],C1,0,0,0),   P0[14],P0[15],P1[0],P1[1],   pw1[2]=PKW(P0,12),pw1[3]=PKW(P0,14), pw1); \
    VRD(2); SBAR(); GAPA(C0=__builtin_amdgcn_mfma_f32_32x32x16_bf16(kf[4],qr[2],C0,0,0,0),   P1[2],P1[3],P1[4],P1[5],     pw2[0]=PKW(P1,0), pw2[1]=PKW(P1,2), pw2); \
    VRD(6); SBAR(); GAPA(C1=__builtin_amdgcn_mfma_f32_32x32x16_bf16(kf[5],qr[2],C1,0,0,0),   P1[6],P1[7],P1[8],P1[9],     pw2[2]=PKW(P1,4), pw2[3]=PKW(P1,6), pw2); \
    VRD(3); SBAR(); GAPA(C0=__builtin_amdgcn_mfma_f32_32x32x16_bf16(kf[6],qr[3],C0,0,0,0),   P1[10],P1[11],P1[12],P1[13], pw3[0]=PKW(P1,8), pw3[1]=PKW(P1,10), pw3); \
    VRD(7); SBAR(); GAPA(C1=__builtin_amdgcn_mfma_f32_32x32x16_bf16(kf[7],qr[3],C1,0,0,0),   P1[14],P1[15],0.f,0.f,       pw3[2]=PKW(P1,12),pw3[3]=PKW(P1,14), pw3); \
    l_reg+=sacc; \
    if(GK){DMA_K((t)+3,sl_cur);} if(GV){DMA_V((t)+1,sl_next);} \
    CMASK(C0,C1,t); \
    { float a=MX3(C0[0],C0[1],C1[0]),b=MX3(C0[2],C0[3],C1[1]); a=MX3(a,C1[2],C1[3]); \
      _Pragma("unroll") for(int r=4;r<16;r+=4){a=MX3(a,C0[r],C0[r+1]);b=MX3(b,C0[r+2],C0[r+3]);a=MX3(a,C1[r],C1[r+1]);b=MX3(b,C1[r+2],C1[r+3]);} \
      float rm=__builtin_fmaxf(a,b); { auto rr=__builtin_amdgcn_permlane32_swap(__float_as_uint(rm),__float_as_uint(rm),false,false); rm=__builtin_fmaxf(__uint_as_float(rr[0]),__uint_as_float(rr[1])); } \
      resc=false; \
      if(__builtin_expect(__any(rm>(float)THRL),0)){ const float dl=__builtin_fmaxf(rm,0.f); mhat+=dl; \
        _Pragma("unroll") for(int r=0;r<16;++r){C0[r]-=dl;C1[r]-=dl;} \
        _Pragma("unroll") for(int r=0;r<16;++r)negm[r]=-mhat; asm volatile("":"+v"(negm)); \
        const float f=__builtin_amdgcn_exp2f(-dl); l_reg*=f; if(hi==0)wsf[r32]=f; resc=true; } } \
    SBAR(); \
    GAPB(o[0]=__builtin_amdgcn_mfma_f32_32x32x16_bf16(PAF(0),VFR(0),o[0],0,0,0), C0,0); \
    GAPB(o[1]=__builtin_amdgcn_mfma_f32_32x32x16_bf16(PAF(0),VFR(4),o[1],0,0,0), C0,4); \
    KRD(GL,0); GAPB(o[0]=__builtin_amdgcn_mfma_f32_32x32x16_bf16(PAF(1),VFR(1),o[0],0,0,0), C0,8); \
    KRD(GL,1); GAPB(o[1]=__builtin_amdgcn_mfma_f32_32x32x16_bf16(PAF(1),VFR(5),o[1],0,0,0), C0,12); \
    KRD(GL,2); GAPB(o[0]=__builtin_amdgcn_mfma_f32_32x32x16_bf16(PAF(2),VFR(2),o[0],0,0,0), C1,0); \
    KRD(GL,3); GAPB(o[1]=__builtin_amdgcn_mfma_f32_32x32x16_bf16(PAF(2),VFR(6),o[1],0,0,0), C1,4); \
    GAPB(o[0]=__builtin_amdgcn_mfma_f32_32x32x16_bf16(PAF(3),VFR(3),o[0],0,0,0), C1,8); \
    GAPB(o[1]=__builtin_amdgcn_mfma_f32_32x32x16_bf16(PAF(3),VFR(7),o[1],0,0,0), C1,12); \
    }while(0)
  int t=1;
  #undef CMASK
  #define CMASK(P0,P1,t) do{}while(0)
  for(;t+5<NT;t+=2){
    STEP(pB0,pB1,pA0,pA1,t,true,true,true);     WAIT_BAR(2); RESC(); ROT();
    STEP(pA0,pA1,pB0,pB1,t+1,true,true,true);   WAIT_BAR(2); RESC(); ROT();
  }
  #undef CMASK
  #define CMASK(P0,P1,t) do{}while(0)
  #define ENDW(tt) do{ if((tt)+3<NT){WAIT_BAR(2);} else if((tt)+2<NT){WAIT_BAR(1);} else {WAIT_BAR(0);} }while(0)
  for(;t+1<NT;t+=2){
    STEP(pB0,pB1,pA0,pA1,t,(t+3<NT),(t+1<NT),(t+1<NT));       ENDW(t);   RESC(); ROT();
    STEP(pA0,pA1,pB0,pB1,t+1,(t+4<NT),(t+2<NT),(t+2<NT));     ENDW(t+1); RESC(); ROT();
  }
  STEP(pB0,pB1,pA0,pA1,NT-1,false,false,false); RESC();
  { float sacc=pB0[0]+pB0[1]; _Pragma("unroll") for(int r=2;r<16;++r)sacc+=pB0[r]; _Pragma("unroll") for(int r=0;r<16;++r)sacc+=pB1[r]; l_reg+=sacc;
    pw0=(u32x4){PKW(pB0,0),PKW(pB0,2),PKW(pB0,4),PKW(pB0,6)};pw1=(u32x4){PKW(pB0,8),PKW(pB0,10),PKW(pB0,12),PKW(pB0,14)};pw2=(u32x4){PKW(pB1,0),PKW(pB1,2),PKW(pB1,4),PKW(pB1,6)};pw3=(u32x4){PKW(pB1,8),PKW(pB1,10),PKW(pB1,12),PKW(pB1,14)};
    SBAR(); pv(o,vb0+sl_cur,PAF(0),PAF(1),PAF(2),PAF(3)); }
  #undef PKW
  #undef PAF
  #undef VFR
  #undef PIN
  #undef MX3
  #undef GAPA
  #undef GAPB
  #undef EX
  #undef VRD
  #undef KRD
  #undef STEP
  #undef ENDW
  {auto rr=__builtin_amdgcn_permlane32_swap(__float_as_uint(l_reg),__float_as_uint(l_reg),false,false);l_reg=__uint_as_float(rr[0])+__uint_as_float(rr[1]);}
  if(hi==0)wsf[32+r32]=l_reg;asm volatile("s_waitcnt lgkmcnt(0)":::"memory");
  float rli[16];
  #pragma unroll
  for(int r=0;r<16;++r)rli[r]=__builtin_amdgcn_rcpf(wsf[32+crow(r,hi)]);
  bf16*Ow=O+(rowbase+q0+wid*QBLK)*OP+h*D;
  { bf16*stg=(bf16*)(shm+LDS_OST)+wid*2048;
    #pragma unroll
    for(int r=0;r<16;++r){const int orow=crow(r,hi);
      #pragma unroll
      for(int d0=0;d0<2;++d0)stg[orow*64+d0*32+r32]=__float2bfloat16(o[d0][r]*rli[r]);}
    asm volatile("s_waitcnt lgkmcnt(0)":::"memory");
    #pragma unroll
    for(int i=0;i<4;++i){const int row=i*8+(lane>>3),ch=lane&7; const u32x4 v=*(const u32x4*)(stg+row*64+ch*8); ATTN_STORE16(Ow+(long)row*OP+ch*8,v);} }
  asm volatile("s_waitcnt lgkmcnt(0)\n\ts_barrier":::"memory");
  #undef DMA_K
  #undef DMA_V
  #undef CMASK
  #undef START
  #undef RESC
  #undef ROT
}
constexpr int ATTN_LDS_BYTES=LDS_BYTES;
struct AttnTensors { const bf16* Q; const bf16* K; const bf16* V; bf16* O; };
struct AttnUnit { int bh; int qb; };
struct StaticOrder {
  int vcu;
  __device__ __forceinline__ explicit StaticOrder(int vcu_):vcu(vcu_){}
  __device__ __forceinline__ bool next(int i,AttnUnit&u)const{ if(i>=2)return false; const int p=vcu>>6, li=vcu&63, un=li*2+i; u.bh=(p>>1)*NHEAD+(p&1)*4+(un>>5); u.qb=un&31; return true; }
  __device__ __forceinline__ void a_ready(const AttnUnit&)const{}
  __device__ __forceinline__ void done(const AttnUnit&)const{}
};
template<class Sched,int THRL=8> __device__ __forceinline__ void attn_phase(char*lds,const AttnTensors&T,const Sched&S){
  AttnUnit u;
  for(int i=0;S.next(i,u);++i){ S.a_ready(u); attn_unit<THRL>(u.bh/NHEAD,u.bh%NHEAD,u.qb,T.Q,T.K,T.V,T.O,lds); S.done(u); }
}
#undef SBAR
#undef WAIT_BAR
}
#define GAS __attribute__((address_space(1)))
#define LAS __attribute__((address_space(3)))
typedef unsigned short bf16;
typedef unsigned v4u __attribute__((ext_vector_type(4)));
typedef float f32x4 __attribute__((ext_vector_type(4)));
typedef short bf16x8 __attribute__((ext_vector_type(8)));
typedef GAS unsigned gu32;
typedef GAS unsigned long long gu64;
#define RLX_AGENT __ATOMIC_RELAXED, __HIP_MEMORY_SCOPE_AGENT
#define LDS_WAIT() asm volatile("s_waitcnt lgkmcnt(0)" ::: "memory")
#define VM_WAIT() asm volatile("s_waitcnt vmcnt(0)" ::: "memory")
__device__ __forceinline__ unsigned long long rt() { return __builtin_amdgcn_s_memrealtime(); }
__device__ __forceinline__ unsigned f2bf(float f) { unsigned u = __builtin_bit_cast(unsigned, f); return (u + 0x7fffu + ((u >> 16) & 1u)) >> 16; }
__device__ __forceinline__ unsigned pk2(float lo, float hi) { return f2bf(lo) | (f2bf(hi) << 16); }
#define XB_TMO      128
#define XB_XCNT(j)  (256  + 64 * (j))
#define XB_XSUB(j)  (1280 + 64 * (j))
#define XB_XGEN(j)  (2304 + 64 * (j))
#define XB_TOP      3328
#define XB_TOPGEN   3392
#define XCD_BAR_WORDS 3456
#define XB_SPIN_CAP (1u << 18)

__device__ __forceinline__ unsigned xb_ld(unsigned* p)              { return __hip_atomic_load(p, __ATOMIC_RELAXED, __HIP_MEMORY_SCOPE_AGENT); }
__device__ __forceinline__ unsigned xb_add(unsigned* p, unsigned v) { return __hip_atomic_fetch_add(p, v, __ATOMIC_RELAXED, __HIP_MEMORY_SCOPE_AGENT); }
__device__ __forceinline__ unsigned xb_xcc_id() { return (unsigned)__builtin_amdgcn_s_getreg((3 << 11) | 20) & 0xFu; }
#define XB_SPIN(cond, bar) do { unsigned _sp = 0; while (cond) { __builtin_amdgcn_s_sleep(1); \
    if ((++_sp & 255u) == 0u) { if (xb_ld(&(bar)[XB_TMO])) break; if (_sp > XB_SPIN_CAP) { atomicAdd(&(bar)[XB_TMO], 1u); break; } } } } while (0)

struct XcdBarrier {
    unsigned* bar; unsigned x;
    volatile LAS unsigned* st;
};

__device__ __forceinline__ XcdBarrier xcd_barrier_post(unsigned* bar, volatile LAS unsigned* st) {
    XcdBarrier b; b.bar = bar; b.x = xb_xcc_id(); b.st = st;
    if (threadIdx.x == 0) (void)xb_add(&bar[XB_XCNT(b.x)], 1u);
    return b;
}
__device__ __forceinline__ void xcd_barrier_complete(unsigned* bar, unsigned x, unsigned& nloc, unsigned& nx) {
    const unsigned G = gridDim.x * gridDim.y * gridDim.z;
    unsigned sum, cnt, mine, sp = 0u;
    for (;;) {
        sum = 0u; cnt = 0u; mine = 0u;
#pragma unroll
        for (unsigned j = 0; j < 16; ++j) { const unsigned c = xb_ld(&bar[XB_XCNT(j)]); sum += c; cnt += (c > 0u) ? 1u : 0u; mine = (j == x) ? c : mine; }
        if (sum == G) break;
        __builtin_amdgcn_s_sleep(1);
        if ((++sp & 255u) == 0u) { if (xb_ld(&bar[XB_TMO])) break; if (sp > XB_SPIN_CAP) { atomicAdd(&bar[XB_TMO], 1u); break; } }
    }
    nloc = mine > 0u ? mine : 1u; nx = cnt > 0u ? cnt : 1u;
}

__device__ __forceinline__ void xcd_barrier(const XcdBarrier& b) {
    asm volatile("s_waitcnt vmcnt(0)" ::: "memory");
    __syncthreads();
    if (threadIdx.x == 0) {
        unsigned* bar = b.bar;
        __builtin_amdgcn_s_waitcnt(0);
        unsigned nloc = b.st[0], nx = b.st[1];
        if (nloc == 0u) { xcd_barrier_complete(bar, b.x, nloc, nx); b.st[0] = nloc; b.st[1] = nx; }
        const unsigned old = xb_add(&bar[XB_XSUB(b.x)], 1u);
        const unsigned gen = old / nloc;
        if (old + 1u == (gen + 1u) * nloc) {
            __builtin_amdgcn_fence(__ATOMIC_RELEASE, "agent");
            asm volatile("s_waitcnt vmcnt(0)" ::: "memory");
            const unsigned og = xb_add(&bar[XB_TOP], 1u);
            const unsigned tg = og / nx;
            if (og + 1u == (tg + 1u) * nx) xb_add(&bar[XB_TOPGEN], 1u);
            else XB_SPIN(xb_ld(&bar[XB_TOPGEN]) == tg, bar);
            __builtin_amdgcn_fence(__ATOMIC_ACQUIRE, "agent");
            xb_add(&bar[XB_XGEN(b.x)], 1u);
            asm volatile("s_waitcnt vmcnt(0)" ::: "memory");
        } else {
            XB_SPIN(xb_ld(&bar[XB_XGEN(b.x)]) == gen, bar);
            __builtin_amdgcn_fence(__ATOMIC_ACQUIRE, "agent");
            asm volatile("s_waitcnt vmcnt(0)" ::: "memory");
        }
    }
    __syncthreads();
}

namespace pg8 {
struct EpiSwiGLU {
    static constexpr bool PERM = true, AFTER_DRAIN = false;
    bf16_t* O; int ldc;
    __device__ __forceinline__ void operator()(const f32x4 (&acc)[2][2][4][2], const Unit& u, int wr, int wc, int fr, int fq) const {
        const int row0 = u.pm * BM + wr * 64 + fr; const int col0 = u.pn * HALF + wc * 32 + 8 * fq;
#pragma unroll
        for (int ai = 0; ai < 2; ++ai)
#pragma unroll
            for (int m = 0; m < 4; ++m) { bf16_t* rowp = O + (size_t)(row0 + ai * HALF + m * 16) * ldc + col0;
                float r[8];
#pragma unroll
                for (int n = 0; n < 2; ++n)
#pragma unroll
                    for (int i = 0; i < 4; ++i) { const float g = acc[ai][0][m][n][i], up = acc[ai][1][m][n][i];
                        const float e = __builtin_amdgcn_exp2f(-g * 1.4426950408889634f); r[n * 4 + i] = g * __builtin_amdgcn_rcpf(1.0f + e) * up; }
                u32x4 w; w.x = cvt_pk_bf16(r[0], r[1]); w.y = cvt_pk_bf16(r[2], r[3]); w.z = cvt_pk_bf16(r[4], r[5]); w.w = cvt_pk_bf16(r[6], r[7]);
                *(u32x4*)rowp = w; }
    }
};
}

constexpr int NWAVES = 8;
constexpr int BATCH = 2, SEQ = 8192, D = 1024, M = BATCH * SEQ, FFH = 2816;
constexpr float EPS = 1e-6f;
constexpr int NKEY = 387, NKEYP = 392;

constexpr size_t MiB = 1u << 20, HMiB = 1u << 19;
constexpr size_t WS_CTL = 0, CTL_ZERO_BYTES = 1 * MiB;
constexpr size_t WS_SMALL = 1 * MiB;
constexpr size_t SM_MOD = 0;
constexpr size_t SM_BIAST = 131072;
constexpr size_t SM_LB = 147456;
constexpr size_t SM_TW = 262144;
constexpr size_t WS_WINAB = 2 * MiB, WS_WOUTAB = 10 * MiB, WS_WINCD = 12 * MiB, WS_WOUTCD = 14 * MiB + HMiB;
constexpr size_t WS_WF1 = 16 * MiB + HMiB, WF1_BYTES = 11 * MiB, WS_WF2 = 38 * MiB + HMiB, WF2_BYTES = 5 * MiB + HMiB;
constexpr size_t WS_XN = 50 * MiB, WS_YB = 82 * MiB, WS_Z = 114 * MiB, WS_END = 242 * MiB;
constexpr size_t SEG = (size_t)M * 512;
constexpr int CW_BAR = 4096;

constexpr int RING_OFF = 0, RING_BYTES = 131072;
constexpr int TAB_OFF = RING_BYTES;
constexpr int LDSCTL_OFF = RING_BYTES + 1024, MISC_OFF = LDSCTL_OFF + 320;
constexpr int LDS_BYTES = 147456;

__device__ __forceinline__ float bf2f(unsigned short h) { return __builtin_bit_cast(float, (unsigned)h << 16); }
__device__ __forceinline__ float bflo(unsigned w) { return __builtin_bit_cast(float, w << 16); }
__device__ __forceinline__ float bfhi(unsigned w) { return __builtin_bit_cast(float, w & 0xffff0000u); }
__device__ __forceinline__ float wave_sum(float v) {
#pragma unroll
    for (int o = 1; o < 64; o <<= 1) v += __shfl_xor(v, o);
    return v;
}
__device__ __forceinline__ float wave_max(float v) {
#pragma unroll
    for (int o = 1; o < 64; o <<= 1) v = fmaxf(v, __shfl_xor(v, o));
    return v;
}
__device__ __forceinline__ float rdlane(float v, int j) { return __builtin_bit_cast(float, __builtin_amdgcn_readlane(__builtin_bit_cast(int, v), j)); }
__device__ __forceinline__ float siluf(float g) { return g / (1.0f + __expf(-g)); }

struct Frame {
    LAS unsigned char* lds;
    volatile LAS unsigned* MISC;
    gu32* ctl;
    int tid, lane, wave, vcu, G;
    const float *x, *c, *t5, *lbl, *ada_w, *ada_b, *gains, *ab_in, *ab_out, *hnorm, *cd_in, *cd_out, *qkn, *f_in, *f_out;
    float* out;
    unsigned char* ws;
};

__device__ __forceinline__ void p_adaln(Frame& F) {
    LAS float* red = (LAS float*)(F.lds + RING_OFF);
    float* MOD = (float*)(F.ws + WS_SMALL + SM_MOD);
    const int r4 = F.lane >> 4, c4 = F.lane & 15;
    for (int task = blockIdx.x; task < 192; task += F.G) {
        const int l = task / 96, cg = task % 96;
        const float* W = F.ada_w + (size_t)l * 1024 * 6144 + cg * 64 + 4 * c4;
        f32x4 a0 = {0.f, 0.f, 0.f, 0.f}, a1 = {0.f, 0.f, 0.f, 0.f};
#pragma unroll 4
        for (int i = 0; i < 32; ++i) {
            const int row = 128 * F.wave + 4 * i + r4;
            const f32x4 wv = *(const f32x4*)(W + (size_t)row * 6144);
            const float c0 = F.c[row], c1 = F.c[1024 + row];
            a0 += siluf(c0) * wv; a1 += siluf(c1) * wv;
        }
#pragma unroll
        for (int i = 0; i < 4; ++i) { a0[i] += __shfl_xor(a0[i], 16); a0[i] += __shfl_xor(a0[i], 32); a1[i] += __shfl_xor(a1[i], 16); a1[i] += __shfl_xor(a1[i], 32); }
        if (r4 == 0) {
#pragma unroll
            for (int i = 0; i < 4; ++i) { red[(F.wave * 2 + 0) * 64 + 4 * c4 + i] = a0[i]; red[(F.wave * 2 + 1) * 64 + 4 * c4 + i] = a1[i]; }
        }
        __syncthreads();
        if (F.tid < 128) { const int b = F.tid >> 6, col = F.tid & 63; float s = 0.f;
#pragma unroll
            for (int w = 0; w < 8; ++w) s += red[(w * 2 + b) * 64 + col];
            MOD[(l * 2 + b) * 6144 + cg * 64 + col] = s + F.ada_b[l * 6144 + cg * 64 + col]; }
        __syncthreads();
    }
    if ((int)blockIdx.x == F.G - 1) {
        float* BT = (float*)(F.ws + WS_SMALL + SM_BIAST);
        for (int idx = F.tid; idx < NKEY; idx += NWAVES * 64) {
            const int r = idx / 129, j = idx - r * 129 - 64, d = (r == 0) ? 1 : (r == 1) ? 4 : 16, rel = j * d, n = rel < 0 ? -rel : rel;
            int large = 8 + (int)(log((double)(n > 1 ? n : 1) / 8.0) / log(128.0) * 8.0); if (large > 15) large = 15;
            const int bucket = (rel > 0 ? 16 : 0) + (n < 8 ? n : large);
#pragma unroll
            for (int h = 0; h < 8; ++h) BT[h * NKEYP + idx] = F.t5[bucket * 8 + h];
        }
    }
    if ((int)blockIdx.x == F.G - 2) {
        float* LB = (float*)(F.ws + WS_SMALL + SM_LB);
        for (int i = F.tid; i < 1024; i += NWAVES * 64) {
            const float l0 = F.lbl[i], l1 = F.lbl[1024 + i], l2 = F.lbl[2048 + i]; const float mx = fmaxf(l0, fmaxf(l1, l2));
            const float e0 = expf(l0 - mx), e1 = expf(l1 - mx), e2 = expf(l2 - mx); LB[i] = e0 / (e0 + e1 + e2);
        }
    }
    if ((int)blockIdx.x >= F.G - 18 && (int)blockIdx.x < F.G - 2) {
        float* TW = (float*)(F.ws + WS_SMALL + SM_TW);
        const int j = ((int)blockIdx.x - (F.G - 18)) * 512 + F.tid;
        const double a = (double)j * (6.283185307179586476925286766559 / 8192.0);
        TW[j] = (float)cos(a); TW[8192 + j] = (float)sin(a);
    }
}

__device__ __forceinline__ void transpose_item(const float* W, int K, int N, bf16* WT, int dest_row0, int k0, int n0, LAS float* scr, int lane) {
#pragma unroll 8
    for (int i = 0; i < 32; ++i) { const int kk = 2 * i + (lane >> 5); scr[kk * 33 + (lane & 31)] = W[(size_t)(k0 + kk) * N + n0 + (lane & 31)]; }
    LDS_WAIT(); asm volatile("" ::: "memory");
    const int c = lane & 7;
#pragma unroll
    for (int j = 0; j < 4; ++j) { const int n = (lane >> 3) + 8 * j; const LAS float* s = scr + (8 * c) * 33 + n;
        v4u o; o.x = pk2(s[0 * 33], s[1 * 33]); o.y = pk2(s[2 * 33], s[3 * 33]); o.z = pk2(s[4 * 33], s[5 * 33]); o.w = pk2(s[6 * 33], s[7 * 33]);
        *(GAS v4u*)(WT + (size_t)(dest_row0 + n) * K + k0 + 8 * c) = o; }
    LDS_WAIT(); asm volatile("" ::: "memory");
}
__device__ __forceinline__ void p_weights(Frame& F) {
    LAS float* scr = (LAS float*)(F.lds + RING_OFF + F.wave * 16384);
    const int gw = F.vcu * NWAVES + F.wave, NGW = F.G * NWAVES;
    constexpr int I_ABI = 16 * 128, I_ABO = 16 * 32, I_CDI = 16 * 40, I_CDO = 16 * 32, I_F1 = 16 * 176, I_F2 = 44 * 32;
    constexpr int NITEMS = I_ABI + I_ABO + I_CDI + I_CDO + 2 * I_F1 + 2 * I_F2;
    for (int it = gw; it < NITEMS; it += NGW) {
        int r = it;
        if (r < I_ABI) { const int nb = 128, kb = r / nb, n0 = 32 * (r % nb); transpose_item(F.ab_in, 1024, 4096, (bf16*)(F.ws + WS_WINAB), n0, 64 * kb, n0, scr, F.lane); continue; } r -= I_ABI;
        if (r < I_ABO) { const int nb = 32, kb = r / nb, n0 = 32 * (r % nb); transpose_item(F.ab_out, 1024, 1024, (bf16*)(F.ws + WS_WOUTAB), n0, 64 * kb, n0, scr, F.lane); continue; } r -= I_ABO;
        if (r < I_CDI) { const int nb = 40, kb = r / nb, n0 = 32 * (r % nb); transpose_item(F.cd_in, 1024, 1280, (bf16*)(F.ws + WS_WINCD), n0, 64 * kb, n0, scr, F.lane); continue; } r -= I_CDI;
        if (r < I_CDO) { const int nb = 32, kb = r / nb, n0 = 32 * (r % nb); transpose_item(F.cd_out, 1024, 1024, (bf16*)(F.ws + WS_WOUTCD), n0, 64 * kb, n0, scr, F.lane); continue; } r -= I_CDO;
        if (r < 2 * I_F1) { const int l = r / I_F1; r -= l * I_F1; const int nb = 176, kb = r / nb, n0 = 32 * (r % nb);
            const int up = n0 >= FFH ? 1 : 0, j = n0 - up * FFH, drow = 256 * (j >> 7) + 128 * up + (j & 127);
            transpose_item(F.f_in + (size_t)l * 1024 * 5632, 1024, 5632, (bf16*)(F.ws + WS_WF1 + l * WF1_BYTES), drow, 64 * kb, n0, scr, F.lane); continue; } r -= 2 * I_F1;
        { const int l = r / I_F2; r -= l * I_F2; const int nb = 32, kb = r / nb, n0 = 32 * (r % nb);
            transpose_item(F.f_out + (size_t)l * FFH * 1024, FFH, 1024, (bf16*)(F.ws + WS_WF2 + l * WF2_BYTES), n0, 64 * kb, n0, scr, F.lane); }
    }
}
__device__ __forceinline__ void p_rows(Frame& F, const float* xin, const bf16* y, const float* gate_mod  , const float* gain_post,
                                       float* xout, const float* mod_next  , const float* gain_pre, bf16* xn) {
    const int gw = F.vcu * NWAVES + F.wave, NGW = F.G * NWAVES;
    for (int b = 0; b < BATCH; ++b) {
        f32x4 A1[4], A2[4], B2[4];
#pragma unroll
        for (int j = 0; j < 4; ++j) { const int col = 4 * F.lane + 256 * j;
            if (y) { const f32x4 g = *(const f32x4*)(gate_mod + b * 6144 + col), gp = *(const f32x4*)(gain_post + col); A1[j] = g * gp; } else A1[j] = (f32x4){0.f, 0.f, 0.f, 0.f};
            if (mod_next) { const f32x4 sh = *(const f32x4*)(mod_next + b * 6144 + col), sc = *(const f32x4*)(mod_next + b * 6144 + 1024 + col), gp = *(const f32x4*)(gain_pre + col);
                A2[j] = gp * (sc + 1.0f); B2[j] = sh; } else { A2[j] = (f32x4){0.f, 0.f, 0.f, 0.f}; B2[j] = A2[j]; } }
        for (int m = b * SEQ + gw; m < (b + 1) * SEQ; m += NGW) {
            f32x4 v[4];
#pragma unroll
            for (int j = 0; j < 4; ++j) v[j] = *(const f32x4*)(xin + (size_t)m * D + 4 * F.lane + 256 * j);
            if (y) {
                f32x4 yv[4]; float ss = 0.f;
#pragma unroll
                for (int j = 0; j < 4; ++j) { const uint2 w = *(const uint2*)(y + (size_t)m * D + 4 * F.lane + 256 * j);
                    yv[j] = (f32x4){bflo(w.x), bfhi(w.x), bflo(w.y), bfhi(w.y)}; ss += (yv[j].x * yv[j].x + yv[j].y * yv[j].y) + (yv[j].z * yv[j].z + yv[j].w * yv[j].w); }
                const float rs = 1.0f / sqrtf(wave_sum(ss) * (1.0f / D) + EPS);
#pragma unroll
                for (int j = 0; j < 4; ++j) v[j] = v[j] + A1[j] * (yv[j] * rs);
            }
            if (xout) {
#pragma unroll
                for (int j = 0; j < 4; ++j) *(f32x4*)(xout + (size_t)m * D + 4 * F.lane + 256 * j) = v[j];
            }
            if (mod_next) {
                float ss = 0.f;
#pragma unroll
                for (int j = 0; j < 4; ++j) ss += (v[j].x * v[j].x + v[j].y * v[j].y) + (v[j].z * v[j].z + v[j].w * v[j].w);
                const float rs = 1.0f / sqrtf(wave_sum(ss) * (1.0f / D) + EPS);
#pragma unroll
                for (int j = 0; j < 4; ++j) { const f32x4 h = (v[j] * rs) * A2[j] + B2[j];
                    uint2 w; w.x = pk2(h.x, h.y); w.y = pk2(h.z, h.w); *(uint2*)(xn + (size_t)m * D + 4 * F.lane + 256 * j) = w; }
            }
        }
    }
}

__device__ __forceinline__ void p_dilated_naive(Frame& F, const bf16* Q, const bf16* K, const bf16* V, bf16* O  ) {
    const float* BT = (const float*)(F.ws + WS_SMALL + SM_BIAST);
    const int gw = F.vcu * NWAVES + F.wave, NGW = F.G * NWAVES, lane = F.lane;
    for (int item = gw; item < M * 8; item += NGW) {
        const int m = item >> 3, h = item & 7, b = m >> 13, t = m & 8191;
        float qf[64];
        { const uint4* qp = (const uint4*)(Q + (size_t)m * 512 + h * 64);
#pragma unroll
          for (int i = 0; i < 8; ++i) { const uint4 w = qp[i]; qf[8 * i + 0] = bflo(w.x); qf[8 * i + 1] = bfhi(w.x); qf[8 * i + 2] = bflo(w.y); qf[8 * i + 3] = bfhi(w.y);
              qf[8 * i + 4] = bflo(w.z); qf[8 * i + 5] = bfhi(w.z); qf[8 * i + 6] = bflo(w.w); qf[8 * i + 7] = bfhi(w.w); } }
        float lg[7]; int posv[7]; float mx = -3.0e38f;
#pragma unroll
        for (int g = 0; g < 7; ++g) {
            const int idx = g * 64 + lane; float l = -3.0e38f; int pos = t;
            if (idx < NKEY) { const int r = idx / 129, j = idx - r * 129 - 64, d = (r == 0) ? 1 : (r == 1) ? 4 : 16; pos = t + j * d;
                if (pos >= 0 && pos < SEQ) { const uint4* kp = (const uint4*)(K + (size_t)(b * SEQ + pos) * 512 + h * 64); float dot = 0.f;
#pragma unroll
                    for (int i = 0; i < 8; ++i) { const uint4 w = kp[i]; dot += qf[8 * i + 0] * bflo(w.x) + qf[8 * i + 1] * bfhi(w.x) + qf[8 * i + 2] * bflo(w.y) + qf[8 * i + 3] * bfhi(w.y)
                                                                            + qf[8 * i + 4] * bflo(w.z) + qf[8 * i + 5] * bfhi(w.z) + qf[8 * i + 6] * bflo(w.w) + qf[8 * i + 7] * bfhi(w.w); }
                    l = dot * 0.125f + BT[h * NKEYP + idx]; } else pos = t; }
            lg[g] = l; posv[g] = pos; mx = fmaxf(mx, l);
        }
        mx = wave_max(mx);
        float s = 0.f;
#pragma unroll
        for (int g = 0; g < 7; ++g) { lg[g] = (lg[g] > -1.0e38f) ? __expf(lg[g] - mx) : 0.f; s += lg[g]; }
        s = wave_sum(s);
        float acc = 0.f; const bf16* Vb = V + (size_t)b * SEQ * 512 + h * 64 + lane;
#pragma unroll
        for (int g = 0; g < 7; ++g) { const int n = (g < 6) ? 64 : (NKEY - 384);
            for (int j = 0; j < n; ++j) { const float pj = rdlane(lg[g], j); const int pos = __builtin_amdgcn_readlane(posv[g], j);
                if (pj != 0.f) acc += pj * bf2f(Vb[(size_t)pos * 512]); } }
        O[(size_t)m * 1024 + h * 64 + lane] = (bf16)f2bf(acc / s);
    }
}

__device__ __forceinline__ void p_hgrn_naive(Frame& F, const bf16* Qh, const bf16* Ff, const bf16* Fb, const bf16* Ih, float* Odir) {
    const float* LB = (const float*)(F.ws + WS_SMALL + SM_LB);
    constexpr int TT = 32;
    LAS float* qs = (LAS float*)(F.lds + RING_OFF);
    LAS float* fa = qs + TT * 128;
    LAS float* vv = fa + TT * 128;
    const int tid = F.tid, lane = F.lane, vi = lane & 1, kq = lane >> 1;
    for (int item = blockIdx.x; item < 128; item += F.G) {
        const int chain = item >> 3, vs = item & 7, dir = chain >> 3, b = (chain >> 2) & 1, h = chain & 3;
        const bf16* Fp = dir ? Fb : Ff;
        float S[4] = {0.f, 0.f, 0.f, 0.f};
        const int vcol = h * 128 + vs * 16 + F.wave * 2 + vi;
        for (int s0 = 0; s0 < SEQ; s0 += TT) {
            __syncthreads();
            { const int tt = tid >> 4, k0 = (tid & 15) * 8; const int t = dir ? (SEQ - 1 - (s0 + tt)) : (s0 + tt); const size_t row = (size_t)(b * SEQ + t) * 512 + h * 128 + k0;
              const uint4 qw = *(const uint4*)(Qh + row), fw = *(const uint4*)(Fp + row);
              const unsigned qa[4] = {qw.x, qw.y, qw.z, qw.w}, fb_[4] = {fw.x, fw.y, fw.z, fw.w};
#pragma unroll
              for (int i = 0; i < 4; ++i) {
                  const float lb0 = LB[dir * 512 + h * 128 + k0 + 2 * i], lb1 = LB[dir * 512 + h * 128 + k0 + 2 * i + 1];
                  qs[tt * 128 + k0 + 2 * i] = bflo(qa[i]) * 0.08838834764831845f; qs[tt * 128 + k0 + 2 * i + 1] = bfhi(qa[i]) * 0.08838834764831845f;
                  fa[tt * 128 + k0 + 2 * i] = lb0 + (1.0f - lb0) / (1.0f + __expf(-bflo(fb_[i]))); fa[tt * 128 + k0 + 2 * i + 1] = lb1 + (1.0f - lb1) / (1.0f + __expf(-bfhi(fb_[i]))); }
              if (tid < TT * 16) { const int tv = tid >> 4, vc = tid & 15; const int t2 = dir ? (SEQ - 1 - (s0 + tv)) : (s0 + tv);
                  vv[tv * 16 + vc] = bf2f(Ih[(size_t)(b * SEQ + t2) * 512 + h * 128 + vs * 16 + vc]); } }
            __syncthreads();
#pragma unroll 4
            for (int tt = 0; tt < TT; ++tt) {
                const f32x4 f4 = *(const LAS f32x4*)(fa + tt * 128 + 4 * kq), q4 = *(const LAS f32x4*)(qs + tt * 128 + 4 * kq); const float v = vv[tt * 16 + F.wave * 2 + vi];
                float o = 0.f;
#pragma unroll
                for (int i = 0; i < 4; ++i) { S[i] = f4[i] * S[i] + (1.0f - f4[i]) * v; o += q4[i] * S[i]; }
                o += __shfl_xor(o, 2); o += __shfl_xor(o, 4); o += __shfl_xor(o, 8); o += __shfl_xor(o, 16); o += __shfl_xor(o, 32);
                if (kq == 0) { const int t = dir ? (SEQ - 1 - (s0 + tt)) : (s0 + tt); Odir[((size_t)dir * M + (size_t)(b * SEQ + t)) * 512 + vcol] = o; }
            }
        }
    }
}
__device__ __forceinline__ void p_hgrn_final(Frame& F, const float* Odir, const bf16* Gh, bf16* O) {
    const int gw = F.vcu * NWAVES + F.wave, NGW = F.G * NWAVES, lane = F.lane;
    const float g0 = F.hnorm[2 * lane], g1 = F.hnorm[2 * lane + 1];
    for (int item = gw; item < M * 4; item += NGW) {
        const int m = item >> 2, h = item & 3; const size_t off = (size_t)m * 512 + h * 128 + 2 * lane;
        const float2 a = *(const float2*)(Odir + off), c = *(const float2*)(Odir + (size_t)M * 512 + off);
        const float o0 = a.x + c.x, o1 = a.y + c.y; const float rs = 1.0f / sqrtf(wave_sum(o0 * o0 + o1 * o1) * (1.0f / 128.0f) + EPS);
        const unsigned gw2 = *(const unsigned*)(Gh + off); const float r0 = o0 * rs * g0 * siluf(bflo(gw2)), r1 = o1 * rs * g1 * siluf(bfhi(gw2));
        *(unsigned*)(O + (size_t)m * 1024 + 512 + h * 128 + 2 * lane) = pk2(r0, r1);
    }
}

__device__ __forceinline__ void tab128_init(Frame& F) {
    LAS float* T = (LAS float*)(F.lds + TAB_OFF);
    if (F.tid < 128) { float s, c; sincospif((float)F.tid * (1.0f / 64.0f), &s, &c); T[F.tid] = c; T[128 + F.tid] = s; }
    __syncthreads();
}
__device__ __forceinline__ void p_fnet1_naive(Frame& F, const bf16* U  , float* APR, float* API) {
    const float* TW = (const float*)(F.ws + WS_SMALL + SM_TW);
    LAS float* T = (LAS float*)(F.lds + TAB_OFF);
    LAS float* Us = (LAS float*)(F.lds + RING_OFF);
    LAS float* Zr = Us + 64 * 129 + 64;
    LAS float* Zi = Zr + 64 * 128;
    tab128_init(F);
    const int tid = F.tid, kc = tid & 127, grp = tid >> 7;
    for (int unit = blockIdx.x; unit < 2 * 4 * 128; unit += F.G) {
        const int b = unit >> 9, g = (unit >> 7) & 3, n2 = unit & 127;
        __syncthreads();
        { const int row = tid >> 3, c0 = (tid & 7) * 16; const uint4* p = (const uint4*)(U + (size_t)(b * SEQ + 128 * row + n2) * 512 + g * 128 + c0);
#pragma unroll
          for (int i = 0; i < 2; ++i) { const uint4 w = p[i]; LAS float* d = Us + row * 129 + c0 + 8 * i;
              d[0] = bflo(w.x); d[1] = bfhi(w.x); d[2] = bflo(w.y); d[3] = bfhi(w.y); d[4] = bflo(w.z); d[5] = bfhi(w.z); d[6] = bflo(w.w); d[7] = bfhi(w.w); } }
        __syncthreads();
        { float zr[16], zi[16];
#pragma unroll
          for (int i = 0; i < 16; ++i) { zr[i] = 0.f; zi[i] = 0.f; }
          for (int c = 0; c < 128; ++c) { const int idx = (c * kc) & 127; const float cs = T[idx], sn = T[128 + idx];
#pragma unroll
              for (int i = 0; i < 16; ++i) { const float u = Us[(grp * 16 + i) * 129 + c]; zr[i] += u * cs; zi[i] -= u * sn; } }
#pragma unroll
          for (int i = 0; i < 16; ++i) { Zr[(grp * 16 + i) * 128 + kc] = zr[i]; Zi[(grp * 16 + i) * 128 + kc] = zi[i]; } }
        __syncthreads();
        { float ar[16], ai[16];
#pragma unroll
          for (int i = 0; i < 16; ++i) { ar[i] = 0.f; ai[i] = 0.f; }
          for (int n1 = 0; n1 < 64; ++n1) { const float zr = Zr[n1 * 128 + kc], zi = Zi[n1 * 128 + kc];
#pragma unroll
              for (int i = 0; i < 16; ++i) { const int idx = (2 * n1 * (grp * 16 + i)) & 127; const float cs = T[idx], sn = T[128 + idx]; ar[i] += zr * cs + zi * sn; ai[i] += zi * cs - zr * sn; } }
#pragma unroll
          for (int i = 0; i < 16; ++i) { const int k1 = grp * 16 + i; const float ct = TW[n2 * k1], st = TW[8192 + n2 * k1];
              const size_t o = ((size_t)((b * 4 + g) * 128 + n2) * 64 + k1) * 128 + kc;
              APR[o] = ar[i] * ct + ai[i] * st; API[o] = ai[i] * ct - ar[i] * st; } }
    }
}
__device__ __forceinline__ void p_fnet2_naive(Frame& F, const float* APR, const float* API, bf16* O) {
    LAS float* T = (LAS float*)(F.lds + TAB_OFF);
    LAS float* Ar = (LAS float*)(F.lds + RING_OFF);
    LAS float* Ai = Ar + 128 * 128;
    tab128_init(F);
    const int tid = F.tid, kc = tid & 127, grp = tid >> 7;
    for (int unit = blockIdx.x; unit < 2 * 4 * 64; unit += F.G) {
        const int b = unit >> 8, g = (unit >> 6) & 3, k1 = unit & 63;
        __syncthreads();
        for (int e = tid; e < 128 * 128 / 4; e += NWAVES * 64) { const int n2 = e >> 5, c4 = (e & 31) * 4; const size_t o = ((size_t)((b * 4 + g) * 128 + n2) * 64 + k1) * 128 + c4;
            *(LAS f32x4*)(Ar + n2 * 128 + c4) = *(const f32x4*)(APR + o); *(LAS f32x4*)(Ai + n2 * 128 + c4) = *(const f32x4*)(API + o); }
        __syncthreads();
        float y[32];
#pragma unroll
        for (int i = 0; i < 32; ++i) y[i] = 0.f;
        for (int n2 = 0; n2 < 128; ++n2) { const float ar = Ar[n2 * 128 + kc], ai = Ai[n2 * 128 + kc];
#pragma unroll
            for (int i = 0; i < 32; ++i) { const int idx = (n2 * (grp * 32 + i)) & 127; y[i] += ar * T[idx] + ai * T[128 + idx]; } }
#pragma unroll
        for (int i = 0; i < 32; ++i) { const int k2 = grp * 32 + i; O[(size_t)(b * SEQ + k1 + 64 * k2) * 1024 + g * 128 + kc] = (bf16)f2bf(y[i] * (1.0f / 1024.0f)); }
    }
}

__device__ __forceinline__ void p_qkprep(Frame& F, bf16* QD, bf16* KV, float qscale) {
    const int gw = F.vcu * NWAVES + F.wave, NGW = F.G * NWAVES, lane = F.lane;
    const float invf = powf(10000.0f, -(float)(lane & 15) * (1.0f / 16.0f));
    const float gq = F.qkn[lane], gk = F.qkn[64 + lane];
    for (int m = gw; m < M; m += NGW) {
        const int t = m & 8191; const float pos = (lane < 32) ? (float)(t >> 6) : (float)(t & 63); const float ang = pos * invf; const float cs = cosf(ang), sn = sinf(ang);
#pragma unroll
        for (int hh = 0; hh < 10; ++hh) {
            bf16* p = (hh < 8) ? (QD + (size_t)m * 512 + hh * 64 + lane) : (KV + (size_t)m * 512 + (hh - 8) * 64 + lane);
            const float x = bf2f(*p); const float rs = 1.0f / sqrtf(wave_sum(x * x) * (1.0f / 64.0f) + EPS); const float xn = x * rs * ((hh < 8) ? gq : gk);
            const float xp = __shfl_xor(xn, 16);
            const float r = (lane & 16) ? (xp * sn + xn * cs) : (xn * cs - xp * sn);
            *p = (bf16)f2bf(r * ((hh < 8) ? qscale : 1.0f));
        }
    }
}
__device__ __forceinline__ void p_gqa_naive(Frame& F, const bf16* QD, const bf16* KV, bf16* O) {
    const int gw = F.vcu * NWAVES + F.wave, NGW = F.G * NWAVES, lane = F.lane;
    for (int item = gw; item < M * 8; item += NGW) {
        const int m = item >> 3, hq = item & 7, b = m >> 13, hk = hq >> 2;
        float qf[64];
        { const uint4* qp = (const uint4*)(QD + (size_t)m * 512 + hq * 64);
#pragma unroll
          for (int i = 0; i < 8; ++i) { const uint4 w = qp[i]; qf[8 * i + 0] = bflo(w.x); qf[8 * i + 1] = bfhi(w.x); qf[8 * i + 2] = bflo(w.y); qf[8 * i + 3] = bfhi(w.y);
              qf[8 * i + 4] = bflo(w.z); qf[8 * i + 5] = bfhi(w.z); qf[8 * i + 6] = bflo(w.w); qf[8 * i + 7] = bfhi(w.w); } }
        float mrun = -3.0e38f, srun = 0.f, acc = 0.f;
        const bf16* Kb = KV + (size_t)b * SEQ * 512 + hk * 64; const bf16* Vb = KV + (size_t)b * SEQ * 512 + 128 + hk * 64 + lane;
        for (int kg = 0; kg < SEQ / 64; ++kg) {
            const uint4* kp = (const uint4*)(Kb + (size_t)(kg * 64 + lane) * 512); float dot = 0.f;
#pragma unroll
            for (int i = 0; i < 8; ++i) { const uint4 w = kp[i]; dot += qf[8 * i + 0] * bflo(w.x) + qf[8 * i + 1] * bfhi(w.x) + qf[8 * i + 2] * bflo(w.y) + qf[8 * i + 3] * bfhi(w.y)
                                                                    + qf[8 * i + 4] * bflo(w.z) + qf[8 * i + 5] * bfhi(w.z) + qf[8 * i + 6] * bflo(w.w) + qf[8 * i + 7] * bfhi(w.w); }
            const float mnew = fmaxf(mrun, wave_max(dot)); const float corr = __expf(mrun - mnew); const float p = __expf(dot - mnew);
            srun = srun * corr + wave_sum(p); acc *= corr; mrun = mnew;
#pragma unroll 8
            for (int j = 0; j < 64; ++j) acc += rdlane(p, j) * bf2f(Vb[(size_t)(kg * 64 + j) * 512]);
        }
        O[(size_t)m * 1024 + 512 + hq * 64 + lane] = (bf16)f2bf(acc / srun);
    }
}

namespace dil {
typedef short bf16x8 __attribute__((ext_vector_type(8)));
typedef short s16x4 __attribute__((ext_vector_type(4)));
typedef float f32x16 __attribute__((ext_vector_type(16)));
typedef unsigned u32x4v __attribute__((ext_vector_type(4)));
typedef unsigned u32x2v __attribute__((ext_vector_type(2)));
typedef short v4i16_t __attribute__((ext_vector_type(4)));
#define DIL_LAS __attribute__((address_space(3)))
constexpr float LOG2E = 1.4426950408889634f, C2 = 0.125f * LOG2E, THR = 8.0f;
constexpr int BT_OFF = 0, BT_H = 396, BT_BR = 132;
constexpr int WAVE_OFF = 12800, WAVE_BYTES = 8192;
constexpr int LDS_NEED = WAVE_OFF + 8 * WAVE_BYTES;
__device__ __forceinline__ unsigned cvtpk(float lo, float hi) { typedef float f2 __attribute__((ext_vector_type(2))); typedef __bf16 b2 __attribute__((ext_vector_type(2))); f2 v = {lo, hi}; b2 r = __builtin_convertvector(v, b2); return __builtin_bit_cast(unsigned, r); }
__device__ __forceinline__ s16x4 vtr(const DIL_LAS char* p) { return __builtin_bit_cast(s16x4, __builtin_amdgcn_ds_read_tr16_b64_v4i16((DIL_LAS v4i16_t*)p)); }
__device__ __forceinline__ float halfmax(float v) { auto rr = __builtin_amdgcn_permlane32_swap(__float_as_uint(v), __float_as_uint(v), false, false); return fmaxf(__uint_as_float(rr[0]), __uint_as_float(rr[1])); }
__device__ __forceinline__ float halfsum(float v) { auto rr = __builtin_amdgcn_permlane32_swap(__float_as_uint(v), __float_as_uint(v), false, false); return __uint_as_float(rr[0]) + __uint_as_float(rr[1]); }

__device__ __forceinline__ void tile_desc(int t, int it, int rho, int i0, int& base_tok, int& stride, int& dbase, bool& kindA, bool& tvalid) {
    if (t < 17) { const int a = (t == 0) ? 8 : ((t - 1 < 8) ? t - 1 : t); kindA = true; tvalid = (unsigned)(it - 8 + a) < 64u; base_tok = 4 * (i0 - 256 + 32 * a) + rho; stride = 4; dbase = 32 * (a - 8); }
    else { const int e = t - 17; kindA = false; tvalid = (unsigned)(4 * it - 2 + e) < 256u; base_tok = 128 * it - 64 + 32 * e; stride = 1; dbase = 32 * (e - 2) - rho; }
    if (!tvalid) base_tok = 0;
}

__device__ __forceinline__ void job(const unsigned short* __restrict__ Qg, const unsigned short* __restrict__ Kg, const unsigned short* __restrict__ Vg, unsigned short* Og,
                                    int b, int h, int rho, int it, DIL_LAS char* lbase, int wave, int lane) {
    const int c = lane & 31, hi = lane >> 5, i0 = 32 * it;
    const size_t rowb = (size_t)b * 8192;
    const int posq = 4 * (i0 + c) + rho;
    bf16x8 qf[4];
#pragma unroll
    for (int ks = 0; ks < 4; ++ks) qf[ks] = *(const bf16x8*)(Qg + (rowb + posq) * 512 + h * 64 + 16 * ks + 8 * hi);
    const DIL_LAS float* bt = (const DIL_LAS float*)(lbase + BT_OFF) + h * BT_H;
    DIL_LAS char* vbuf = lbase + WAVE_OFF + wave * WAVE_BYTES;
    const int krow = lane & 31, vrow = lane >> 1, vdh = lane & 1;
    const int vtro = ((lane >> 4) & 1) * 32 + (lane & 3) * 8 + (4 * hi + ((lane & 15) >> 2)) * 64;
    f32x16 o0, o1;
#pragma unroll
    for (int r = 0; r < 16; ++r) { o0[r] = 0.f; o1[r] = 0.f; }
    float lsum = 0.f, mhat = 0.f;
    int base_tok, stride, dbase; bool kindA, tvalid;
    tile_desc(0, it, rho, i0, base_tok, stride, dbase, kindA, tvalid);
    bf16x8 kc[4]; u32x4v vr[4];
    { const unsigned short* kp = Kg + (rowb + base_tok + stride * krow) * 512 + h * 64 + 8 * hi;
#pragma unroll
      for (int ks = 0; ks < 4; ++ks) kc[ks] = *(const bf16x8*)(kp + 16 * ks);
      const unsigned short* vp = Vg + (rowb + base_tok + stride * vrow) * 512 + h * 64 + 32 * vdh;
#pragma unroll
      for (int i = 0; i < 4; ++i) vr[i] = *(const u32x4v*)(vp + 8 * i); }
    for (int t = 0; t < 25; ++t) {
        DIL_LAS char* vb = vbuf + (t & 1) * 4096;
#pragma unroll
        for (int i = 0; i < 4; ++i) *(DIL_LAS u32x4v*)(vb + vdh * 2048 + vrow * 64 + 16 * i) = vr[i];
        const int dbase_c = dbase; const bool kindA_c = kindA, tvalid_c = tvalid;
        bf16x8 kn[4];
        if (t + 1 < 25) {
            tile_desc(t + 1, it, rho, i0, base_tok, stride, dbase, kindA, tvalid);
            const unsigned short* kp = Kg + (rowb + base_tok + stride * krow) * 512 + h * 64 + 8 * hi;
#pragma unroll
            for (int ks = 0; ks < 4; ++ks) kn[ks] = *(const bf16x8*)(kp + 16 * ks);
            const unsigned short* vp = Vg + (rowb + base_tok + stride * vrow) * 512 + h * 64 + 32 * vdh;
#pragma unroll
            for (int i = 0; i < 4; ++i) vr[i] = *(const u32x4v*)(vp + 8 * i);
        } else {
#pragma unroll
            for (int ks = 0; ks < 4; ++ks) kn[ks] = kc[ks];
        }
        f32x16 acc;
#pragma unroll
        for (int r = 0; r < 16; ++r) acc[r] = 0.f;
#pragma unroll
        for (int ks = 0; ks < 4; ++ks) acc = __builtin_amdgcn_mfma_f32_32x32x16_bf16(kc[ks], qf[ks], acc, 0, 0, 0);
        const int cm = kindA_c ? c : 4 * c;
        const int d0 = dbase_c + 4 * hi - cm;
        const int tb1 = kindA_c ? BT_BR : 0;
        const float NEG = -INFINITY;
        f32x16 t1, t2;
        float rm = NEG;
#pragma unroll
        for (int r = 0; r < 16; ++r) {
            const int dl = d0 + (r & 3) + 8 * (r >> 2);
            const bool v1 = tvalid_c && dl >= -64 && dl <= 64;
            int i1 = dl + 64; i1 = i1 < 0 ? 0 : (i1 > 128 ? 128 : i1);
            const float s = acc[r] * C2;
            t1[r] = v1 ? s + bt[tb1 + i1] : NEG;
            rm = fmaxf(rm, t1[r]);
        }
        if (kindA_c) {
#pragma unroll
            for (int r = 0; r < 16; ++r) {
                const int dl = d0 + (r & 3) + 8 * (r >> 2);
                const bool v2 = tvalid_c && ((dl & 3) == 0) && dl >= -256 && dl <= 256;
                int i2 = (dl >> 2) + 64; i2 = i2 < 0 ? 0 : (i2 > 128 ? 128 : i2);
                t2[r] = v2 ? acc[r] * C2 + bt[2 * BT_BR + i2] : NEG;
                rm = fmaxf(rm, t2[r]);
            }
        } else {
#pragma unroll
            for (int r = 0; r < 16; ++r) t2[r] = NEG;
        }
        rm = halfmax(rm);
        if (t == 0) { mhat = rm; }
        else {
            const float d = rm - mhat;
            if (__any(d > THR)) { const float dl = fmaxf(d, 0.f); mhat += dl; const float f = __builtin_amdgcn_exp2f(-dl); lsum *= f;
#pragma unroll
                for (int r = 0; r < 16; ++r) { o0[r] *= f; o1[r] *= f; } }
        }
        float p[16]; float ps = 0.f;
#pragma unroll
        for (int r = 0; r < 16; ++r) { p[r] = __builtin_amdgcn_exp2f(t1[r] - mhat) + __builtin_amdgcn_exp2f(t2[r] - mhat); ps += p[r]; }
        lsum += ps;
        u32x4v pw0, pw1;
        pw0[0] = cvtpk(p[0], p[1]); pw0[1] = cvtpk(p[2], p[3]); pw0[2] = cvtpk(p[4], p[5]); pw0[3] = cvtpk(p[6], p[7]);
        pw1[0] = cvtpk(p[8], p[9]); pw1[1] = cvtpk(p[10], p[11]); pw1[2] = cvtpk(p[12], p[13]); pw1[3] = cvtpk(p[14], p[15]);
        const bf16x8 pf0 = __builtin_bit_cast(bf16x8, pw0), pf1 = __builtin_bit_cast(bf16x8, pw1);
        const DIL_LAS char* vt = vb + vtro;
#pragma unroll
        for (int dt = 0; dt < 2; ++dt) {
            const s16x4 a0 = vtr(vt + dt * 2048), a1 = vtr(vt + dt * 2048 + 512), b0 = vtr(vt + dt * 2048 + 1024), b1 = vtr(vt + dt * 2048 + 1536);
            const bf16x8 vf0 = {a0[0], a0[1], a0[2], a0[3], a1[0], a1[1], a1[2], a1[3]}, vf1 = {b0[0], b0[1], b0[2], b0[3], b1[0], b1[1], b1[2], b1[3]};
            if (dt == 0) { o0 = __builtin_amdgcn_mfma_f32_32x32x16_bf16(vf0, pf0, o0, 0, 0, 0); o0 = __builtin_amdgcn_mfma_f32_32x32x16_bf16(vf1, pf1, o0, 0, 0, 0); }
            else         { o1 = __builtin_amdgcn_mfma_f32_32x32x16_bf16(vf0, pf0, o1, 0, 0, 0); o1 = __builtin_amdgcn_mfma_f32_32x32x16_bf16(vf1, pf1, o1, 0, 0, 0); }
        }
#pragma unroll
        for (int ks = 0; ks < 4; ++ks) kc[ks] = kn[ks];
    }
    const float inv = 1.0f / halfsum(lsum);
    unsigned short* op = Og + (rowb + posq) * 1024 + h * 64 + 4 * hi;
#pragma unroll
    for (int g = 0; g < 4; ++g) {
        u32x2v w0, w1;
        w0[0] = cvtpk(o0[4 * g] * inv, o0[4 * g + 1] * inv); w0[1] = cvtpk(o0[4 * g + 2] * inv, o0[4 * g + 3] * inv);
        w1[0] = cvtpk(o1[4 * g] * inv, o1[4 * g + 1] * inv); w1[1] = cvtpk(o1[4 * g + 2] * inv, o1[4 * g + 3] * inv);
        *(u32x2v*)(op + 8 * g) = w0; *(u32x2v*)(op + 32 + 8 * g) = w1;
    }
}
}

__device__ __forceinline__ void p_dilated(Frame& F, const bf16* Q, const bf16* K, const bf16* V, bf16* O  ) {
    const float* BT = (const float*)(F.ws + WS_SMALL + SM_BIAST);
    LAS float* bt = (LAS float*)(F.lds + RING_OFF + dil::BT_OFF);
    __syncthreads();
    for (int idx = F.tid; idx < 8 * NKEY; idx += NWAVES * 64) { const int h = idx / NKEY, rem = idx - h * NKEY, br = rem / 129, j = rem - br * 129;
        bt[h * dil::BT_H + br * dil::BT_BR + j] = BT[h * NKEYP + rem] * dil::LOG2E; }
    __syncthreads();
    const int gw = F.vcu * NWAVES + F.wave, NGW = F.G * NWAVES;
    for (int j = gw; j < 4096; j += NGW) { const int s = j >> 11, g = j & 2047, bh = 2 * (g >> 8) + s, w256 = g & 255;
        dil::job(Q, K, V, O, bh >> 3, bh & 7, w256 & 3, w256 >> 2, (LAS char*)(F.lds + RING_OFF), F.wave, F.lane); }
    __syncthreads();
}

#ifndef MK_ONE_LAUNCH
#define MK_ONE_LAUNCH 1
#endif
constexpr int N_PHASES = 18;
struct Args { const float* in[15]; float* out; unsigned char* ws; int ph_lo, ph_hi; };
__global__ void __launch_bounds__(NWAVES * 64, 2) mk_fwd(Args args) {
    extern __shared__ __attribute__((aligned(16))) unsigned char lds[];
    Frame F;
    F.lds = (LAS unsigned char*)lds;
    F.MISC = (volatile LAS unsigned*)(F.lds + MISC_OFF);
    F.tid = threadIdx.x; F.lane = F.tid & 63; F.wave = __builtin_amdgcn_readfirstlane(F.tid >> 6);
    F.G = gridDim.x; { const int bx = blockIdx.x; F.vcu = (F.G % 8 == 0) ? (bx % 8) * (F.G / 8) + bx / 8 : bx; }
    F.ws = args.ws; F.ctl = (gu32*)(args.ws + WS_CTL);
    F.x = args.in[0]; F.c = args.in[1]; F.t5 = args.in[2]; F.lbl = args.in[3]; F.ada_w = args.in[4]; F.ada_b = args.in[5]; F.gains = args.in[6];
    F.ab_in = args.in[7]; F.ab_out = args.in[8]; F.hnorm = args.in[9]; F.cd_in = args.in[10]; F.cd_out = args.in[11]; F.qkn = args.in[12]; F.f_in = args.in[13]; F.f_out = args.in[14];
    F.out = args.out;
    for (int u = F.tid; u < (LDS_BYTES - LDSCTL_OFF) / 4; u += NWAVES * 64) ((LAS unsigned*)(F.lds + LDSCTL_OFF))[u] = 0u;
    __syncthreads();
    XcdBarrier bar; bar.bar = (unsigned*)(F.ctl + CW_BAR); bar.x = 0; bar.st = nullptr;
    if (MK_ONE_LAUNCH) bar = xcd_barrier_post((unsigned*)(F.ctl + CW_BAR), F.MISC + 8);
    const int lo = args.ph_lo, hi = args.ph_hi;
#define IN(k) (lo <= (k) && (k) < hi)
#define SEAM(k) do { if (MK_ONE_LAUNCH && IN(k) && IN((k) + 1)) xcd_barrier(bar); } while (0)
    unsigned char* ws = args.ws;
    float* MOD = (float*)(ws + WS_SMALL + SM_MOD);
    bf16* XN = (bf16*)(ws + WS_XN); bf16* YB = (bf16*)(ws + WS_YB); bf16* Z = (bf16*)(ws + WS_Z);
    bf16* H = Z;
    const float* G0 = F.gains; const float* G1 = F.gains + 4 * 1024;
    float* MOD0 = MOD; float* MOD1 = MOD + 2 * 6144;

    if (IN(0)) { p_adaln(F); } SEAM(0);
    if (IN(1)) { p_weights(F); p_rows(F, F.x, nullptr, nullptr, nullptr, nullptr, MOD0, G0, XN); } SEAM(1);
    if (IN(2)) { pg8::Gemm g{XN, (const bf16*)(ws + WS_WINAB), M, 4096, 1024}; pg8::StaticOrder S; S.init(M, 4096, F.G, (int)blockIdx.x);
        pg8::EpiBf16<0> E{Z, 512, nullptr, 512, SEG, 1.0f};
        pg8::gemm_phase<pg8::EpiBf16<0>, pg8::StaticOrder, true, true>(F.lds + RING_OFF, g, S, E); } SEAM(2);
    if (IN(3)) { p_hgrn_naive(F, Z + 3 * SEG, Z + 4 * SEG, Z + 5 * SEG, Z + 6 * SEG, F.out);
                 p_dilated(F, Z, Z + SEG, Z + 2 * SEG, XN); } SEAM(3);
    if (IN(4)) { p_hgrn_final(F, F.out, Z + 7 * SEG, XN); } SEAM(4);
    if (IN(5)) { pg8::Gemm g{XN, (const bf16*)(ws + WS_WOUTAB), M, 1024, 1024}; pg8::StaticOrder S; S.init(M, 1024, F.G, (int)blockIdx.x);
        pg8::EpiBf16<0> E{YB, 1024, nullptr, 0, 0, 1.0f};
        pg8::gemm_phase<pg8::EpiBf16<0>, pg8::StaticOrder, true, true>(F.lds + RING_OFF, g, S, E); } SEAM(5);
    if (IN(6)) { p_rows(F, F.x, YB, MOD0 + 2048, G0 + 1024, F.out, MOD0 + 3072, G0 + 2048, XN); } SEAM(6);
    if (IN(7)) { pg8::Gemm g{XN, (const bf16*)(ws + WS_WF1), M, 2 * FFH, 1024}; pg8::StaticOrder S; S.init(M, 2 * FFH, F.G, (int)blockIdx.x);
        pg8::EpiSwiGLU E{H, FFH};
        pg8::gemm_phase<pg8::EpiSwiGLU, pg8::StaticOrder, true, true>(F.lds + RING_OFF, g, S, E); } SEAM(7);
    if (IN(8)) { pg8::Gemm g{H, (const bf16*)(ws + WS_WF2), M, 1024, FFH}; pg8::StaticOrder S; S.init(M, 1024, F.G, (int)blockIdx.x);
        pg8::EpiBf16<0> E{YB, 1024, nullptr, 0, 0, 1.0f};
        pg8::gemm_phase<pg8::EpiBf16<0>, pg8::StaticOrder, true, true>(F.lds + RING_OFF, g, S, E); } SEAM(8);
    if (IN(9)) { p_rows(F, F.out, YB, MOD0 + 5120, G0 + 3072, F.out, MOD1, G1, XN); } SEAM(9);
    if (IN(10)) { pg8::Gemm g{XN, (const bf16*)(ws + WS_WINCD), M, 1280, 1024}; pg8::StaticOrder S; S.init(M, 1280, F.G, (int)blockIdx.x);
        pg8::EpiBf16<0> E{Z, 512, nullptr, 512, SEG, 1.0f};
        pg8::gemm_phase<pg8::EpiBf16<0>, pg8::StaticOrder, true, true>(F.lds + RING_OFF, g, S, E); } SEAM(10);
    bf16* MIX1 = Z + 4 * SEG;
    float* APR = (float*)(ws + WS_XN); float* API = APR + (size_t)2 * 4 * 128 * 64 * 128;
    if (IN(11)) { p_qkprep(F, Z + SEG, Z + 2 * SEG, attn_body::C2); p_fnet1_naive(F, Z, APR, API); } SEAM(11);
    if (IN(12)) { p_fnet2_naive(F, APR, API, MIX1); __syncthreads();
        const attn_body::AttnTensors AT{(const attn_body::bf16*)(Z + SEG), (const attn_body::bf16*)(Z + 2 * SEG), (const attn_body::bf16*)(Z + 2 * SEG + 128), (attn_body::bf16*)(MIX1 + 512)};
        const attn_body::StaticOrder S(F.vcu);
        attn_body::attn_phase<attn_body::StaticOrder>((char*)lds + RING_OFF, AT, S); } SEAM(12);
    if (IN(13)) { pg8::Gemm g{MIX1, (const bf16*)(ws + WS_WOUTCD), M, 1024, 1024}; pg8::StaticOrder S; S.init(M, 1024, F.G, (int)blockIdx.x);
        pg8::EpiBf16<0> E{YB, 1024, nullptr, 0, 0, 1.0f};
        pg8::gemm_phase<pg8::EpiBf16<0>, pg8::StaticOrder, true, true>(F.lds + RING_OFF, g, S, E); } SEAM(13);
    if (IN(14)) { p_rows(F, F.out, YB, MOD1 + 2048, G1 + 1024, F.out, MOD1 + 3072, G1 + 2048, XN); } SEAM(14);
    if (IN(15)) { pg8::Gemm g{XN, (const bf16*)(ws + WS_WF1 + WF1_BYTES), M, 2 * FFH, 1024}; pg8::StaticOrder S; S.init(M, 2 * FFH, F.G, (int)blockIdx.x);
        pg8::EpiSwiGLU E{H, FFH};
        pg8::gemm_phase<pg8::EpiSwiGLU, pg8::StaticOrder, true, true>(F.lds + RING_OFF, g, S, E); } SEAM(15);
    if (IN(16)) { pg8::Gemm g{H, (const bf16*)(ws + WS_WF2 + WF2_BYTES), M, 1024, FFH}; pg8::StaticOrder S; S.init(M, 1024, F.G, (int)blockIdx.x);
        pg8::EpiBf16<0> E{YB, 1024, nullptr, 0, 0, 1.0f};
        pg8::gemm_phase<pg8::EpiBf16<0>, pg8::StaticOrder, true, true>(F.lds + RING_OFF, g, S, E); } SEAM(16);
    if (IN(17)) { p_rows(F, F.out, YB, MOD1 + 5120, G1 + 3072, F.out, nullptr, nullptr, nullptr); }
#undef IN
#undef SEAM
}

extern "C" void kernel_launch(void* const* d_in, const int* in_sizes, int n_in, void* d_out, int out_size, void* d_ws, size_t ws_size, hipStream_t stream) {
    static int grid = 0;
    if (grid == 0) {
        if (n_in != 15 || in_sizes[0] != M * D || out_size != M * D || ws_size < WS_END) { fprintf(stderr, "kernel_launch: unexpected shapes (n_in %d, in0 %d, out %d, ws %zu)\n", n_in, n_in > 0 ? in_sizes[0] : -1, out_size, ws_size); grid = -1; return; }
        int dev = 0, cus = 0;
        if (hipGetDevice(&dev) != hipSuccess || hipDeviceGetAttribute(&cus, hipDeviceAttributeMultiprocessorCount, dev) != hipSuccess) { grid = -1; return; }
        if (hipFuncSetAttribute((const void*)mk_fwd, hipFuncAttributeMaxDynamicSharedMemorySize, LDS_BYTES) != hipSuccess) { fprintf(stderr, "kernel_launch: hipFuncSetAttribute failed\n"); grid = -1; return; }
        (void)hipGetLastError();
        grid = cus;
    }
    if (grid < 0) return;
    if (hipMemsetAsync((char*)d_ws + WS_CTL, 0, CTL_ZERO_BYTES, stream) != hipSuccess) return;
    Args a{};
    for (int i = 0; i < 15; ++i) a.in[i] = (const float*)d_in[i];
    a.out = (float*)d_out; a.ws = (unsigned char*)d_ws;
#if MK_ONE_LAUNCH
    a.ph_lo = 0; a.ph_hi = N_PHASES;
    hipLaunchKernelGGL(mk_fwd, dim3(grid), dim3(NWAVES * 64), LDS_BYTES, stream, a);
#else
    for (int p = 0; p < N_PHASES; ++p) { a.ph_lo = p; a.ph_hi = p + 1; hipLaunchKernelGGL(mk_fwd, dim3(grid), dim3(NWAVES * 64), LDS_BYTES, stream, a); }
#endif
}
```

```cpp
#include <hip/hip_runtime.h>
#include <cstdio>
#include <cstdint>
namespace pg8 {
#define PG8_LAS __attribute__((address_space(3)))
typedef unsigned short bf16_t;
typedef short bf16x8 __attribute__((ext_vector_type(8)));
typedef float f32x4 __attribute__((ext_vector_type(4)));
typedef unsigned u32x4 __attribute__((ext_vector_type(4)));
constexpr int BM = 256, BK = 64, HALF = 128, HTB = HALF * BK * 2  , STAGE_BYTES = 8 * HTB, NXCD = 8, WGM = 8;

__host__ __device__ __forceinline__ int lds_byte(int r, int c) { const int st = (r >> 4) * 2 + (c >> 5), rr = r & 15, cc = c & 31, ob = rr * 64 + cc * 2; return st * 1024 + (ob ^ (((ob >> 9) & 1) << 5)); }
__host__ __device__ __forceinline__ void stage_rc(int b, int& R, int& C) { const int st = b / 1024, sb = b % 1024, swz = sb ^ (((sb >> 9) & 1) << 5); R = (st >> 1) * 16 + swz / 64; C = (st & 1) * 32 + (swz % 64) / 2; }
__host__ __device__ __forceinline__ int perm32(int rho) { const int n = rho >> 4, i = rho & 15; return 8 * (i >> 2) + 4 * n + (i & 3); }

struct Unit { int pm, pn; };
struct Gemm { const bf16_t* A; const bf16_t* Bt; int M, N, K; };

struct StaticOrder {
    int nM, nN, nwg, G, c;
    __host__ __device__ void init(int M, int N, int G_, int c_) { nM = M / BM; nN = N / BM; nwg = nM * nN; G = G_; c = c_; }
    __host__ __device__ bool next(int i, Unit& u) const {
        const long L = (long)i * G + c; if (L >= nwg) return false;
        int wgid = (int)L; { const int q = nwg / NXCD, r = nwg % NXCD, xcd = wgid % NXCD, off = wgid / NXCD; wgid = (xcd < r ? xcd * (q + 1) : r * (q + 1) + (xcd - r) * q) + off; }
        const int nig = WGM * nN, gid = wgid / nig, fm = gid * WGM, gsz = (nM - fm) < WGM ? (nM - fm) : WGM;
        u.pm = fm + ((wgid % nig) % gsz); u.pn = (wgid % nig) / gsz; return true;
    }
    __device__ __forceinline__ void a_ready(const Unit&) const {}
    __device__ __forceinline__ void done(const Unit&) const {}
};

__device__ __forceinline__ unsigned cvt_pk_bf16(float lo, float hi) { unsigned r; asm volatile("v_cvt_pk_bf16_f32 %0, %1, %2" : "=v"(r) : "v"(lo), "v"(hi)); return r; }
typedef float f32x2 __attribute__((ext_vector_type(2)));
__device__ __forceinline__ f32x2 gelu_pk(f32x2 v) {
    const f32x2 av = __builtin_elementwise_abs(v), d = av * 0.2316418882f + 1.0f;
    f32x2 t; t.x = __builtin_amdgcn_rcpf(d.x); t.y = __builtin_amdgcn_rcpf(d.y);
    f32x2 q = t * 0.5307027145f + (-0.7265760135f); q = q * t + 0.7107068705f; q = q * t + (-0.142248368f); q = q * t + 0.127414796f; q = q * t;
    const f32x2 s = (v * v) * (-0.72134752044f);
    f32x2 e; e.x = __builtin_amdgcn_exp2f(s.x); e.y = __builtin_amdgcn_exp2f(s.y);
    const f32x2 m = v * (q * e), r = v - m;
    f32x2 o; o.x = v.x < 0.f ? m.x : r.x; o.y = v.y < 0.f ? m.y : r.y; return o;
}

template <int ACT  > struct EpiBf16 {
    static constexpr bool PERM = true, AFTER_DRAIN = false; static_assert(ACT == 0 || ACT == 1, "EpiBf16: ACT is 0 (none) or 1 (gelu_pk)");
    bf16_t* O; int ldc; const float* bias; int split_cols; size_t split_stride; float scale0;
    __device__ __forceinline__ void operator()(const f32x4 (&acc)[2][2][4][2], const Unit& u, int wr, int wc, int fr, int fq) const {
        const int row0 = u.pm * BM + wr * 64 + fr; int colt = u.pn * BM; bf16_t* base = O;
        float sc = 1.f; if (split_cols) { const int t = colt / split_cols; base += (size_t)t * split_stride; colt -= t * split_cols; if (t == 0) sc = scale0; }
        const int col0 = colt + wc * 32 + 8 * fq, bcol0 = u.pn * BM + wc * 32 + 8 * fq;
        f32x4 bv[2][2];
#pragma unroll
        for (int bj = 0; bj < 2; ++bj)
#pragma unroll
            for (int n = 0; n < 2; ++n) bv[bj][n] = bias ? *(const f32x4*)(bias + bcol0 + bj * HALF + 4 * n) : (f32x4){0.f, 0.f, 0.f, 0.f};
#pragma unroll
        for (int ai = 0; ai < 2; ++ai)
#pragma unroll
            for (int m = 0; m < 4; ++m) { bf16_t* rowp = base + (size_t)(row0 + ai * HALF + m * 16) * ldc + col0;
#pragma unroll
                for (int bj = 0; bj < 2; ++bj) { f32x4 v0 = acc[ai][bj][m][0] + bv[bj][0], v1 = acc[ai][bj][m][1] + bv[bj][1];
                    if (ACT == 1) { f32x2 a = gelu_pk((f32x2){v0[0], v0[1]}), b = gelu_pk((f32x2){v0[2], v0[3]}), c = gelu_pk((f32x2){v1[0], v1[1]}), d = gelu_pk((f32x2){v1[2], v1[3]});
                        v0 = (f32x4){a.x, a.y, b.x, b.y}; v1 = (f32x4){c.x, c.y, d.x, d.y}; }
                    v0 = v0 * sc; v1 = v1 * sc; u32x4 w; w.x = cvt_pk_bf16(v0[0], v0[1]); w.y = cvt_pk_bf16(v0[2], v0[3]); w.z = cvt_pk_bf16(v1[0], v1[1]); w.w = cvt_pk_bf16(v1[2], v1[3]);
                    *(u32x4*)(rowp + bj * HALF) = w; } }
    }
};
template <class Epi, class Sched, bool ALIGN_EPI = false, bool SP2 = false>
__device__ __forceinline__ void gemm_phase(PG8_LAS unsigned char* lds, const Gemm g, const Sched& S, const Epi& E) {
    const int tid = threadIdx.x, wid = __builtin_amdgcn_readfirstlane(tid >> 6), lane = tid & 63, wr = wid >> 2, wc = wid & 3, fr = lane & 15, fq = lane >> 4;
    const int K = g.K, nt = K / BK;
    unsigned voffA[2], voffB[2];
#pragma unroll
    for (int i = 0; i < 2; ++i) { int R, C; stage_rc(tid * 16 + i * 8192, R, C); const int Rb = Epi::PERM ? ((R & ~31) + perm32(R & 31)) : R;
        voffA[i] = (unsigned)(R * K + C) * 2u; voffB[i] = (unsigned)(Rb * K + C) * 2u; }
    const size_t kstep = (size_t)(BK * 2);
    const size_t hstep = (size_t)HALF * K * 2;
    const size_t tstep = 2 * hstep;
    const unsigned ldsw = (unsigned)wid * 1024u;
    const int aoff = lds_byte(wr * 64 + fr, fq * 8), boff = lds_byte(wc * 32 + fr, fq * 8);
#define PG8_SA(b, h) (((b) * 2 + (h)) * HTB)
#define PG8_SB(b, h) ((4 + (b) * 2 + (h)) * HTB)
#define PG8_STAGE(bufoff, gbase, voff) do { _Pragma("unroll") for (int _i = 0; _i < 2; ++_i) \
        __builtin_amdgcn_global_load_lds((const unsigned*)((const char*)(gbase) + (voff)[_i]), (PG8_LAS unsigned*)(lds + (bufoff) + ldsw + _i * 8192), 16, 0, 0); } while (0)
#define PG8_LDA(dst, b, h) do { _Pragma("unroll") for (int m = 0; m < 4; ++m) _Pragma("unroll") for (int k = 0; k < 2; ++k) dst[m][k] = *(const PG8_LAS bf16x8*)(lds + PG8_SA(b, h) + aoff + m * 2048 + k * 1024); } while (0)
#define PG8_LDB(dst, b, h) do { _Pragma("unroll") for (int n = 0; n < 2; ++n) _Pragma("unroll") for (int k = 0; k < 2; ++k) dst[n][k] = *(const PG8_LAS bf16x8*)(lds + PG8_SB(b, h) + boff + n * 2048 + k * 1024); } while (0)
#define PG8_MMA(ai, bj, At, Bt) do { __builtin_amdgcn_s_setprio(1); _Pragma("unroll") for (int m = 0; m < 4; ++m) _Pragma("unroll") for (int n = 0; n < 2; ++n) _Pragma("unroll") for (int k = 0; k < 2; ++k) \
        acc[ai][bj][m][n] = __builtin_amdgcn_mfma_f32_16x16x32_bf16(Bt[n][k], At[m][k], acc[ai][bj][m][n], 0, 0, 0); __builtin_amdgcn_s_setprio(0); } while (0)
#define PG8_WAIT_V(n) asm volatile("s_waitcnt vmcnt(" #n ")" ::: "memory")
#define PG8_WAIT_L(n) asm volatile("s_waitcnt lgkmcnt(" #n ")" ::: "memory")
#define PG8_BAR __builtin_amdgcn_s_barrier()
#define PG8_SCHED __builtin_amdgcn_sched_barrier(0)
    Unit cur, nxt; int ui = 0;
    if (!S.next(0, cur)) return;
    f32x4 acc[2][2][4][2];
#pragma unroll
    for (int a = 0; a < 2; ++a)
#pragma unroll
        for (int b = 0; b < 2; ++b)
#pragma unroll
            for (int m = 0; m < 4; ++m)
#pragma unroll
                for (int n = 0; n < 2; ++n) acc[a][b][m][n] = (f32x4){0.f, 0.f, 0.f, 0.f};
    bf16x8 At[4][2], B0[2][2], B1[2][2];
    const char* cA = (const char*)g.A + (size_t)cur.pm * tstep; const char* cB = (const char*)g.Bt + (size_t)cur.pn * tstep;
    S.a_ready(cur);
    if constexpr (SP2) {
        PG8_STAGE(PG8_SB(0, 0), cB, voffB); PG8_STAGE(PG8_SB(0, 1), cB + hstep, voffB); PG8_STAGE(PG8_SA(0, 0), cA, voffA); PG8_STAGE(PG8_SA(0, 1), cA + hstep, voffA);
        if (wr == 1) PG8_BAR;
        PG8_WAIT_V(2); PG8_BAR;
        PG8_STAGE(PG8_SB(1, 0), cB + kstep, voffB); PG8_STAGE(PG8_SA(1, 0), cA + kstep, voffA); PG8_STAGE(PG8_SB(1, 1), cB + hstep + kstep, voffB);
        PG8_WAIT_V(6); PG8_BAR;
    } else {
        PG8_STAGE(PG8_SB(0, 0), cB, voffB); PG8_STAGE(PG8_SA(0, 0), cA, voffA); PG8_STAGE(PG8_SB(0, 1), cB + hstep, voffB); PG8_STAGE(PG8_SA(0, 1), cA + hstep, voffA);
        if (wr == 1) PG8_BAR;
        PG8_WAIT_V(4); PG8_BAR;
        PG8_STAGE(PG8_SB(1, 0), cB + kstep, voffB); PG8_STAGE(PG8_SA(1, 0), cA + kstep, voffA); PG8_STAGE(PG8_SB(1, 1), cB + hstep + kstep, voffB);
        PG8_WAIT_V(6); PG8_BAR;
    }
    for (;;) {
        const bool has_next = S.next(ui + 1, nxt);
        const char* nA = has_next ? (const char*)g.A + (size_t)nxt.pm * tstep : cA; const char* nB = has_next ? (const char*)g.Bt + (size_t)nxt.pn * tstep : cB;
        for (int t = 0; t < nt; t += 2) {
            const bool last = (t == nt - 2);
            const char* a1 = cA + (size_t)(t + 1) * kstep;
            const char* a2 = last ? nA : cA + (size_t)(t + 2) * kstep; const char* b2 = last ? nB : cB + (size_t)(t + 2) * kstep;
            const char* a3 = a2 + kstep; const char* b3 = b2 + kstep;
            if (last && has_next) S.a_ready(nxt);
            if constexpr (SP2) {
            PG8_LDB(B0, 0, 0); PG8_LDB(B1, 0, 1); PG8_SCHED; PG8_LDA(At, 0, 0); PG8_STAGE(PG8_SA(1, 1), a1 + hstep, voffA);
            PG8_WAIT_V(8); PG8_WAIT_L(0); PG8_BAR; PG8_MMA(0, 0, At, B0); PG8_MMA(0, 1, At, B1); PG8_BAR; PG8_SCHED;
            PG8_LDA(At, 0, 1); PG8_STAGE(PG8_SB(0, 0), b2, voffB); PG8_STAGE(PG8_SB(0, 1), b2 + hstep, voffB); PG8_STAGE(PG8_SA(0, 0), a2, voffA);
            PG8_WAIT_V(8); PG8_WAIT_L(0); PG8_BAR; PG8_MMA(1, 0, At, B0); PG8_MMA(1, 1, At, B1); PG8_BAR; PG8_SCHED;
            PG8_LDB(B0, 1, 0); PG8_LDB(B1, 1, 1); PG8_SCHED; PG8_LDA(At, 1, 0); PG8_STAGE(PG8_SA(0, 1), a2 + hstep, voffA);
            PG8_WAIT_V(8); PG8_WAIT_L(0); PG8_BAR; PG8_MMA(0, 0, At, B0); PG8_MMA(0, 1, At, B1); PG8_BAR; PG8_SCHED;
            PG8_LDA(At, 1, 1); PG8_STAGE(PG8_SB(1, 0), b3, voffB); PG8_STAGE(PG8_SB(1, 1), b3 + hstep, voffB); PG8_STAGE(PG8_SA(1, 0), a3, voffA);
            PG8_WAIT_V(8); PG8_WAIT_L(0); PG8_BAR; PG8_MMA(1, 0, At, B0); PG8_MMA(1, 1, At, B1); PG8_BAR; PG8_SCHED;
            } else {
            PG8_LDB(B0, 0, 0); PG8_SCHED; PG8_LDA(At, 0, 0); PG8_STAGE(PG8_SA(1, 1), a1 + hstep, voffA);
            PG8_WAIT_L(8); PG8_BAR; PG8_WAIT_L(0); PG8_MMA(0, 0, At, B0); PG8_BAR; PG8_SCHED;
            PG8_LDB(B1, 0, 1); PG8_STAGE(PG8_SB(0, 0), b2, voffB);
            PG8_BAR; PG8_WAIT_L(0); PG8_MMA(0, 1, At, B1); PG8_BAR;
            PG8_LDA(At, 0, 1); PG8_STAGE(PG8_SA(0, 0), a2, voffA);
            PG8_BAR; PG8_WAIT_L(0); PG8_MMA(1, 0, At, B0); PG8_BAR; PG8_SCHED;
            PG8_STAGE(PG8_SB(0, 1), b2 + hstep, voffB);
            PG8_WAIT_V(6); PG8_BAR; PG8_MMA(1, 1, At, B1); PG8_BAR;
            PG8_LDB(B0, 1, 0); PG8_SCHED; PG8_LDA(At, 1, 0); PG8_STAGE(PG8_SA(0, 1), a2 + hstep, voffA);
            PG8_WAIT_L(8); PG8_BAR; PG8_WAIT_L(0); PG8_MMA(0, 0, At, B0); PG8_BAR; PG8_SCHED;
            PG8_LDB(B1, 1, 1); PG8_STAGE(PG8_SB(1, 0), b3, voffB);
            PG8_BAR; PG8_WAIT_L(0); PG8_MMA(0, 1, At, B1); PG8_BAR;
            PG8_LDA(At, 1, 1); PG8_STAGE(PG8_SA(1, 0), a3, voffA);
            PG8_BAR; PG8_WAIT_L(0); PG8_MMA(1, 0, At, B0); PG8_BAR; PG8_SCHED;
            PG8_STAGE(PG8_SB(1, 1), b3 + hstep, voffB);
            PG8_WAIT_V(6); PG8_BAR; PG8_MMA(1, 1, At, B1); PG8_BAR;
            }
        }
        if constexpr (ALIGN_EPI) { if (wr == 0) PG8_BAR; }
        if constexpr (!Epi::AFTER_DRAIN) { E(acc, cur, wr, wc, fr, fq); S.done(cur); }
        if (!has_next) break;
#pragma unroll
        for (int a = 0; a < 2; ++a)
#pragma unroll
            for (int b = 0; b < 2; ++b)
#pragma unroll
                for (int m = 0; m < 4; ++m)
#pragma unroll
                    for (int n = 0; n < 2; ++n) acc[a][b][m][n] = (f32x4){0.f, 0.f, 0.f, 0.f};
        cur = nxt; cA = nA; cB = nB; ++ui;
        if constexpr (ALIGN_EPI) { if (wr == 1) PG8_BAR; }
    }
    PG8_WAIT_V(0);
    if constexpr (!ALIGN_EPI) { if (wr == 0) PG8_BAR; }
    PG8_BAR;
    if constexpr (Epi::AFTER_DRAIN) { E.fused(acc, cur, wr, wc, fr, fq, lds, wid, lane); S.done(cur); }
#undef PG8_SA
#undef PG8_SB
#undef PG8_STAGE
#undef PG8_LDA
#undef PG8_LDB
#undef PG8_MMA
#undef PG8_WAIT_V
#undef PG8_WAIT_L
#undef PG8_BAR
#undef PG8_SCHED
}
}
#include <hip/hip_bf16.h>
#include <cmath>
namespace attn_body {
using bf16=__hip_bfloat16;
using bf16x8=__attribute__((ext_vector_type(8)))short;
using s16x4=__attribute__((ext_vector_type(4)))short;
using f32x16=__attribute__((ext_vector_type(16)))float;
using u32x4=__attribute__((ext_vector_type(4)))unsigned;
constexpr int BATCH=2,NHEAD=8,NKVH=2,SEQ=8192,D=64,QP=512,KP=512,VP=512,OP=1024;
constexpr int NW=8,QBLK=32,QB=QBLK*NW,KVBLK=64,NQB=SEQ/QB;
constexpr int ATTN_UNIT_ROWS=QB;
__device__ __forceinline__ int crow(int r,int hi){return (r&3)+8*(r>>2)+4*hi;}
#define SBAR() __builtin_amdgcn_sched_barrier(0)
__device__ __forceinline__ void cmask(f32x16&p0,f32x16&p1,int jb,int qrel,int hi){
  const float NEG=-INFINITY; int kb=64*jb+4*hi;
  #pragma unroll
  for(int r=0;r<16;++r){int kv=kb+(r&3)+8*(r>>2); if(kv>qrel)p0[r]=NEG; if(kv+32>qrel)p1[r]=NEG;}
}

constexpr int NSLOT=3, SLOTB=8192;
constexpr int LDS_K=0, LDS_V=NSLOT*SLOTB, LDS_WS=2*NSLOT*SLOTB, LDS_OST=LDS_WS+NW*64*4, LDS_BYTES=LDS_OST+NW*4096;
constexpr float C2=0.125f*1.4426950408889634f;
__device__ __forceinline__ void glds16(const void*gsrc,unsigned lds_dst){unsigned keep;
  asm volatile("s_mov_b32 %0, m0\n\ts_mov_b32 m0, %2\n\ts_nop 0\n\tglobal_load_lds_dwordx4 %1, off\n\ts_mov_b32 m0, %0":"=&s"(keep):"v"(gsrc),"s"(lds_dst):"memory");}
__device__ __forceinline__ float max3f(float a,float b,float c){float r;asm("v_max3_f32 %0, %1, %2, %3":"=v"(r):"v"(a),"v"(b),"v"(c));return r;}
__device__ __forceinline__ float max2f(float a,float b){float r;asm("v_max_f32_e32 %0, %1, %2":"=v"(r):"v"(a),"v"(b));return r;}
__device__ __forceinline__ float fadd_s(float a,float b){float r;asm("v_add_f32_e32 %0, %1, %2":"=v"(r):"v"(a),"v"(b));return r;}
__device__ __forceinline__ float fsub_s(float a,float b){float r;asm("v_sub_f32_e32 %0, %1, %2":"=v"(r):"v"(a),"v"(b));return r;}
typedef float f32x2_t __attribute__((ext_vector_type(2))); typedef __bf16 bf16x2_t __attribute__((ext_vector_type(2)));
__device__ __forceinline__ unsigned cvtpk_s(float lo,float hi){f32x2_t v={lo,hi};bf16x2_t b=__builtin_convertvector(v,bf16x2_t);return __builtin_bit_cast(unsigned,b);}
#define WAIT_BAR(N) asm volatile("s_waitcnt vmcnt(" #N ") lgkmcnt(0)\n\ts_barrier":::"memory")

__device__ __forceinline__ void qkt(f32x16&p0,f32x16&p1,const char*Kslot,const bf16x8*qr,const f32x16&negm,int r32,int hi){
  const char*kb=Kslot+hi*1024+r32*16;
  #pragma unroll
  for(int d0=0;d0<4;++d0){
    const bf16x8 b0=*reinterpret_cast<const bf16x8*>(kb+d0*2048);
    const bf16x8 b1=*reinterpret_cast<const bf16x8*>(kb+d0*2048+512);
    if(d0==0){p0=__builtin_amdgcn_mfma_f32_32x32x16_bf16(b0,qr[0],negm,0,0,0);p1=__builtin_amdgcn_mfma_f32_32x32x16_bf16(b1,qr[0],negm,0,0,0);}
    else{p0=__builtin_amdgcn_mfma_f32_32x32x16_bf16(b0,qr[d0],p0,0,0,0);p1=__builtin_amdgcn_mfma_f32_32x32x16_bf16(b1,qr[d0],p1,0,0,0);}}
}
typedef __attribute__((address_space(3))) const char* lds_cptr;
typedef short v4i16_t __attribute__((ext_vector_type(4)));
__device__ __forceinline__ void kload8(bf16x8*kf,lds_cptr kp){
  kf[0]=*(const __attribute__((address_space(3))) bf16x8*)(kp);      kf[1]=*(const __attribute__((address_space(3))) bf16x8*)(kp+512);
  kf[2]=*(const __attribute__((address_space(3))) bf16x8*)(kp+2048); kf[3]=*(const __attribute__((address_space(3))) bf16x8*)(kp+2560);
  kf[4]=*(const __attribute__((address_space(3))) bf16x8*)(kp+4096); kf[5]=*(const __attribute__((address_space(3))) bf16x8*)(kp+4608);
  kf[6]=*(const __attribute__((address_space(3))) bf16x8*)(kp+6144); kf[7]=*(const __attribute__((address_space(3))) bf16x8*)(kp+6656);
}
__device__ __forceinline__ void kload2(bf16x8*kf,lds_cptr kp,int j){ kf[2*j]=*(const __attribute__((address_space(3))) bf16x8*)(kp+j*2048); kf[2*j+1]=*(const __attribute__((address_space(3))) bf16x8*)(kp+j*2048+512); }
__device__ __forceinline__ s16x4 vtr(lds_cptr p){ return __builtin_bit_cast(s16x4,__builtin_amdgcn_ds_read_tr16_b64_v4i16((__attribute__((address_space(3))) v4i16_t*)p)); }
__device__ __forceinline__ float rowmax(const f32x16&p0,const f32x16&p1){
  float a=max3f(p0[0],p0[1],p1[0]),b=max3f(p0[2],p0[3],p1[1]);a=max3f(a,p1[2],p1[3]);
  #pragma unroll
  for(int r=4;r<16;r+=4){a=max3f(a,p0[r],p0[r+1]);b=max3f(b,p0[r+2],p0[r+3]);a=max3f(a,p1[r],p1[r+1]);b=max3f(b,p1[r+2],p1[r+3]);}
  const float m=max2f(a,b);
  auto rr=__builtin_amdgcn_permlane32_swap(__float_as_uint(m),__float_as_uint(m),false,false);
  return max2f(__uint_as_float(rr[0]),__uint_as_float(rr[1]));
}
__device__ __forceinline__ void pv(f32x16*o,int vb,bf16x8 pa0,bf16x8 pa1,bf16x8 pa2,bf16x8 pa3){
  #pragma unroll
  for(int d0=0;d0<2;++d0){s16x4 lo[4],hi[4];
    #pragma unroll
    for(int ks=0;ks<4;++ks){
      asm volatile("ds_read_b64_tr_b16 %0,%1 offset:%c2":"=&v"(lo[ks]):"v"(vb),"i"(d0*4096+ks*1024):"memory");
      asm volatile("ds_read_b64_tr_b16 %0,%1 offset:%c2":"=&v"(hi[ks]):"v"(vb),"i"(d0*4096+ks*1024+512):"memory");}
    asm volatile("s_waitcnt lgkmcnt(0)":::"memory");SBAR();
    #define PK(k) (bf16x8){lo[k][0],lo[k][1],lo[k][2],lo[k][3],hi[k][0],hi[k][1],hi[k][2],hi[k][3]}
    o[d0]=__builtin_amdgcn_mfma_f32_32x32x16_bf16(pa0,PK(0),o[d0],0,0,0);
    o[d0]=__builtin_amdgcn_mfma_f32_32x32x16_bf16(pa1,PK(1),o[d0],0,0,0);
    o[d0]=__builtin_amdgcn_mfma_f32_32x32x16_bf16(pa2,PK(2),o[d0],0,0,0);
    o[d0]=__builtin_amdgcn_mfma_f32_32x32x16_bf16(pa3,PK(3),o[d0],0,0,0);
    #undef PK
  }
}

#ifndef ATTN_STORE16
#define ATTN_STORE16(p,v) (*(u32x4*)(p)=(v))
#endif
template<int THRL> __device__ __forceinline__ void attn_unit(int b,int h,int qb,const bf16*Q,const bf16*__restrict__ K,const bf16*__restrict__ V,bf16*O,char*shm){
  const int tid=threadIdx.x,lane=tid&63,r32=lane&31,hi=lane>>5; const int wid=__builtin_amdgcn_readfirstlane(tid>>6);
  const long rowbase=(long)b*SEQ; const int q0=qb*QB;
  const bf16*Qw=Q+(rowbase+q0+wid*QBLK)*QP+h*D; const int hk=h>>2;
  const bf16*Kh=K+rowbase*KP+hk*D,*Vh=V+rowbase*VP+hk*D;
  const unsigned lds0=(unsigned)(uintptr_t)shm;
  float*wsf=(float*)(shm+LDS_WS)+wid*64;
  const bf16*ksrc=Kh+(long)lane*KP+wid*8;
  const bf16*vsrc=Vh+(long)(16*(wid&3)+(lane>>2))*VP+(wid>>2)*32+(lane&3)*8;
  const unsigned kdst=lds0+LDS_K+wid*1024, vdst=lds0+LDS_V+wid*1024;
  #define DMA_K(t,slot) glds16(ksrc+(long)(t)*KVBLK*KP,(unsigned)__builtin_amdgcn_readfirstlane(kdst+(slot)))
  #define DMA_V(t,slot) glds16(vsrc+(long)(t)*KVBLK*VP,(unsigned)__builtin_amdgcn_readfirstlane(vdst+(slot)))
  const int vb0=(int)(lds0+LDS_V)+((lane>>4)&1)*32+(lane&3)*8+(4*hi+((lane&15)>>2))*64;
  const char*Kbase=shm+LDS_K; bf16x8 kf[8];
  const lds_cptr shm3=(lds_cptr)shm; const lds_cptr kp0=shm3+LDS_K+hi*1024+r32*16; const lds_cptr vp0=shm3+LDS_V+((lane>>4)&1)*32+(lane&3)*8+(4*hi+((lane&15)>>2))*64;
  const int NT=SEQ/KVBLK;
  DMA_K(0,0);DMA_V(0,0);DMA_K(1,SLOTB);
  bf16x8 qr[4];
  #pragma unroll
  for(int d0=0;d0<4;++d0)qr[d0]=*reinterpret_cast<const bf16x8*>(&Qw[(long)r32*QP+d0*16+hi*8]);
  float mhat=0.f,l_reg=0.f;f32x16 o[2];o[0]=f32x16{};o[1]=f32x16{};f32x16 negm=f32x16{};asm volatile("":"+v"(negm));

  #define CMASK(P0,P1,t) do{}while(0)
  bool resc=false;
  #define START(P0,P1) do{ const float rm=rowmax(P0,P1); resc=false; \
    { const float dl=rm; mhat=fadd_s(mhat,dl); \
      _Pragma("unroll") for(int r=0;r<16;++r){P0[r]=fsub_s(P0[r],dl);P1[r]=fsub_s(P1[r],dl);} \
      _Pragma("unroll") for(int r=0;r<16;++r)negm[r]=-mhat; asm volatile("":"+v"(negm)); } \
    _Pragma("unroll") for(int r=0;r<16;++r)P0[r]=__builtin_amdgcn_exp2f(P0[r]); }while(0)
  #define RESC() do{ if(resc){ asm volatile("s_waitcnt lgkmcnt(0)":::"memory"); \
      _Pragma("unroll") for(int d_=0;d_<2;++d_) _Pragma("unroll") for(int r=0;r<16;++r)o[d_][r]*=wsf[crow(r,hi)]; } }while(0)
  f32x16 pA0,pA1,pB0,pB1;
  int sl_prev=0,sl_cur=0,sl_next=SLOTB;
  #define ROT() do{sl_prev=sl_cur;sl_cur=sl_next;sl_next=(sl_next==(NSLOT-1)*SLOTB)?0:sl_next+SLOTB;}while(0)
  DMA_K(2,2*SLOTB);
  WAIT_BAR(3);
  qkt(pA0,pA1,Kbase,qr,negm,r32,hi);asm volatile("s_nop 15\n\ts_nop 7":"+v"(pA0),"+v"(pA1));CMASK(pA0,pA1,0);
  START(pA0,pA1);
  _Pragma("unroll") for(int r=0;r<16;++r)pA1[r]=__builtin_amdgcn_exp2f(pA1[r]);
  WAIT_BAR(0);
  DMA_K(3,0);DMA_V(1,SLOTB);
  ROT();
  kload8(kf,kp0+sl_cur);
  WAIT_BAR(2);
  s16x4 vlo[8],vhi[8]; u32x4 pw0,pw1,pw2,pw3;
  #define PKW(P,B) cvtpk_s(P[B],P[B+1])
  #define PAF(k) __builtin_bit_cast(bf16x8,pw##k)
  #define VFR(i) (bf16x8){vlo[i][0],vlo[i][1],vlo[i][2],vlo[i][3],vhi[i][0],vhi[i][1],vhi[i][2],vhi[i][3]}
  #define PIN(x) asm volatile("":"+v"(x))
  #define MX3(a,b,c) __builtin_fmaxf(__builtin_fmaxf((a),(b)),(c))
  #define GAPA(MF,A0,A1,A2,A3,W0,W1,PW) do{ MF; sacc+=A0; sacc+=A1; sacc+=A2; sacc+=A3; PIN(sacc); W0; W1; PIN(PW); SBAR(); }while(0)
  #define EX(v) __builtin_amdgcn_exp2f(v)
  #define GAPB(MF,X,B) do{ MF; X[B]=EX(X[B]); X[B+1]=EX(X[B+1]); X[B+2]=EX(X[B+2]); X[B+3]=EX(X[B+3]); PIN(X); SBAR(); }while(0)
  #define VRD(i) do{ vlo[i]=vtr(vp_+(((i)>>2)*4096+((i)&3)*1024)); vhi[i]=vtr(vp_+(((i)>>2)*4096+((i)&3)*1024+512)); }while(0)
  #define KRD(G,j) do{ if(G){ kload2(kf,kp0+sl_next,j); SBAR(); } }while(0)
  #define STEP(C0,C1,P0,P1,t,GK,GV,GL) do{ SBAR(); \
    const lds_cptr vp_=vp0+sl_prev; \
    VRD(0); SBAR(); float sacc=(P0[0]+P0[1]); \
    GAPA(C0=__builtin_amdgcn_mfma_f32_32x32x16_bf16(kf[0],qr[0],negm,0,0,0), P0[2],P0[3],P0[4],P0[5],     pw0[0]=PKW(P0,0), pw0[1]=PKW(P0,2), pw0); \
    VRD(4); SBAR(); GAPA(C1=__builtin_amdgcn_mfma_f32_32x32x16_bf16(kf[1],qr[0],negm,0,0,0), P0[6],P0[7],P0[8],P0[9],     pw0[2]=PKW(P0,4), pw0[3]=PKW(P0,6), pw0); \
    VRD(1); SBAR(); GAPA(C0=__builtin_amdgcn_mfma_f32_32x32x16_bf16(kf[2],qr[1],C0,0,0,0),   P0[10],P0[11],P0[12],P0[13], pw1[0]=PKW(P0,8), pw1[1]=PKW(P0,10), pw1); \
    VRD(5); SBAR(); GAPA(C1=__builtin_amdgcn_mfma_f32_32x32x16_bf16(kf[3],qr[1],C1,0,0,0),   P0[14],P0[15],P1[0],P1[1],   pw1[2]=PKW(P0,12),pw1[3]=PKW(P0,14), pw1); \
    VRD(2); SBAR(); GAPA(C0=__builtin_amdgcn_mfma_f32_32x32x16_bf16(kf[4],qr[2],C0,0,0,0),   P1[2],P1[3],P1[4],P1[5],     pw2[0]=PKW(P1,0), pw2[1]=PKW(P1,2), pw2); \
    VRD(6); SBAR(); GAPA(C1=__builtin_amdgcn_mfma_f32_32x32x16_bf16(kf[5],qr[2],C1,0,0,0),   P1[6],P1[7],P1[8],P1[9],     pw2[2]=PKW(P1,4), pw2[3]=PKW(P1,6), pw2); \
    VRD(3); SBAR(); GAPA(C0=__builtin_amdgcn_mfma_f32_32x32x16_bf16(kf[6],qr[3],C0,0,0,0),   P1[10],P1[11],P1[12],P1[13], pw3[0]=PKW(P1,8), pw3[1]=PKW(P1,10), pw3); \
    VRD(7); SBAR(); GAPA(C1=__builtin_amdgcn_mfma_f32_32x32x16_bf16(kf[7],qr[3],C1,0,0,0),   P1[14],P1[15],0.f,0.f,       pw3[2]=PKW(P1,12),pw3[3]=PKW(P1,14), pw3); \
    l_reg+=sacc; \
    if(GK){DMA_K((t)+3,sl_cur);} if(GV){DMA_V((t)+1,sl_next);} \
    CMASK(C0,C1,t); \
    { float a=MX3(C0[0],C0[1],C1[0]),b=MX3(C0[2],C0[3],C1[1]); a=MX3(a,C1[2],C1[3]); \
      _Pragma("unroll") for(int r=4;r<16;r+=4){a=MX3(a,C0[r],C0[r+1]);b=MX3(b,C0[r+2],C0[r+3]);a=MX3(a,C1[r],C1[r+1]);b=MX3(b,C1[r+2],C1[r+3]);} \
      float rm=__builtin_fmaxf(a,b); { auto rr=__builtin_amdgcn_permlane32_swap(__float_as_uint(rm),__float_as_uint(rm),false,false); rm=__builtin_fmaxf(__uint_as_float(rr[0]),__uint_as_float(rr[1])); } \
      resc=false; \
      if(__builtin_expect(__any(rm>(float)THRL),0)){ const float dl=__builtin_fmaxf(rm,0.f); mhat+=dl; \
        _Pragma("unroll") for(int r=0;r<16;++r){C0[r]-=dl;C1[r]-=dl;} \
        _Pragma("unroll") for(int r=0;r<16;++r)negm[r]=-mhat; asm volatile("":"+v"(negm)); \
        const float f=__builtin_amdgcn_exp2f(-dl); l_reg*=f; if(hi==0)wsf[r32]=f; resc=true; } } \
    SBAR(); \
    GAPB(o[0]=__builtin_amdgcn_mfma_f32_32x32x16_bf16(PAF(0),VFR(0),o[0],0,0,0), C0,0); \
    GAPB(o[1]=__builtin_amdgcn_mfma_f32_32x32x16_bf16(PAF(0),VFR(4),o[1],0,0,0), C0,4); \
    KRD(GL,0); GAPB(o[0]=__builtin_amdgcn_mfma_f32_32x32x16_bf16(PAF(1),VFR(1),o[0],0,0,0), C0,8); \
    KRD(GL,1); GAPB(o[1]=__builtin_amdgcn_mfma_f32_32x32x16_bf16(PAF(1),VFR(5),o[1],0,0,0), C0,12); \
    KRD(GL,2); GAPB(o[0]=__builtin_amdgcn_mfma_f32_32x32x16_bf16(PAF(2),VFR(2),o[0],0,0,0), C1,0); \
    KRD(GL,3); GAPB(o[1]=__builtin_amdgcn_mfma_f32_32x32x16_bf16(PAF(2),VFR(6),o[1],0,0,0), C1,4); \
    GAPB(o[0]=__builtin_amdgcn_mfma_f32_32x32x16_bf16(PAF(3),VFR(3),o[0],0,0,0), C1,8); \
    GAPB(o[1]=__builtin_amdgcn_mfma_f32_32x32x16_bf16(PAF(3),VFR(7),o[1],0,0,0), C1,12); \
    }while(0)
  int t=1;
  #undef CMASK
  #define CMASK(P0,P1,t) do{}while(0)
  for(;t+5<NT;t+=2){
    STEP(pB0,pB1,pA0,pA1,t,true,true,true);     WAIT_BAR(2); RESC(); ROT();
    STEP(pA0,pA1,pB0,pB1,t+1,true,true,true);   WAIT_BAR(2); RESC(); ROT();
  }
  #undef CMASK
  #define CMASK(P0,P1,t) do{}while(0)
  #define ENDW(tt) do{ if((tt)+3<NT){WAIT_BAR(2);} else if((tt)+2<NT){WAIT_BAR(1);} else {WAIT_BAR(0);} }while(0)
  for(;t+1<NT;t+=2){
    STEP(pB0,pB1,pA0,pA1,t,(t+3<NT),(t+1<NT),(t+1<NT));       ENDW(t);   RESC(); ROT();
    STEP(pA0,pA1,pB0,pB1,t+1,(t+4<NT),(t+2<NT),(t+2<NT));     ENDW(t+1); RESC(); ROT();
  }
  STEP(pB0,pB1,pA0,pA1,NT-1,false,false,false); RESC();
  { float sacc=pB0[0]+pB0[1]; _Pragma("unroll") for(int r=2;r<16;++r)sacc+=pB0[r]; _Pragma("unroll") for(int r=0;r<16;++r)sacc+=pB1[r]; l_reg+=sacc;
    pw0=(u32x4){PKW(pB0,0),PKW(pB0,2),PKW(pB0,4),PKW(pB0,6)};pw1=(u32x4){PKW(pB0,8),PKW(pB0,10),PKW(pB0,12),PKW(pB0,14)};pw2=(u32x4){PKW(pB1,0),PKW(pB1,2),PKW(pB1,4),PKW(pB1,6)};pw3=(u32x4){PKW(pB1,8),PKW(pB1,10),PKW(pB1,12),PKW(pB1,14)};
    SBAR(); pv(o,vb0+sl_cur,PAF(0),PAF(1),PAF(2),PAF(3)); }
  #undef PKW
  #undef PAF
  #undef VFR
  #undef PIN
  #undef MX3
  #undef GAPA
  #undef GAPB
  #undef EX
  #undef VRD
  #undef KRD
  #undef STEP
  #undef ENDW
  {auto rr=__builtin_amdgcn_permlane32_swap(__float_as_uint(l_reg),__float_as_uint(l_reg),false,false);l_reg=__uint_as_float(rr[0])+__uint_as_float(rr[1]);}
  if(hi==0)wsf[32+r32]=l_reg;asm volatile("s_waitcnt lgkmcnt(0)":::"memory");
  float rli[16];
  #pragma unroll
  for(int r=0;r<16;++r)rli[r]=__builtin_amdgcn_rcpf(wsf[32+crow(r,hi)]);
  bf16*Ow=O+(rowbase+q0+wid*QBLK)*OP+h*D;
  { bf16*stg=(bf16*)(shm+LDS_OST)+wid*2048;
    #pragma unroll
    for(int r=0;r<16;++r){const int orow=crow(r,hi);
      #pragma unroll
      for(int d0=0;d0<2;++d0)stg[orow*64+d0*32+r32]=__float2bfloat16(o[d0][r]*rli[r]);}
    asm volatile("s_waitcnt lgkmcnt(0)":::"memory");
    #pragma unroll
    for(int i=0;i<4;++i){const int row=i*8+(lane>>3),ch=lane&7; const u32x4 v=*(const u32x4*)(stg+row*64+ch*8); ATTN_STORE16(Ow+(long)row*OP+ch*8,v);} }
  asm volatile("s_waitcnt lgkmcnt(0)\n\ts_barrier":::"memory");
  #undef DMA_K
  #undef DMA_V
  #undef CMASK
  #undef START
  #undef RESC
  #undef ROT
}
constexpr int ATTN_LDS_BYTES=LDS_BYTES;
struct AttnTensors { const bf16* Q; const bf16* K; const bf16* V; bf16* O; };
struct AttnUnit { int bh; int qb; };
struct StaticOrder {
  int vcu;
  __device__ __forceinline__ explicit StaticOrder(int vcu_):vcu(vcu_){}
  __device__ __forceinline__ bool next(int i,AttnUnit&u)const{ if(i>=2)return false; const int p=vcu>>6, li=vcu&63, un=li*2+i; u.bh=(p>>1)*NHEAD+(p&1)*4+(un>>5); u.qb=un&31; return true; }
  __device__ __forceinline__ void a_ready(const AttnUnit&)const{}
  __device__ __forceinline__ void done(const AttnUnit&)const{}
};
template<class Sched,int THRL=8> __device__ __forceinline__ void attn_phase(char*lds,const AttnTensors&T,const Sched&S){
  AttnUnit u;
  for(int i=0;S.next(i,u);++i){ S.a_ready(u); attn_unit<THRL>(u.bh/NHEAD,u.bh%NHEAD,u.qb,T.Q,T.K,T.V,T.O,lds); S.done(u); }
}
#undef SBAR
#undef WAIT_BAR
}
#define GAS __attribute__((address_space(1)))
#define LAS __attribute__((address_space(3)))
typedef unsigned short bf16;
typedef unsigned v4u __attribute__((ext_vector_type(4)));
typedef float f32x4 __attribute__((ext_vector_type(4)));
typedef short bf16x8 __attribute__((ext_vector_type(8)));
typedef GAS unsigned gu32;
typedef GAS unsigned long long gu64;
#define RLX_AGENT __ATOMIC_RELAXED, __HIP_MEMORY_SCOPE_AGENT
#define LDS_WAIT() asm volatile("s_waitcnt lgkmcnt(0)" ::: "memory")
#define VM_WAIT() asm volatile("s_waitcnt vmcnt(0)" ::: "memory")
__device__ __forceinline__ unsigned long long rt() { return __builtin_amdgcn_s_memrealtime(); }
__device__ __forceinline__ unsigned f2bf(float f) { unsigned u = __builtin_bit_cast(unsigned, f); return (u + 0x7fffu + ((u >> 16) & 1u)) >> 16; }
__device__ __forceinline__ unsigned pk2(float lo, float hi) { return f2bf(lo) | (f2bf(hi) << 16); }
#define XB_TMO      128
#define XB_XCNT(j)  (256  + 64 * (j))
#define XB_XSUB(j)  (1280 + 64 * (j))
#define XB_XGEN(j)  (2304 + 64 * (j))
#define XB_TOP      3328
#define XB_TOPGEN   3392
#define XCD_BAR_WORDS 3456
#define XB_SPIN_CAP (1u << 18)

__device__ __forceinline__ unsigned xb_ld(unsigned* p)              { return __hip_atomic_load(p, __ATOMIC_RELAXED, __HIP_MEMORY_SCOPE_AGENT); }
__device__ __forceinline__ unsigned xb_add(unsigned* p, unsigned v) { return __hip_atomic_fetch_add(p, v, __ATOMIC_RELAXED, __HIP_MEMORY_SCOPE_AGENT); }
__device__ __forceinline__ unsigned xb_xcc_id() { return (unsigned)__builtin_amdgcn_s_getreg((3 << 11) | 20) & 0xFu; }
#define XB_SPIN(cond, bar) do { unsigned _sp = 0; while (cond) { __builtin_amdgcn_s_sleep(1); \
    if ((++_sp & 255u) == 0u) { if (xb_ld(&(bar)[XB_TMO])) break; if (_sp > XB_SPIN_CAP) { atomicAdd(&(bar)[XB_TMO], 1u); break; } } } } while (0)

struct XcdBarrier {
    unsigned* bar; unsigned x;
    volatile LAS unsigned* st;
};

__device__ __forceinline__ XcdBarrier xcd_barrier_post(unsigned* bar, volatile LAS unsigned* st) {
    XcdBarrier b; b.bar = bar; b.x = xb_xcc_id(); b.st = st;
    if (threadIdx.x == 0) (void)xb_add(&bar[XB_XCNT(b.x)], 1u);
    return b;
}
__device__ __forceinline__ void xcd_barrier_complete(unsigned* bar, unsigned x, unsigned& nloc, unsigned& nx) {
    const unsigned G = gridDim.x * gridDim.y * gridDim.z;
    unsigned sum, cnt, mine, sp = 0u;
    for (;;) {
        sum = 0u; cnt = 0u; mine = 0u;
#pragma unroll
        for (unsigned j = 0; j < 16; ++j) { const unsigned c = xb_ld(&bar[XB_XCNT(j)]); sum += c; cnt += (c > 0u) ? 1u : 0u; mine = (j == x) ? c : mine; }
        if (sum == G) break;
        __builtin_amdgcn_s_sleep(1);
        if ((++sp & 255u) == 0u) { if (xb_ld(&bar[XB_TMO])) break; if (sp > XB_SPIN_CAP) { atomicAdd(&bar[XB_TMO], 1u); break; } }
    }
    nloc = mine > 0u ? mine : 1u; nx = cnt > 0u ? cnt : 1u;
}

__device__ __forceinline__ void xcd_barrier(const XcdBarrier& b) {
    asm volatile("s_waitcnt vmcnt(0)" ::: "memory");
    __syncthreads();
    if (threadIdx.x == 0) {
        unsigned* bar = b.bar;
        __builtin_amdgcn_s_waitcnt(0);
        unsigned nloc = b.st[0], nx = b.st[1];
        if (nloc == 0u) { xcd_barrier_complete(bar, b.x, nloc, nx); b.st[0] = nloc; b.st[1] = nx; }
        const unsigned old = xb_add(&bar[XB_XSUB(b.x)], 1u);
        const unsigned gen = old / nloc;
        if (old + 1u == (gen + 1u) * nloc) {
            __builtin_amdgcn_fence(__ATOMIC_RELEASE, "agent");
            asm volatile("s_waitcnt vmcnt(0)" ::: "memory");
            const unsigned og = xb_add(&bar[XB_TOP], 1u);
            const unsigned tg = og / nx;
            if (og + 1u == (tg + 1u) * nx) xb_add(&bar[XB_TOPGEN], 1u);
            else XB_SPIN(xb_ld(&bar[XB_TOPGEN]) == tg, bar);
            __builtin_amdgcn_fence(__ATOMIC_ACQUIRE, "agent");
            xb_add(&bar[XB_XGEN(b.x)], 1u);
            asm volatile("s_waitcnt vmcnt(0)" ::: "memory");
        } else {
            XB_SPIN(xb_ld(&bar[XB_XGEN(b.x)]) == gen, bar);
            __builtin_amdgcn_fence(__ATOMIC_ACQUIRE, "agent");
            asm volatile("s_waitcnt vmcnt(0)" ::: "memory");
        }
    }
    __syncthreads();
}

namespace pg8 {
struct EpiSwiGLU {
    static constexpr bool PERM = true, AFTER_DRAIN = false;
    bf16_t* O; int ldc;
    __device__ __forceinline__ void operator()(const f32x4 (&acc)[2][2][4][2], const Unit& u, int wr, int wc, int fr, int fq) const {
        const int row0 = u.pm * BM + wr * 64 + fr; const int col0 = u.pn * HALF + wc * 32 + 8 * fq;
#pragma unroll
        for (int ai = 0; ai < 2; ++ai)
#pragma unroll
            for (int m = 0; m < 4; ++m) { bf16_t* rowp = O + (size_t)(row0 + ai * HALF + m * 16) * ldc + col0;
                float r[8];
#pragma unroll
                for (int n = 0; n < 2; ++n)
#pragma unroll
                    for (int i = 0; i < 4; ++i) { const float g = acc[ai][0][m][n][i], up = acc[ai][1][m][n][i];
                        const float e = __builtin_amdgcn_exp2f(-g * 1.4426950408889634f); r[n * 4 + i] = g * __builtin_amdgcn_rcpf(1.0f + e) * up; }
                u32x4 w; w.x = cvt_pk_bf16(r[0], r[1]); w.y = cvt_pk_bf16(r[2], r[3]); w.z = cvt_pk_bf16(r[4], r[5]); w.w = cvt_pk_bf16(r[6], r[7]);
                *(u32x4*)rowp = w; }
    }
};
}

constexpr int NWAVES = 8;
constexpr int BATCH = 2, SEQ = 8192, D = 1024, M = BATCH * SEQ, FFH = 2816;
constexpr float EPS = 1e-6f;
constexpr int NKEY = 387, NKEYP = 392;

constexpr size_t MiB = 1u << 20, HMiB = 1u << 19;
constexpr size_t WS_CTL = 0, CTL_ZERO_BYTES = 1 * MiB;
constexpr size_t WS_SMALL = 1 * MiB;
constexpr size_t SM_MOD = 0;
constexpr size_t SM_BIAST = 131072;
constexpr size_t SM_LB = 147456;
constexpr size_t SM_TW = 262144;
constexpr size_t WS_WINAB = 2 * MiB, WS_WOUTAB = 10 * MiB, WS_WINCD = 12 * MiB, WS_WOUTCD = 14 * MiB + HMiB;
constexpr size_t WS_WF1 = 16 * MiB + HMiB, WF1_BYTES = 11 * MiB, WS_WF2 = 38 * MiB + HMiB, WF2_BYTES = 5 * MiB + HMiB;
constexpr size_t WS_XN = 50 * MiB, WS_YB = 82 * MiB, WS_Z = 114 * MiB, WS_END = 242 * MiB;
constexpr size_t SEG = (size_t)M * 512;
constexpr int CW_BAR = 4096;

constexpr int RING_OFF = 0, RING_BYTES = 131072;
constexpr int TAB_OFF = RING_BYTES;
constexpr int LDSCTL_OFF = RING_BYTES + 1024, MISC_OFF = LDSCTL_OFF + 320;
constexpr int LDS_BYTES = 147456;

__device__ __forceinline__ float bf2f(unsigned short h) { return __builtin_bit_cast(float, (unsigned)h << 16); }
__device__ __forceinline__ float bflo(unsigned w) { return __builtin_bit_cast(float, w << 16); }
__device__ __forceinline__ float bfhi(unsigned w) { return __builtin_bit_cast(float, w & 0xffff0000u); }
__device__ __forceinline__ float wave_sum(float v) {
#pragma unroll
    for (int o = 1; o < 64; o <<= 1) v += __shfl_xor(v, o);
    return v;
}
__device__ __forceinline__ float wave_max(float v) {
#pragma unroll
    for (int o = 1; o < 64; o <<= 1) v = fmaxf(v, __shfl_xor(v, o));
    return v;
}
__device__ __forceinline__ float rdlane(float v, int j) { return __builtin_bit_cast(float, __builtin_amdgcn_readlane(__builtin_bit_cast(int, v), j)); }
__device__ __forceinline__ float siluf(float g) { return g / (1.0f + __expf(-g)); }

struct Frame {
    LAS unsigned char* lds;
    volatile LAS unsigned* MISC;
    gu32* ctl;
    int tid, lane, wave, vcu, G;
    const float *x, *c, *t5, *lbl, *ada_w, *ada_b, *gains, *ab_in, *ab_out, *hnorm, *cd_in, *cd_out, *qkn, *f_in, *f_out;
    float* out;
    unsigned char* ws;
};

__device__ __forceinline__ void p_adaln(Frame& F) {
    LAS float* red = (LAS float*)(F.lds + RING_OFF);
    float* MOD = (float*)(F.ws + WS_SMALL + SM_MOD);
    const int r4 = F.lane >> 4, c4 = F.lane & 15;
    for (int task = blockIdx.x; task < 192; task += F.G) {
        const int l = task / 96, cg = task % 96;
        const float* W = F.ada_w + (size_t)l * 1024 * 6144 + cg * 64 + 4 * c4;
        f32x4 a0 = {0.f, 0.f, 0.f, 0.f}, a1 = {0.f, 0.f, 0.f, 0.f};
#pragma unroll 4
        for (int i = 0; i < 32; ++i) {
            const int row = 128 * F.wave + 4 * i + r4;
            const f32x4 wv = *(const f32x4*)(W + (size_t)row * 6144);
            const float c0 = F.c[row], c1 = F.c[1024 + row];
            a0 += siluf(c0) * wv; a1 += siluf(c1) * wv;
        }
#pragma unroll
        for (int i = 0; i < 4; ++i) { a0[i] += __shfl_xor(a0[i], 16); a0[i] += __shfl_xor(a0[i], 32); a1[i] += __shfl_xor(a1[i], 16); a1[i] += __shfl_xor(a1[i], 32); }
        if (r4 == 0) {
#pragma unroll
            for (int i = 0; i < 4; ++i) { red[(F.wave * 2 + 0) * 64 + 4 * c4 + i] = a0[i]; red[(F.wave * 2 + 1) * 64 + 4 * c4 + i] = a1[i]; }
        }
        __syncthreads();
        if (F.tid < 128) { const int b = F.tid >> 6, col = F.tid & 63; float s = 0.f;
#pragma unroll
            for (int w = 0; w < 8; ++w) s += red[(w * 2 + b) * 64 + col];
            MOD[(l * 2 + b) * 6144 + cg * 64 + col] = s + F.ada_b[l * 6144 + cg * 64 + col]; }
        __syncthreads();
    }
    if ((int)blockIdx.x == F.G - 1) {
        float* BT = (float*)(F.ws + WS_SMALL + SM_BIAST);
        for (int idx = F.tid; idx < NKEY; idx += NWAVES * 64) {
            const int r = idx / 129, j = idx - r * 129 - 64, d = (r == 0) ? 1 : (r == 1) ? 4 : 16, rel = j * d, n = rel < 0 ? -rel : rel;
            int large = 8 + (int)(log((double)(n > 1 ? n : 1) / 8.0) / log(128.0) * 8.0); if (large > 15) large = 15;
            const int bucket = (rel > 0 ? 16 : 0) + (n < 8 ? n : large);
#pragma unroll
            for (int h = 0; h < 8; ++h) BT[h * NKEYP + idx] = F.t5[bucket * 8 + h];
        }
    }
    if ((int)blockIdx.x == F.G - 2) {
        float* LB = (float*)(F.ws + WS_SMALL + SM_LB);
        for (int i = F.tid; i < 1024; i += NWAVES * 64) {
            const float l0 = F.lbl[i], l1 = F.lbl[1024 + i], l2 = F.lbl[2048 + i]; const float mx = fmaxf(l0, fmaxf(l1, l2));
            const float e0 = expf(l0 - mx), e1 = expf(l1 - mx), e2 = expf(l2 - mx); LB[i] = e0 / (e0 + e1 + e2);
        }
    }
    if ((int)blockIdx.x >= F.G - 18 && (int)blockIdx.x < F.G - 2) {
        float* TW = (float*)(F.ws + WS_SMALL + SM_TW);
        const int j = ((int)blockIdx.x - (F.G - 18)) * 512 + F.tid;
        const double a = (double)j * (6.283185307179586476925286766559 / 8192.0);
        TW[j] = (float)cos(a); TW[8192 + j] = (float)sin(a);
    }
}

__device__ __forceinline__ void transpose_item(const float* W, int K, int N, bf16* WT, int dest_row0, int k0, int n0, LAS float* scr, int lane) {
#pragma unroll 8
    for (int i = 0; i < 32; ++i) { const int kk = 2 * i + (lane >> 5); scr[kk * 33 + (lane & 31)] = W[(size_t)(k0 + kk) * N + n0 + (lane & 31)]; }
    LDS_WAIT(); asm volatile("" ::: "memory");
    const int c = lane & 7;
#pragma unroll
    for (int j = 0; j < 4; ++j) { const int n = (lane >> 3) + 8 * j; const LAS float* s = scr + (8 * c) * 33 + n;
        v4u o; o.x = pk2(s[0 * 33], s[1 * 33]); o.y = pk2(s[2 * 33], s[3 * 33]); o.z = pk2(s[4 * 33], s[5 * 33]); o.w = pk2(s[6 * 33], s[7 * 33]);
        *(GAS v4u*)(WT + (size_t)(dest_row0 + n) * K + k0 + 8 * c) = o; }
    LDS_WAIT(); asm volatile("" ::: "memory");
}
__device__ __forceinline__ void p_weights(Frame& F) {
    LAS float* scr = (LAS float*)(F.lds + RING_OFF + F.wave * 16384);
    const int gw = F.vcu * NWAVES + F.wave, NGW = F.G * NWAVES;
    constexpr int I_ABI = 16 * 128, I_ABO = 16 * 32, I_CDI = 16 * 40, I_CDO = 16 * 32, I_F1 = 16 * 176, I_F2 = 44 * 32;
    constexpr int NITEMS = I_ABI + I_ABO + I_CDI + I_CDO + 2 * I_F1 + 2 * I_F2;
    for (int it = gw; it < NITEMS; it += NGW) {
        int r = it;
        if (r < I_ABI) { const int nb = 128, kb = r / nb, n0 = 32 * (r % nb); transpose_item(F.ab_in, 1024, 4096, (bf16*)(F.ws + WS_WINAB), n0, 64 * kb, n0, scr, F.lane); continue; } r -= I_ABI;
        if (r < I_ABO) { const int nb = 32, kb = r / nb, n0 = 32 * (r % nb); transpose_item(F.ab_out, 1024, 1024, (bf16*)(F.ws + WS_WOUTAB), n0, 64 * kb, n0, scr, F.lane); continue; } r -= I_ABO;
        if (r < I_CDI) { const int nb = 40, kb = r / nb, n0 = 32 * (r % nb); transpose_item(F.cd_in, 1024, 1280, (bf16*)(F.ws + WS_WINCD), n0, 64 * kb, n0, scr, F.lane); continue; } r -= I_CDI;
        if (r < I_CDO) { const int nb = 32, kb = r / nb, n0 = 32 * (r % nb); transpose_item(F.cd_out, 1024, 1024, (bf16*)(F.ws + WS_WOUTCD), n0, 64 * kb, n0, scr, F.lane); continue; } r -= I_CDO;
        if (r < 2 * I_F1) { const int l = r / I_F1; r -= l * I_F1; const int nb = 176, kb = r / nb, n0 = 32 * (r % nb);
            const int up = n0 >= FFH ? 1 : 0, j = n0 - up * FFH, drow = 256 * (j >> 7) + 128 * up + (j & 127);
            transpose_item(F.f_in + (size_t)l * 1024 * 5632, 1024, 5632, (bf16*)(F.ws + WS_WF1 + l * WF1_BYTES), drow, 64 * kb, n0, scr, F.lane); continue; } r -= 2 * I_F1;
        { const int l = r / I_F2; r -= l * I_F2; const int nb = 32, kb = r / nb, n0 = 32 * (r % nb);
            transpose_item(F.f_out + (size_t)l * FFH * 1024, FFH, 1024, (bf16*)(F.ws + WS_WF2 + l * WF2_BYTES), n0, 64 * kb, n0, scr, F.lane); }
    }
}
__device__ __forceinline__ void p_rows(Frame& F, const float* xin, const bf16* y, const float* gate_mod  , const float* gain_post,
                                       float* xout, const float* mod_next  , const float* gain_pre, bf16* xn) {
    const int gw = F.vcu * NWAVES + F.wave, NGW = F.G * NWAVES;
    for (int b = 0; b < BATCH; ++b) {
        f32x4 A1[4], A2[4], B2[4];
#pragma unroll
        for (int j = 0; j < 4; ++j) { const int col = 4 * F.lane + 256 * j;
            if (y) { const f32x4 g = *(const f32x4*)(gate_mod + b * 6144 + col), gp = *(const f32x4*)(gain_post + col); A1[j] = g * gp; } else A1[j] = (f32x4){0.f, 0.f, 0.f, 0.f};
            if (mod_next) { const f32x4 sh = *(const f32x4*)(mod_next + b * 6144 + col), sc = *(const f32x4*)(mod_next + b * 6144 + 1024 + col), gp = *(const f32x4*)(gain_pre + col);
                A2[j] = gp * (sc + 1.0f); B2[j] = sh; } else { A2[j] = (f32x4){0.f, 0.f, 0.f, 0.f}; B2[j] = A2[j]; } }
        for (int m = b * SEQ + gw; m < (b + 1) * SEQ; m += NGW) {
            f32x4 v[4];
#pragma unroll
            for (int j = 0; j < 4; ++j) v[j] = *(const f32x4*)(xin + (size_t)m * D + 4 * F.lane + 256 * j);
            if (y) {
                f32x4 yv[4]; float ss = 0.f;
#pragma unroll
                for (int j = 0; j < 4; ++j) { const uint2 w = *(const uint2*)(y + (size_t)m * D + 4 * F.lane + 256 * j);
                    yv[j] = (f32x4){bflo(w.x), bfhi(w.x), bflo(w.y), bfhi(w.y)}; ss += (yv[j].x * yv[j].x + yv[j].y * yv[j].y) + (yv[j].z * yv[j].z + yv[j].w * yv[j].w); }
                const float rs = 1.0f / sqrtf(wave_sum(ss) * (1.0f / D) + EPS);
#pragma unroll
                for (int j = 0; j < 4; ++j) v[j] = v[j] + A1[j] * (yv[j] * rs);
            }
            if (xout) {
#pragma unroll
                for (int j = 0; j < 4; ++j) *(f32x4*)(xout + (size_t)m * D + 4 * F.lane + 256 * j) = v[j];
            }
            if (mod_next) {
                float ss = 0.f;
#pragma unroll
                for (int j = 0; j < 4; ++j) ss += (v[j].x * v[j].x + v[j].y * v[j].y) + (v[j].z * v[j].z + v[j].w * v[j].w);
                const float rs = 1.0f / sqrtf(wave_sum(ss) * (1.0f / D) + EPS);
#pragma unroll
                for (int j = 0; j < 4; ++j) { const f32x4 h = (v[j] * rs) * A2[j] + B2[j];
                    uint2 w; w.x = pk2(h.x, h.y); w.y = pk2(h.z, h.w); *(uint2*)(xn + (size_t)m * D + 4 * F.lane + 256 * j) = w; }
            }
        }
    }
}

__device__ __forceinline__ void p_dilated_naive(Frame& F, const bf16* Q, const bf16* K, const bf16* V, bf16* O  ) {
    const float* BT = (const float*)(F.ws + WS_SMALL + SM_BIAST);
    const int gw = F.vcu * NWAVES + F.wave, NGW = F.G * NWAVES, lane = F.lane;
    for (int item = gw; item < M * 8; item += NGW) {
        const int m = item >> 3, h = item & 7, b = m >> 13, t = m & 8191;
        float qf[64];
        { const uint4* qp = (const uint4*)(Q + (size_t)m * 512 + h * 64);
#pragma unroll
          for (int i = 0; i < 8; ++i) { const uint4 w = qp[i]; qf[8 * i + 0] = bflo(w.x); qf[8 * i + 1] = bfhi(w.x); qf[8 * i + 2] = bflo(w.y); qf[8 * i + 3] = bfhi(w.y);
              qf[8 * i + 4] = bflo(w.z); qf[8 * i + 5] = bfhi(w.z); qf[8 * i + 6] = bflo(w.w); qf[8 * i + 7] = bfhi(w.w); } }
        float lg[7]; int posv[7]; float mx = -3.0e38f;
#pragma unroll
        for (int g = 0; g < 7; ++g) {
            const int idx = g * 64 + lane; float l = -3.0e38f; int pos = t;
            if (idx < NKEY) { const int r = idx / 129, j = idx - r * 129 - 64, d = (r == 0) ? 1 : (r == 1) ? 4 : 16; pos = t + j * d;
                if (pos >= 0 && pos < SEQ) { const uint4* kp = (const uint4*)(K + (size_t)(b * SEQ + pos) * 512 + h * 64); float dot = 0.f;
#pragma unroll
                    for (int i = 0; i < 8; ++i) { const uint4 w = kp[i]; dot += qf[8 * i + 0] * bflo(w.x) + qf[8 * i + 1] * bfhi(w.x) + qf[8 * i + 2] * bflo(w.y) + qf[8 * i + 3] * bfhi(w.y)
                                                                            + qf[8 * i + 4] * bflo(w.z) + qf[8 * i + 5] * bfhi(w.z) + qf[8 * i + 6] * bflo(w.w) + qf[8 * i + 7] * bfhi(w.w); }
                    l = dot * 0.125f + BT[h * NKEYP + idx]; } else pos = t; }
            lg[g] = l; posv[g] = pos; mx = fmaxf(mx, l);
        }
        mx = wave_max(mx);
        float s = 0.f;
#pragma unroll
        for (int g = 0; g < 7; ++g) { lg[g] = (lg[g] > -1.0e38f) ? __expf(lg[g] - mx) : 0.f; s += lg[g]; }
        s = wave_sum(s);
        float acc = 0.f; const bf16* Vb = V + (size_t)b * SEQ * 512 + h * 64 + lane;
#pragma unroll
        for (int g = 0; g < 7; ++g) { const int n = (g < 6) ? 64 : (NKEY - 384);
            for (int j = 0; j < n; ++j) { const float pj = rdlane(lg[g], j); const int pos = __builtin_amdgcn_readlane(posv[g], j);
                if (pj != 0.f) acc += pj * bf2f(Vb[(size_t)pos * 512]); } }
        O[(size_t)m * 1024 + h * 64 + lane] = (bf16)f2bf(acc / s);
    }
}

__device__ __forceinline__ void p_hgrn_naive(Frame& F, const bf16* Qh, const bf16* Ff, const bf16* Fb, const bf16* Ih, float* Odir) {
    const float* LB = (const float*)(F.ws + WS_SMALL + SM_LB);
    constexpr int TT = 32;
    LAS float* qs = (LAS float*)(F.lds + RING_OFF);
    LAS float* fa = qs + TT * 128;
    LAS float* vv = fa + TT * 128;
    const int tid = F.tid, lane = F.lane, vi = lane & 1, kq = lane >> 1;
    for (int item = blockIdx.x; item < 128; item += F.G) {
        const int chain = item >> 3, vs = item & 7, dir = chain >> 3, b = (chain >> 2) & 1, h = chain & 3;
        const bf16* Fp = dir ? Fb : Ff;
        float S[4] = {0.f, 0.f, 0.f, 0.f};
        const int vcol = h * 128 + vs * 16 + F.wave * 2 + vi;
        for (int s0 = 0; s0 < SEQ; s0 += TT) {
            __syncthreads();
            { const int tt = tid >> 4, k0 = (tid & 15) * 8; const int t = dir ? (SEQ - 1 - (s0 + tt)) : (s0 + tt); const size_t row = (size_t)(b * SEQ + t) * 512 + h * 128 + k0;
              const uint4 qw = *(const uint4*)(Qh + row), fw = *(const uint4*)(Fp + row);
              const unsigned qa[4] = {qw.x, qw.y, qw.z, qw.w}, fb_[4] = {fw.x, fw.y, fw.z, fw.w};
#pragma unroll
              for (int i = 0; i < 4; ++i) {
                  const float lb0 = LB[dir * 512 + h * 128 + k0 + 2 * i], lb1 = LB[dir * 512 + h * 128 + k0 + 2 * i + 1];
                  qs[tt * 128 + k0 + 2 * i] = bflo(qa[i]) * 0.08838834764831845f; qs[tt * 128 + k0 + 2 * i + 1] = bfhi(qa[i]) * 0.08838834764831845f;
                  fa[tt * 128 + k0 + 2 * i] = lb0 + (1.0f - lb0) / (1.0f + __expf(-bflo(fb_[i]))); fa[tt * 128 + k0 + 2 * i + 1] = lb1 + (1.0f - lb1) / (1.0f + __expf(-bfhi(fb_[i]))); }
              if (tid < TT * 16) { const int tv = tid >> 4, vc = tid & 15; const int t2 = dir ? (SEQ - 1 - (s0 + tv)) : (s0 + tv);
                  vv[tv * 16 + vc] = bf2f(Ih[(size_t)(b * SEQ + t2) * 512 + h * 128 + vs * 16 + vc]); } }
            __syncthreads();
#pragma unroll 4
            for (int tt = 0; tt < TT; ++tt) {
                const f32x4 f4 = *(const LAS f32x4*)(fa + tt * 128 + 4 * kq), q4 = *(const LAS f32x4*)(qs + tt * 128 + 4 * kq); const float v = vv[tt * 16 + F.wave * 2 + vi];
                float o = 0.f;
#pragma unroll
                for (int i = 0; i < 4; ++i) { S[i] = f4[i] * S[i] + (1.0f - f4[i]) * v; o += q4[i] * S[i]; }
                o += __shfl_xor(o, 2); o += __shfl_xor(o, 4); o += __shfl_xor(o, 8); o += __shfl_xor(o, 16); o += __shfl_xor(o, 32);
                if (kq == 0) { const int t = dir ? (SEQ - 1 - (s0 + tt)) : (s0 + tt); Odir[((size_t)dir * M + (size_t)(b * SEQ + t)) * 512 + vcol] = o; }
            }
        }
    }
}
__device__ __forceinline__ void p_hgrn_final(Frame& F, const float* Odir, const bf16* Gh, bf16* O) {
    const int gw = F.vcu * NWAVES + F.wave, NGW = F.G * NWAVES, lane = F.lane;
    const float g0 = F.hnorm[2 * lane], g1 = F.hnorm[2 * lane + 1];
    for (int item = gw; item < M * 4; item += NGW) {
        const int m = item >> 2, h = item & 3; const size_t off = (size_t)m * 512 + h * 128 + 2 * lane;
        const float2 a = *(const float2*)(Odir + off), c = *(const float2*)(Odir + (size_t)M * 512 + off);
        const float o0 = a.x + c.x, o1 = a.y + c.y; const float rs = 1.0f / sqrtf(wave_sum(o0 * o0 + o1 * o1) * (1.0f / 128.0f) + EPS);
        const unsigned gw2 = *(const unsigned*)(Gh + off); const float r0 = o0 * rs * g0 * siluf(bflo(gw2)), r1 = o1 * rs * g1 * siluf(bfhi(gw2));
        *(unsigned*)(O + (size_t)m * 1024 + 512 + h * 128 + 2 * lane) = pk2(r0, r1);
    }
}

__device__ __forceinline__ void tab128_init(Frame& F) {
    LAS float* T = (LAS float*)(F.lds + TAB_OFF);
    if (F.tid < 128) { float s, c; sincospif((float)F.tid * (1.0f / 64.0f), &s, &c); T[F.tid] = c; T[128 + F.tid] = s; }
    __syncthreads();
}
__device__ __forceinline__ void p_fnet1_naive(Frame& F, const bf16* U  , float* APR, float* API) {
    const float* TW = (const float*)(F.ws + WS_SMALL + SM_TW);
    LAS float* T = (LAS float*)(F.lds + TAB_OFF);
    LAS float* Us = (LAS float*)(F.lds + RING_OFF);
    LAS float* Zr = Us + 64 * 129 + 64;
    LAS float* Zi = Zr + 64 * 128;
    tab128_init(F);
    const int tid = F.tid, kc = tid & 127, grp = tid >> 7;
    for (int unit = blockIdx.x; unit < 2 * 4 * 128; unit += F.G) {
        const int b = unit >> 9, g = (unit >> 7) & 3, n2 = unit & 127;
        __syncthreads();
        { const int row = tid >> 3, c0 = (tid & 7) * 16; const uint4* p = (const uint4*)(U + (size_t)(b * SEQ + 128 * row + n2) * 512 + g * 128 + c0);
#pragma unroll
          for (int i = 0; i < 2; ++i) { const uint4 w = p[i]; LAS float* d = Us + row * 129 + c0 + 8 * i;
              d[0] = bflo(w.x); d[1] = bfhi(w.x); d[2] = bflo(w.y); d[3] = bfhi(w.y); d[4] = bflo(w.z); d[5] = bfhi(w.z); d[6] = bflo(w.w); d[7] = bfhi(w.w); } }
        __syncthreads();
        { float zr[16], zi[16];
#pragma unroll
          for (int i = 0; i < 16; ++i) { zr[i] = 0.f; zi[i] = 0.f; }
          for (int c = 0; c < 128; ++c) { const int idx = (c * kc) & 127; const float cs = T[idx], sn = T[128 + idx];
#pragma unroll
              for (int i = 0; i < 16; ++i) { const float u = Us[(grp * 16 + i) * 129 + c]; zr[i] += u * cs; zi[i] -= u * sn; } }
#pragma unroll
          for (int i = 0; i < 16; ++i) { Zr[(grp * 16 + i) * 128 + kc] = zr[i]; Zi[(grp * 16 + i) * 128 + kc] = zi[i]; } }
        __syncthreads();
        { float ar[16], ai[16];
#pragma unroll
          for (int i = 0; i < 16; ++i) { ar[i] = 0.f; ai[i] = 0.f; }
          for (int n1 = 0; n1 < 64; ++n1) { const float zr = Zr[n1 * 128 + kc], zi = Zi[n1 * 128 + kc];
#pragma unroll
              for (int i = 0; i < 16; ++i) { const int idx = (2 * n1 * (grp * 16 + i)) & 127; const float cs = T[idx], sn = T[128 + idx]; ar[i] += zr * cs + zi * sn; ai[i] += zi * cs - zr * sn; } }
#pragma unroll
          for (int i = 0; i < 16; ++i) { const int k1 = grp * 16 + i; const float ct = TW[n2 * k1], st = TW[8192 + n2 * k1];
              const size_t o = ((size_t)((b * 4 + g) * 128 + n2) * 64 + k1) * 128 + kc;
              APR[o] = ar[i] * ct + ai[i] * st; API[o] = ai[i] * ct - ar[i] * st; } }
    }
}
__device__ __forceinline__ void p_fnet2_naive(Frame& F, const float* APR, const float* API, bf16* O) {
    LAS float* T = (LAS float*)(F.lds + TAB_OFF);
    LAS float* Ar = (LAS float*)(F.lds + RING_OFF);
    LAS float* Ai = Ar + 128 * 128;
    tab128_init(F);
    const int tid = F.tid, kc = tid & 127, grp = tid >> 7;
    for (int unit = blockIdx.x; unit < 2 * 4 * 64; unit += F.G) {
        const int b = unit >> 8, g = (unit >> 6) & 3, k1 = unit & 63;
        __syncthreads();
        for (int e = tid; e < 128 * 128 / 4; e += NWAVES * 64) { const int n2 = e >> 5, c4 = (e & 31) * 4; const size_t o = ((size_t)((b * 4 + g) * 128 + n2) * 64 + k1) * 128 + c4;
            *(LAS f32x4*)(Ar + n2 * 128 + c4) = *(const f32x4*)(APR + o); *(LAS f32x4*)(Ai + n2 * 128 + c4) = *(const f32x4*)(API + o); }
        __syncthreads();
        float y[32];
#pragma unroll
        for (int i = 0; i < 32; ++i) y[i] = 0.f;
        for (int n2 = 0; n2 < 128; ++n2) { const float ar = Ar[n2 * 128 + kc], ai = Ai[n2 * 128 + kc];
#pragma unroll
            for (int i = 0; i < 32; ++i) { const int idx = (n2 * (grp * 32 + i)) & 127; y[i] += ar * T[idx] + ai * T[128 + idx]; } }
#pragma unroll
        for (int i = 0; i < 32; ++i) { const int k2 = grp * 32 + i; O[(size_t)(b * SEQ + k1 + 64 * k2) * 1024 + g * 128 + kc] = (bf16)f2bf(y[i] * (1.0f / 1024.0f)); }
    }
}

__device__ __forceinline__ void p_qkprep(Frame& F, bf16* QD, bf16* KV, float qscale) {
    const int gw = F.vcu * NWAVES + F.wave, NGW = F.G * NWAVES, lane = F.lane;
    const float invf = powf(10000.0f, -(float)(lane & 15) * (1.0f / 16.0f));
    const float gq = F.qkn[lane], gk = F.qkn[64 + lane];
    for (int m = gw; m < M; m += NGW) {
        const int t = m & 8191; const float pos = (lane < 32) ? (float)(t >> 6) : (float)(t & 63); const float ang = pos * invf; const float cs = cosf(ang), sn = sinf(ang);
#pragma unroll
        for (int hh = 0; hh < 10; ++hh) {
            bf16* p = (hh < 8) ? (QD + (size_t)m * 512 + hh * 64 + lane) : (KV + (size_t)m * 512 + (hh - 8) * 64 + lane);
            const float x = bf2f(*p); const float rs = 1.0f / sqrtf(wave_sum(x * x) * (1.0f / 64.0f) + EPS); const float xn = x * rs * ((hh < 8) ? gq : gk);
            const float xp = __shfl_xor(xn, 16);
            const float r = (lane & 16) ? (xp * sn + xn * cs) : (xn * cs - xp * sn);
            *p = (bf16)f2bf(r * ((hh < 8) ? qscale : 1.0f));
        }
    }
}
__device__ __forceinline__ void p_gqa_naive(Frame& F, const bf16* QD, const bf16* KV, bf16* O) {
    const int gw = F.vcu * NWAVES + F.wave, NGW = F.G * NWAVES, lane = F.lane;
    for (int item = gw; item < M * 8; item += NGW) {
        const int m = item >> 3, hq = item & 7, b = m >> 13, hk = hq >> 2;
        float qf[64];
        { const uint4* qp = (const uint4*)(QD + (size_t)m * 512 + hq * 64);
#pragma unroll
          for (int i = 0; i < 8; ++i) { const uint4 w = qp[i]; qf[8 * i + 0] = bflo(w.x); qf[8 * i + 1] = bfhi(w.x); qf[8 * i + 2] = bflo(w.y); qf[8 * i + 3] = bfhi(w.y);
              qf[8 * i + 4] = bflo(w.z); qf[8 * i + 5] = bfhi(w.z); qf[8 * i + 6] = bflo(w.w); qf[8 * i + 7] = bfhi(w.w); } }
        float mrun = -3.0e38f, srun = 0.f, acc = 0.f;
        const bf16* Kb = KV + (size_t)b * SEQ * 512 + hk * 64; const bf16* Vb = KV + (size_t)b * SEQ * 512 + 128 + hk * 64 + lane;
        for (int kg = 0; kg < SEQ / 64; ++kg) {
            const uint4* kp = (const uint4*)(Kb + (size_t)(kg * 64 + lane) * 512); float dot = 0.f;
#pragma unroll
            for (int i = 0; i < 8; ++i) { const uint4 w = kp[i]; dot += qf[8 * i + 0] * bflo(w.x) + qf[8 * i + 1] * bfhi(w.x) + qf[8 * i + 2] * bflo(w.y) + qf[8 * i + 3] * bfhi(w.y)
                                                                    + qf[8 * i + 4] * bflo(w.z) + qf[8 * i + 5] * bfhi(w.z) + qf[8 * i + 6] * bflo(w.w) + qf[8 * i + 7] * bfhi(w.w); }
            const float mnew = fmaxf(mrun, wave_max(dot)); const float corr = __expf(mrun - mnew); const float p = __expf(dot - mnew);
            srun = srun * corr + wave_sum(p); acc *= corr; mrun = mnew;
#pragma unroll 8
            for (int j = 0; j < 64; ++j) acc += rdlane(p, j) * bf2f(Vb[(size_t)(kg * 64 + j) * 512]);
        }
        O[(size_t)m * 1024 + 512 + hq * 64 + lane] = (bf16)f2bf(acc / srun);
    }
}

namespace dil {
typedef short bf16x8 __attribute__((ext_vector_type(8)));
typedef short s16x4 __attribute__((ext_vector_type(4)));
typedef float f32x16 __attribute__((ext_vector_type(16)));
typedef unsigned u32x4v __attribute__((ext_vector_type(4)));
typedef unsigned u32x2v __attribute__((ext_vector_type(2)));
typedef short v4i16_t __attribute__((ext_vector_type(4)));
#define DIL_LAS __attribute__((address_space(3)))
constexpr float LOG2E = 1.4426950408889634f, C2 = 0.125f * LOG2E, THR = 8.0f;
constexpr int BT_OFF = 0, BT_H = 396, BT_BR = 132;
constexpr int WAVE_OFF = 12800, WAVE_BYTES = 8192;
constexpr int LDS_NEED = WAVE_OFF + 8 * WAVE_BYTES;
__device__ __forceinline__ unsigned cvtpk(float lo, float hi) { typedef float f2 __attribute__((ext_vector_type(2))); typedef __bf16 b2 __attribute__((ext_vector_type(2))); f2 v = {lo, hi}; b2 r = __builtin_convertvector(v, b2); return __builtin_bit_cast(unsigned, r); }
__device__ __forceinline__ s16x4 vtr(const DIL_LAS char* p) { return __builtin_bit_cast(s16x4, __builtin_amdgcn_ds_read_tr16_b64_v4i16((DIL_LAS v4i16_t*)p)); }
__device__ __forceinline__ float halfmax(float v) { auto rr = __builtin_amdgcn_permlane32_swap(__float_as_uint(v), __float_as_uint(v), false, false); return fmaxf(__uint_as_float(rr[0]), __uint_as_float(rr[1])); }
__device__ __forceinline__ float halfsum(float v) { auto rr = __builtin_amdgcn_permlane32_swap(__float_as_uint(v), __float_as_uint(v), false, false); return __uint_as_float(rr[0]) + __uint_as_float(rr[1]); }

__device__ __forceinline__ void tile_desc(int t, int it, int rho, int i0, int& base_tok, int& stride, int& dbase, bool& kindA, bool& tvalid) {
    if (t < 17) { const int a = (t == 0) ? 8 : ((t - 1 < 8) ? t - 1 : t); kindA = true; tvalid = (unsigned)(it - 8 + a) < 64u; base_tok = 4 * (i0 - 256 + 32 * a) + rho; stride = 4; dbase = 32 * (a - 8); }
    else { const int e = t - 17; kindA = false; tvalid = (unsigned)(4 * it - 2 + e) < 256u; base_tok = 128 * it - 64 + 32 * e; stride = 1; dbase = 32 * (e - 2) - rho; }
    if (!tvalid) base_tok = 0;
}

__device__ __forceinline__ void job(const unsigned short* __restrict__ Qg, const unsigned short* __restrict__ Kg, const unsigned short* __restrict__ Vg, unsigned short* Og,
                                    int b, int h, int rho, int it, DIL_LAS char* lbase, int wave, int lane) {
    const int c = lane & 31, hi = lane >> 5, i0 = 32 * it;
    const size_t rowb = (size_t)b * 8192;
    const int posq = 4 * (i0 + c) + rho;
    bf16x8 qf[4];
#pragma unroll
    for (int ks = 0; ks < 4; ++ks) qf[ks] = *(const bf16x8*)(Qg + (rowb + posq) * 512 + h * 64 + 16 * ks + 8 * hi);
    const DIL_LAS float* bt = (const DIL_LAS float*)(lbase + BT_OFF) + h * BT_H;
    DIL_LAS char* vbuf = lbase + WAVE_OFF + wave * WAVE_BYTES;
    const int krow = lane & 31, vrow = lane >> 1, vdh = lane & 1;
    const int vtro = ((lane >> 4) & 1) * 32 + (lane & 3) * 8 + (4 * hi + ((lane & 15) >> 2)) * 64;
    f32x16 o0, o1;
#pragma unroll
    for (int r = 0; r < 16; ++r) { o0[r] = 0.f; o1[r] = 0.f; }
    float lsum = 0.f, mhat = 0.f;
    int base_tok, stride, dbase; bool kindA, tvalid;
    tile_desc(0, it, rho, i0, base_tok, stride, dbase, kindA, tvalid);
    bf16x8 kc[4]; u32x4v vr[4];
    { const unsigned short* kp = Kg + (rowb + base_tok + stride * krow) * 512 + h * 64 + 8 * hi;
#pragma unroll
      for (int ks = 0; ks < 4; ++ks) kc[ks] = *(const bf16x8*)(kp + 16 * ks);
      const unsigned short* vp = Vg + (rowb + base_tok + stride * vrow) * 512 + h * 64 + 32 * vdh;
#pragma unroll
      for (int i = 0; i < 4; ++i) vr[i] = *(const u32x4v*)(vp + 8 * i); }
    for (int t = 0; t < 25; ++t) {
        DIL_LAS char* vb = vbuf + (t & 1) * 4096;
#pragma unroll
        for (int i = 0; i < 4; ++i) *(DIL_LAS u32x4v*)(vb + vdh * 2048 + vrow * 64 + 16 * i) = vr[i];
        const int dbase_c = dbase; const bool kindA_c = kindA, tvalid_c = tvalid;
        bf16x8 kn[4];
        if (t + 1 < 25) {
            tile_desc(t + 1, it, rho, i0, base_tok, stride, dbase, kindA, tvalid);
            const unsigned short* kp = Kg + (rowb + base_tok + stride * krow) * 512 + h * 64 + 8 * hi;
#pragma unroll
            for (int ks = 0; ks < 4; ++ks) kn[ks] = *(const bf16x8*)(kp + 16 * ks);
            const unsigned short* vp = Vg + (rowb + base_tok + stride * vrow) * 512 + h * 64 + 32 * vdh;
#pragma unroll
            for (int i = 0; i < 4; ++i) vr[i] = *(const u32x4v*)(vp + 8 * i);
        } else {
#pragma unroll
            for (int ks = 0; ks < 4; ++ks) kn[ks] = kc[ks];
        }
        f32x16 acc;
#pragma unroll
        for (int r = 0; r < 16; ++r) acc[r] = 0.f;
#pragma unroll
        for (int ks = 0; ks < 4; ++ks) acc = __builtin_amdgcn_mfma_f32_32x32x16_bf16(kc[ks], qf[ks], acc, 0, 0, 0);
        const int cm = kindA_c ? c : 4 * c;
        const int d0 = dbase_c + 4 * hi - cm;
        const int tb1 = kindA_c ? BT_BR : 0;
        const float NEG = -INFINITY;
        f32x16 t1, t2;
        float rm = NEG;
#pragma unroll
        for (int r = 0; r < 16; ++r) {
            const int dl = d0 + (r & 3) + 8 * (r >> 2);
            const bool v1 = tvalid_c && dl >= -64 && dl <= 64;
            int i1 = dl + 64; i1 = i1 < 0 ? 0 : (i1 > 128 ? 128 : i1);
            const float s = acc[r] * C2;
            t1[r] = v1 ? s + bt[tb1 + i1] : NEG;
            rm = fmaxf(rm, t1[r]);
        }
        if (kindA_c) {
#pragma unroll
            for (int r = 0; r < 16; ++r) {
                const int dl = d0 + (r & 3) + 8 * (r >> 2);
                const bool v2 = tvalid_c && ((dl & 3) == 0) && dl >= -256 && dl <= 256;
                int i2 = (dl >> 2) + 64; i2 = i2 < 0 ? 0 : (i2 > 128 ? 128 : i2);
                t2[r] = v2 ? acc[r] * C2 + bt[2 * BT_BR + i2] : NEG;
                rm = fmaxf(rm, t2[r]);
            }
        } else {
#pragma unroll
            for (int r = 0; r < 16; ++r) t2[r] = NEG;
        }
        rm = halfmax(rm);
        if (t == 0) { mhat = rm; }
        else {
            const float d = rm - mhat;
            if (__any(d > THR)) { const float dl = fmaxf(d, 0.f); mhat += dl; const float f = __builtin_amdgcn_exp2f(-dl); lsum *= f;
#pragma unroll
                for (int r = 0; r < 16; ++r) { o0[r] *= f; o1[r] *= f; } }
        }
        float p[16]; float ps = 0.f;
#pragma unroll
        for (int r = 0; r < 16; ++r) { p[r] = __builtin_amdgcn_exp2f(t1[r] - mhat) + __builtin_amdgcn_exp2f(t2[r] - mhat); ps += p[r]; }
        lsum += ps;
        u32x4v pw0, pw1;
        pw0[0] = cvtpk(p[0], p[1]); pw0[1] = cvtpk(p[2], p[3]); pw0[2] = cvtpk(p[4], p[5]); pw0[3] = cvtpk(p[6], p[7]);
        pw1[0] = cvtpk(p[8], p[9]); pw1[1] = cvtpk(p[10], p[11]); pw1[2] = cvtpk(p[12], p[13]); pw1[3] = cvtpk(p[14], p[15]);
        const bf16x8 pf0 = __builtin_bit_cast(bf16x8, pw0), pf1 = __builtin_bit_cast(bf16x8, pw1);
        const DIL_LAS char* vt = vb + vtro;
#pragma unroll
        for (int dt = 0; dt < 2; ++dt) {
            const s16x4 a0 = vtr(vt + dt * 2048), a1 = vtr(vt + dt * 2048 + 512), b0 = vtr(vt + dt * 2048 + 1024), b1 = vtr(vt + dt * 2048 + 1536);
            const bf16x8 vf0 = {a0[0], a0[1], a0[2], a0[3], a1[0], a1[1], a1[2], a1[3]}, vf1 = {b0[0], b0[1], b0[2], b0[3], b1[0], b1[1], b1[2], b1[3]};
            if (dt == 0) { o0 = __builtin_amdgcn_mfma_f32_32x32x16_bf16(vf0, pf0, o0, 0, 0, 0); o0 = __builtin_amdgcn_mfma_f32_32x32x16_bf16(vf1, pf1, o0, 0, 0, 0); }
            else         { o1 = __builtin_amdgcn_mfma_f32_32x32x16_bf16(vf0, pf0, o1, 0, 0, 0); o1 = __builtin_amdgcn_mfma_f32_32x32x16_bf16(vf1, pf1, o1, 0, 0, 0); }
        }
#pragma unroll
        for (int ks = 0; ks < 4; ++ks) kc[ks] = kn[ks];
    }
    const float inv = 1.0f / halfsum(lsum);
    unsigned short* op = Og + (rowb + posq) * 1024 + h * 64 + 4 * hi;
#pragma unroll
    for (int g = 0; g < 4; ++g) {
        u32x2v w0, w1;
        w0[0] = cvtpk(o0[4 * g] * inv, o0[4 * g + 1] * inv); w0[1] = cvtpk(o0[4 * g + 2] * inv, o0[4 * g + 3] * inv);
        w1[0] = cvtpk(o1[4 * g] * inv, o1[4 * g + 1] * inv); w1[1] = cvtpk(o1[4 * g + 2] * inv, o1[4 * g + 3] * inv);
        *(u32x2v*)(op + 8 * g) = w0; *(u32x2v*)(op + 32 + 8 * g) = w1;
    }
}
}

__device__ __forceinline__ void p_dilated(Frame& F, const bf16* Q, const bf16* K, const bf16* V, bf16* O  ) {
    const float* BT = (const float*)(F.ws + WS_SMALL + SM_BIAST);
    LAS float* bt = (LAS float*)(F.lds + RING_OFF + dil::BT_OFF);
    __syncthreads();
    for (int idx = F.tid; idx < 8 * NKEY; idx += NWAVES * 64) { const int h = idx / NKEY, rem = idx - h * NKEY, br = rem / 129, j = rem - br * 129;
        bt[h * dil::BT_H + br * dil::BT_BR + j] = BT[h * NKEYP + rem] * dil::LOG2E; }
    __syncthreads();
    const int gw = F.vcu * NWAVES + F.wave, NGW = F.G * NWAVES;
    for (int j = gw; j < 4096; j += NGW) { const int s = j >> 11, g = j & 2047, bh = 2 * (g >> 8) + s, w256 = g & 255;
        dil::job(Q, K, V, O, bh >> 3, bh & 7, w256 & 3, w256 >> 2, (LAS char*)(F.lds + RING_OFF), F.wave, F.lane); }
    __syncthreads();
}

namespace hg {
typedef short bf16x8 __attribute__((ext_vector_type(8)));
typedef short s16x4 __attribute__((ext_vector_type(4)));
typedef float f32x16 __attribute__((ext_vector_type(16)));
typedef float f32x4v __attribute__((ext_vector_type(4)));
typedef float f32x2v __attribute__((ext_vector_type(2)));
typedef unsigned u32x4v __attribute__((ext_vector_type(4)));
typedef short v4i16_t __attribute__((ext_vector_type(4)));
#define HG_LAS __attribute__((address_space(3)))
constexpr int QT_S = 272, AT_S = 144, SP_S = 272;
constexpr int L_QT = 0, L_KT = 17408, L_KB = 34816, L_VB = 51200, L_AT = 67584, L_SP = 76800, L_TOT = 111616, L_ER = 115712, L_E2 = 116224, L_END = 116736;
constexpr int NSC = 16, SCLEN = 512;
__device__ __forceinline__ int crow(int r, int hi) { return (r & 3) + 8 * (r >> 2) + 4 * hi; }
__device__ __forceinline__ s16x4 vtr(const HG_LAS char* p) { return __builtin_bit_cast(s16x4, __builtin_amdgcn_ds_read_tr16_b64_v4i16((HG_LAS v4i16_t*)p)); }
__device__ __forceinline__ unsigned short bf1(float f) { unsigned u = __builtin_bit_cast(unsigned, f); return (unsigned short)((u + 0x7fffu + ((u >> 16) & 1u)) >> 16); }
__device__ __forceinline__ unsigned pk(float lo, float hi) { return (unsigned)bf1(lo) | ((unsigned)bf1(hi) << 16); }
#define HG_BAR() do { asm volatile("s_waitcnt vmcnt(0) lgkmcnt(0)" ::: "memory"); __builtin_amdgcn_s_barrier(); asm volatile("" ::: "memory"); } while (0)

template <bool OUT>
__device__ __forceinline__ void unit(HG_LAS char* L, const unsigned short* __restrict__ Qh, const unsigned short* __restrict__ Fp, const unsigned short* __restrict__ Ih, const float* __restrict__ LB,
                                     float* Ubuf, float* LDbuf, float* Od, int dir, int b, int h, int sc, int chain, int tid, int wave, int lane) {
    const int c = lane & 31, hi = lane >> 5, vb = wave >> 1, kb0 = 2 * (wave & 1);
    f32x16 st0, st1;
    float* Up = Ubuf + (size_t)(chain * NSC + sc) * 16384;
    if (OUT) {
#pragma unroll
        for (int r = 0; r < 16; ++r) { st0[r] = Up[(32 * vb + crow(r, hi)) * 128 + 32 * kb0 + c]; st1[r] = Up[(32 * vb + crow(r, hi)) * 128 + 32 * kb0 + 32 + c]; }
    } else {
#pragma unroll
        for (int r = 0; r < 16; ++r) { st0[r] = 0.f; st1[r] = 0.f; }
    }
    const float lb0 = LB[dir * 512 + h * 128 + 2 * lane], lb1 = LB[dir * 512 + h * 128 + 2 * lane + 1];
    float ldt0 = 0.f, ldt1 = 0.f;
    HG_LAS float* TOT = (HG_LAS float*)(L + L_TOT); HG_LAS float* ER = (HG_LAS float*)(L + L_ER); HG_LAS float* E2 = (HG_LAS float*)(L + L_E2);
    const size_t rowb = (size_t)b * 8192;
    for (int j = 0; j < 8; ++j) {
        const int tg0 = SCLEN * sc + 64 * j;
        float qv[16], fav[16], cum[16]; float c0 = 0.f, c1 = 0.f;
#pragma unroll
        for (int i = 0; i < 8; ++i) {
            const int tg = tg0 + 8 * wave + i, t = dir ? (8191 - tg) : tg; const size_t row = (rowb + t) * 512 + h * 128 + 2 * lane;
            const unsigned qw = *(const unsigned*)(Qh + row), fw = *(const unsigned*)(Fp + row);
            const float f0 = __builtin_bit_cast(float, fw << 16), f1 = __builtin_bit_cast(float, fw & 0xffff0000u);
            const float a0 = lb0 + (1.0f - lb0) / (1.0f + __expf(-f0)), a1 = lb1 + (1.0f - lb1) / (1.0f + __expf(-f1));
            c0 += __logf(a0); c1 += __logf(a1);
            qv[2 * i] = __builtin_bit_cast(float, qw << 16) * 0.08838834764831845f; qv[2 * i + 1] = __builtin_bit_cast(float, qw & 0xffff0000u) * 0.08838834764831845f;
            fav[2 * i] = a0; fav[2 * i + 1] = a1; cum[2 * i] = c0; cum[2 * i + 1] = c1;
        }
        *(HG_LAS f32x2v*)(TOT + wave * 128 + 2 * lane) = (f32x2v){c0, c1};
        const int vs = tid >> 3, seg = tid & 7;
        u32x4v vv0, vv1;
        { const int tg = tg0 + vs, t = dir ? (8191 - tg) : tg; const u32x4v* vp = (const u32x4v*)(Ih + (rowb + t) * 512 + h * 128 + seg * 16); vv0 = vp[0]; vv1 = vp[1]; }
        HG_BAR();
        float off0 = 0.f, off1 = 0.f, r0 = 0.f, r1 = 0.f, bl0 = 0.f, bl1 = 0.f;
#pragma unroll
        for (int w2 = 0; w2 < 8; ++w2) { const f32x2v tt = *(const HG_LAS f32x2v*)(TOT + w2 * 128 + 2 * lane);
            if (w2 < wave) { off0 += tt.x; off1 += tt.y; } if (w2 < 4) { r0 += tt.x; r1 += tt.y; } bl0 += tt.x; bl1 += tt.y; }
#pragma unroll
        for (int i = 0; i < 8; ++i) {
            const int tau = 8 * wave + i;
            const float b0 = off0 + cum[2 * i], b1 = off1 + cum[2 * i + 1];
            const float kt0 = (1.0f - fav[2 * i]) * __expf(fminf(r0 - b0, 80.0f)), kt1 = (1.0f - fav[2 * i + 1]) * __expf(fminf(r1 - b1, 80.0f));
            const unsigned kw = pk(kt0, kt1);
            *(HG_LAS unsigned*)(L + L_KB + (lane >> 4) * 4096 + tau * 64 + ((2 * lane) & 31) * 2) = kw;
            if (OUT) { const float qt0 = qv[2 * i] * __expf(b0 - r0), qt1 = qv[2 * i + 1] * __expf(b1 - r1);
                *(HG_LAS unsigned*)(L + L_QT + tau * QT_S + 4 * lane) = pk(qt0, qt1); *(HG_LAS unsigned*)(L + L_KT + tau * QT_S + 4 * lane) = kw; }
        }
        if (wave == 0) { *(HG_LAS f32x2v*)(ER + 2 * lane) = (f32x2v){__expf(r0), __expf(r1)}; *(HG_LAS f32x2v*)(E2 + 2 * lane) = (f32x2v){__expf(bl0 - r0), __expf(bl1 - r1)}; ldt0 += bl0; ldt1 += bl1; }
        { HG_LAS char* vd = L + L_VB + (seg >> 1) * 4096 + vs * 64 + (seg & 1) * 32; *(HG_LAS u32x4v*)vd = vv0; *(HG_LAS u32x4v*)(vd + 16) = vv1; }
        HG_BAR();
        const float er0 = ER[32 * kb0 + c], er1 = ER[32 * kb0 + 32 + c];
        f32x16 sp0 = st0 * er0, sp1 = st1 * er1;
        if (OUT) {
#pragma unroll
            for (int r = 0; r < 16; ++r) { HG_LAS char* p = L + L_SP + (32 * vb + crow(r, hi)) * SP_S + (32 * kb0 + c) * 2;
                *(HG_LAS unsigned short*)p = bf1(sp0[r]); *(HG_LAS unsigned short*)(p + 64) = bf1(sp1[r]); }
            const int tb = wave >> 1, fr = lane & 15, fq = lane >> 4;
#pragma unroll
            for (int jj = 0; jj < 2; ++jj) {
                const int sb = 2 * (wave & 1) + jj; f32x4v acc = {0.f, 0.f, 0.f, 0.f};
                if (sb <= tb) {
#pragma unroll
                    for (int ks = 0; ks < 4; ++ks) {
                        const bf16x8 af = *(const HG_LAS bf16x8*)(L + L_QT + (16 * tb + fr) * QT_S + (32 * ks + 8 * fq) * 2);
                        const bf16x8 bfr = *(const HG_LAS bf16x8*)(L + L_KT + (16 * sb + fr) * QT_S + (32 * ks + 8 * fq) * 2);
                        acc = __builtin_amdgcn_mfma_f32_16x16x32_bf16(af, bfr, acc, 0, 0, 0);
                    }
                }
                const int s_ = 16 * sb + fr;
#pragma unroll
                for (int r = 0; r < 4; ++r) { const int t_ = 16 * tb + 4 * fq + r; *(HG_LAS unsigned short*)(L + L_AT + t_ * AT_S + s_ * 2) = bf1(s_ <= t_ ? acc[r] : 0.f); }
            }
            HG_BAR();
        }
        bf16x8 vf[4];
        { const HG_LAS char* vbase = L + L_VB + vb * 4096 + (8 * hi + ((lane & 15) >> 2)) * 64 + ((lane >> 4) & 1) * 32 + (lane & 3) * 8;
#pragma unroll
          for (int ks = 0; ks < 4; ++ks) { const s16x4 lo = vtr(vbase + ks * 1024), hh = vtr(vbase + ks * 1024 + 256); vf[ks] = (bf16x8){lo[0], lo[1], lo[2], lo[3], hh[0], hh[1], hh[2], hh[3]}; } }
        if (OUT) {
            const int tb2 = wave & 1; f32x16 o;
#pragma unroll
            for (int r = 0; r < 16; ++r) o[r] = 0.f;
#pragma unroll
            for (int ks = 0; ks < 4; ++ks) { const bf16x8 af = *(const HG_LAS bf16x8*)(L + L_AT + (32 * tb2 + c) * AT_S + (16 * ks + 8 * hi) * 2);
                o = __builtin_amdgcn_mfma_f32_32x32x16_bf16(af, vf[ks], o, 0, 0, 0); }
#pragma unroll
            for (int ks = 0; ks < 8; ++ks) { const bf16x8 af = *(const HG_LAS bf16x8*)(L + L_QT + (32 * tb2 + c) * QT_S + (16 * ks + 8 * hi) * 2);
                const bf16x8 bfr = *(const HG_LAS bf16x8*)(L + L_SP + (32 * vb + c) * SP_S + (16 * ks + 8 * hi) * 2);
                o = __builtin_amdgcn_mfma_f32_32x32x16_bf16(af, bfr, o, 0, 0, 0); }
#pragma unroll
            for (int r = 0; r < 16; ++r) { const int tg = tg0 + 32 * tb2 + crow(r, hi), t = dir ? (8191 - tg) : tg; Od[(rowb + t) * 512 + h * 128 + 32 * vb + c] = o[r]; }
        }
        { const HG_LAS char* kbase = L + L_KB + kb0 * 4096 + (8 * hi + ((lane & 15) >> 2)) * 64 + ((lane >> 4) & 1) * 32 + (lane & 3) * 8;
#pragma unroll
          for (int ks = 0; ks < 4; ++ks) {
              const s16x4 lo0 = vtr(kbase + ks * 1024), hh0 = vtr(kbase + ks * 1024 + 256), lo1 = vtr(kbase + 4096 + ks * 1024), hh1 = vtr(kbase + 4096 + ks * 1024 + 256);
              const bf16x8 k0 = {lo0[0], lo0[1], lo0[2], lo0[3], hh0[0], hh0[1], hh0[2], hh0[3]}, k1 = {lo1[0], lo1[1], lo1[2], lo1[3], hh1[0], hh1[1], hh1[2], hh1[3]};
              sp0 = __builtin_amdgcn_mfma_f32_32x32x16_bf16(vf[ks], k0, sp0, 0, 0, 0); sp1 = __builtin_amdgcn_mfma_f32_32x32x16_bf16(vf[ks], k1, sp1, 0, 0, 0);
          } }
        const float e20 = E2[32 * kb0 + c], e21 = E2[32 * kb0 + 32 + c];
        st0 = sp0 * e20; st1 = sp1 * e21;
    }
    if (!OUT) {
#pragma unroll
        for (int r = 0; r < 16; ++r) { Up[(32 * vb + crow(r, hi)) * 128 + 32 * kb0 + c] = st0[r]; Up[(32 * vb + crow(r, hi)) * 128 + 32 * kb0 + 32 + c] = st1[r]; }
        if (wave == 0) *(f32x2v*)(LDbuf + (size_t)(chain * NSC + sc) * 128 + 2 * lane) = (f32x2v){ldt0, ldt1};
    }
    HG_BAR();
}
}

template <bool OUT>
__device__ __forceinline__ void p_hgrn_mfma(Frame& F, const bf16* Qh, const bf16* Ff, const bf16* Fb, const bf16* Ih, float* Ubuf, float* LDbuf, float* Odir) {
    const float* LB = (const float*)(F.ws + WS_SMALL + SM_LB);
    __syncthreads();
    for (int u = F.vcu; u < 16 * hg::NSC; u += F.G) {
        const int chain = u >> 4, sc = u & 15, dir = chain >> 3, b = (chain >> 2) & 1, h = chain & 3;
        hg::unit<OUT>((LAS char*)(F.lds + RING_OFF), Qh, dir ? Fb : Ff, Ih, LB, Ubuf, LDbuf, Odir + (size_t)dir * M * 512, dir, b, h, sc, chain, F.tid, F.wave, F.lane);
    }
}
__device__ __forceinline__ void p_hgrn_scan(Frame& F, float* Ubuf, const float* LDbuf) {
    const int gt = F.vcu * NWAVES * 64 + F.tid, NT = F.G * NWAVES * 64;
    for (int e = gt; e < 16 * 16384; e += NT) {
        const int chain = e >> 14, vk = e & 16383, k = vk & 127; float carry = 0.f;
#pragma unroll 4
        for (int sc = 0; sc < hg::NSC; ++sc) { float* p = Ubuf + (size_t)(chain * hg::NSC + sc) * 16384 + vk; const float u = *p; *p = carry; carry = __expf(LDbuf[(chain * hg::NSC + sc) * 128 + k]) * carry + u; }
    }
}

#ifndef MK_ONE_LAUNCH
#define MK_ONE_LAUNCH 1
#endif
constexpr int N_PHASES = 18;
struct Args { const float* in[15]; float* out; unsigned char* ws; int ph_lo, ph_hi; };
__global__ void __launch_bounds__(NWAVES * 64, 2) mk_fwd(Args args) {
    extern __shared__ __attribute__((aligned(16))) unsigned char lds[];
    Frame F;
    F.lds = (LAS unsigned char*)lds;
    F.MISC = (volatile LAS unsigned*)(F.lds + MISC_OFF);
    F.tid = threadIdx.x; F.lane = F.tid & 63; F.wave = __builtin_amdgcn_readfirstlane(F.tid >> 6);
    F.G = gridDim.x; { const int bx = blockIdx.x; F.vcu = (F.G % 8 == 0) ? (bx % 8) * (F.G / 8) + bx / 8 : bx; }
    F.ws = args.ws; F.ctl = (gu32*)(args.ws + WS_CTL);
    F.x = args.in[0]; F.c = args.in[1]; F.t5 = args.in[2]; F.lbl = args.in[3]; F.ada_w = args.in[4]; F.ada_b = args.in[5]; F.gains = args.in[6];
    F.ab_in = args.in[7]; F.ab_out = args.in[8]; F.hnorm = args.in[9]; F.cd_in = args.in[10]; F.cd_out = args.in[11]; F.qkn = args.in[12]; F.f_in = args.in[13]; F.f_out = args.in[14];
    F.out = args.out;
    for (int u = F.tid; u < (LDS_BYTES - LDSCTL_OFF) / 4; u += NWAVES * 64) ((LAS unsigned*)(F.lds + LDSCTL_OFF))[u] = 0u;
    __syncthreads();
    XcdBarrier bar; bar.bar = (unsigned*)(F.ctl + CW_BAR); bar.x = 0; bar.st = nullptr;
    if (MK_ONE_LAUNCH) bar = xcd_barrier_post((unsigned*)(F.ctl + CW_BAR), F.MISC + 8);
    const int lo = args.ph_lo, hi = args.ph_hi;
#define IN(k) (lo <= (k) && (k) < hi)
#define SEAM(k) do { if (MK_ONE_LAUNCH && IN(k) && IN((k) + 1)) xcd_barrier(bar); } while (0)
    unsigned char* ws = args.ws;
    float* MOD = (float*)(ws + WS_SMALL + SM_MOD);
    bf16* XN = (bf16*)(ws + WS_XN); bf16* YB = (bf16*)(ws + WS_YB); bf16* Z = (bf16*)(ws + WS_Z);
    bf16* H = Z;
    const float* G0 = F.gains; const float* G1 = F.gains + 4 * 1024;
    float* MOD0 = MOD; float* MOD1 = MOD + 2 * 6144;

    if (IN(0)) { p_adaln(F); } SEAM(0);
    if (IN(1)) { p_weights(F); p_rows(F, F.x, nullptr, nullptr, nullptr, nullptr, MOD0, G0, XN); } SEAM(1);
    if (IN(2)) { pg8::Gemm g{XN, (const bf16*)(ws + WS_WINAB), M, 4096, 1024}; pg8::StaticOrder S; S.init(M, 4096, F.G, (int)blockIdx.x);
        pg8::EpiBf16<0> E{Z, 512, nullptr, 512, SEG, 1.0f};
        pg8::gemm_phase<pg8::EpiBf16<0>, pg8::StaticOrder, true, true>(F.lds + RING_OFF, g, S, E); } SEAM(2);
    float* UB = (float*)(ws + WS_YB); float* LDB = UB + (size_t)16 * hg::NSC * 16384;
    if (IN(3)) { p_hgrn_mfma<false>(F, Z + 3 * SEG, Z + 4 * SEG, Z + 5 * SEG, Z + 6 * SEG, UB, LDB, F.out); } if (MK_ONE_LAUNCH && IN(3)) xcd_barrier(bar);
    if (IN(3)) { p_hgrn_scan(F, UB, LDB); p_dilated(F, Z, Z + SEG, Z + 2 * SEG, XN); } if (MK_ONE_LAUNCH && IN(3)) xcd_barrier(bar);
    if (IN(3)) { p_hgrn_mfma<true>(F, Z + 3 * SEG, Z + 4 * SEG, Z + 5 * SEG, Z + 6 * SEG, UB, LDB, F.out); } SEAM(3);
    if (IN(4)) { p_hgrn_final(F, F.out, Z + 7 * SEG, XN); } SEAM(4);
    if (IN(5)) { pg8::Gemm g{XN, (const bf16*)(ws + WS_WOUTAB), M, 1024, 1024}; pg8::StaticOrder S; S.init(M, 1024, F.G, (int)blockIdx.x);
        pg8::EpiBf16<0> E{YB, 1024, nullptr, 0, 0, 1.0f};
        pg8::gemm_phase<pg8::EpiBf16<0>, pg8::StaticOrder, true, true>(F.lds + RING_OFF, g, S, E); } SEAM(5);
    if (IN(6)) { p_rows(F, F.x, YB, MOD0 + 2048, G0 + 1024, F.out, MOD0 + 3072, G0 + 2048, XN); } SEAM(6);
    if (IN(7)) { pg8::Gemm g{XN, (const bf16*)(ws + WS_WF1), M, 2 * FFH, 1024}; pg8::StaticOrder S; S.init(M, 2 * FFH, F.G, (int)blockIdx.x);
        pg8::EpiSwiGLU E{H, FFH};
        pg8::gemm_phase<pg8::EpiSwiGLU, pg8::StaticOrder, true, true>(F.lds + RING_OFF, g, S, E); } SEAM(7);
    if (IN(8)) { pg8::Gemm g{H, (const bf16*)(ws + WS_WF2), M, 1024, FFH}; pg8::StaticOrder S; S.init(M, 1024, F.G, (int)blockIdx.x);
        pg8::EpiBf16<0> E{YB, 1024, nullptr, 0, 0, 1.0f};
        pg8::gemm_phase<pg8::EpiBf16<0>, pg8::StaticOrder, true, true>(F.lds + RING_OFF, g, S, E); } SEAM(8);
    if (IN(9)) { p_rows(F, F.out, YB, MOD0 + 5120, G0 + 3072, F.out, MOD1, G1, XN); } SEAM(9);
    if (IN(10)) { pg8::Gemm g{XN, (const bf16*)(ws + WS_WINCD), M, 1280, 1024}; pg8::StaticOrder S; S.init(M, 1280, F.G, (int)blockIdx.x);
        pg8::EpiBf16<0> E{Z, 512, nullptr, 512, SEG, 1.0f};
        pg8::gemm_phase<pg8::EpiBf16<0>, pg8::StaticOrder, true, true>(F.lds + RING_OFF, g, S, E); } SEAM(10);
    bf16* MIX1 = Z + 4 * SEG;
    float* APR = (float*)(ws + WS_XN); float* API = APR + (size_t)2 * 4 * 128 * 64 * 128;
    if (IN(11)) { p_qkprep(F, Z + SEG, Z + 2 * SEG, attn_body::C2); p_fnet1_naive(F, Z, APR, API); } SEAM(11);
    if (IN(12)) { p_fnet2_naive(F, APR, API, MIX1); __syncthreads();
        const attn_body::AttnTensors AT{(const attn_body::bf16*)(Z + SEG), (const attn_body::bf16*)(Z + 2 * SEG), (const attn_body::bf16*)(Z + 2 * SEG + 128), (attn_body::bf16*)(MIX1 + 512)};
        const attn_body::StaticOrder S(F.vcu);
        attn_body::attn_phase<attn_body::StaticOrder>((char*)lds + RING_OFF, AT, S); } SEAM(12);
    if (IN(13)) { pg8::Gemm g{MIX1, (const bf16*)(ws + WS_WOUTCD), M, 1024, 1024}; pg8::StaticOrder S; S.init(M, 1024, F.G, (int)blockIdx.x);
        pg8::EpiBf16<0> E{YB, 1024, nullptr, 0, 0, 1.0f};
        pg8::gemm_phase<pg8::EpiBf16<0>, pg8::StaticOrder, true, true>(F.lds + RING_OFF, g, S, E); } SEAM(13);
    if (IN(14)) { p_rows(F, F.out, YB, MOD1 + 2048, G1 + 1024, F.out, MOD1 + 3072, G1 + 2048, XN); } SEAM(14);
    if (IN(15)) { pg8::Gemm g{XN, (const bf16*)(ws + WS_WF1 + WF1_BYTES), M, 2 * FFH, 1024}; pg8::StaticOrder S; S.init(M, 2 * FFH, F.G, (int)blockIdx.x);
        pg8::EpiSwiGLU E{H, FFH};
        pg8::gemm_phase<pg8::EpiSwiGLU, pg8::StaticOrder, true, true>(F.lds + RING_OFF, g, S, E); } SEAM(15);
    if (IN(16)) { pg8::Gemm g{H, (const bf16*)(ws + WS_WF2 + WF2_BYTES), M, 1024, FFH}; pg8::StaticOrder S; S.init(M, 1024, F.G, (int)blockIdx.x);
        pg8::EpiBf16<0> E{YB, 1024, nullptr, 0, 0, 1.0f};
        pg8::gemm_phase<pg8::EpiBf16<0>, pg8::StaticOrder, true, true>(F.lds + RING_OFF, g, S, E); } SEAM(16);
    if (IN(17)) { p_rows(F, F.out, YB, MOD1 + 5120, G1 + 3072, F.out, nullptr, nullptr, nullptr); }
#undef IN
#undef SEAM
}

extern "C" void kernel_launch(void* const* d_in, const int* in_sizes, int n_in, void* d_out, int out_size, void* d_ws, size_t ws_size, hipStream_t stream) {
    static int grid = 0;
    if (grid == 0) {
        if (n_in != 15 || in_sizes[0] != M * D || out_size != M * D || ws_size < WS_END) { fprintf(stderr, "kernel_launch: unexpected shapes (n_in %d, in0 %d, out %d, ws %zu)\n", n_in, n_in > 0 ? in_sizes[0] : -1, out_size, ws_size); grid = -1; return; }
        int dev = 0, cus = 0;
        if (hipGetDevice(&dev) != hipSuccess || hipDeviceGetAttribute(&cus, hipDeviceAttributeMultiprocessorCount, dev) != hipSuccess) { grid = -1; return; }
        if (hipFuncSetAttribute((const void*)mk_fwd, hipFuncAttributeMaxDynamicSharedMemorySize, LDS_BYTES) != hipSuccess) { fprintf(stderr, "kernel_launch: hipFuncSetAttribute failed\n"); grid = -1; return; }
        (void)hipGetLastError();
        grid = cus;
    }
    if (grid < 0) return;
    if (hipMemsetAsync((char*)d_ws + WS_CTL, 0, CTL_ZERO_BYTES, stream) != hipSuccess) return;
    Args a{};
    for (int i = 0; i < 15; ++i) a.in[i] = (const float*)d_in[i];
    a.out = (float*)d_out; a.ws = (unsigned char*)d_ws;
#if MK_ONE_LAUNCH
    a.ph_lo = 0; a.ph_hi = N_PHASES;
    hipLaunchKernelGGL(mk_fwd, dim3(grid), dim3(NWAVES * 64), LDS_BYTES, stream, a);
#else
    for (int p = 0; p < N_PHASES; ++p) { a.ph_lo = p; a.ph_hi = p + 1; hipLaunchKernelGGL(mk_fwd, dim3(grid), dim3(NWAVES * 64), LDS_BYTES, stream, a); }
#endif
}
```

```cpp
#include <hip/hip_runtime.h>
#include <cstdio>
#include <cstdint>
namespace pg8 {
#define PG8_LAS __attribute__((address_space(3)))
typedef unsigned short bf16_t;
typedef short bf16x8 __attribute__((ext_vector_type(8)));
typedef float f32x4 __attribute__((ext_vector_type(4)));
typedef unsigned u32x4 __attribute__((ext_vector_type(4)));
constexpr int BM = 256, BK = 64, HALF = 128, HTB = HALF * BK * 2  , STAGE_BYTES = 8 * HTB, NXCD = 8, WGM = 8;

__host__ __device__ __forceinline__ int lds_byte(int r, int c) { const int st = (r >> 4) * 2 + (c >> 5), rr = r & 15, cc = c & 31, ob = rr * 64 + cc * 2; return st * 1024 + (ob ^ (((ob >> 9) & 1) << 5)); }
__host__ __device__ __forceinline__ void stage_rc(int b, int& R, int& C) { const int st = b / 1024, sb = b % 1024, swz = sb ^ (((sb >> 9) & 1) << 5); R = (st >> 1) * 16 + swz / 64; C = (st & 1) * 32 + (swz % 64) / 2; }
__host__ __device__ __forceinline__ int perm32(int rho) { const int n = rho >> 4, i = rho & 15; return 8 * (i >> 2) + 4 * n + (i & 3); }

struct Unit { int pm, pn; };
struct Gemm { const bf16_t* A; const bf16_t* Bt; int M, N, K; };

struct StaticOrder {
    int nM, nN, nwg, G, c;
    __host__ __device__ void init(int M, int N, int G_, int c_) { nM = M / BM; nN = N / BM; nwg = nM * nN; G = G_; c = c_; }
    __host__ __device__ bool next(int i, Unit& u) const {
        const long L = (long)i * G + c; if (L >= nwg) return false;
        int wgid = (int)L; { const int q = nwg / NXCD, r = nwg % NXCD, xcd = wgid % NXCD, off = wgid / NXCD; wgid = (xcd < r ? xcd * (q + 1) : r * (q + 1) + (xcd - r) * q) + off; }
        const int nig = WGM * nN, gid = wgid / nig, fm = gid * WGM, gsz = (nM - fm) < WGM ? (nM - fm) : WGM;
        u.pm = fm + ((wgid % nig) % gsz); u.pn = (wgid % nig) / gsz; return true;
    }
    __device__ __forceinline__ void a_ready(const Unit&) const {}
    __device__ __forceinline__ void done(const Unit&) const {}
};

__device__ __forceinline__ unsigned cvt_pk_bf16(float lo, float hi) { unsigned r; asm volatile("v_cvt_pk_bf16_f32 %0, %1, %2" : "=v"(r) : "v"(lo), "v"(hi)); return r; }
typedef float f32x2 __attribute__((ext_vector_type(2)));
__device__ __forceinline__ f32x2 gelu_pk(f32x2 v) {
    const f32x2 av = __builtin_elementwise_abs(v), d = av * 0.2316418882f + 1.0f;
    f32x2 t; t.x = __builtin_amdgcn_rcpf(d.x); t.y = __builtin_amdgcn_rcpf(d.y);
    f32x2 q = t * 0.5307027145f + (-0.7265760135f); q = q * t + 0.7107068705f; q = q * t + (-0.142248368f); q = q * t + 0.127414796f; q = q * t;
    const f32x2 s = (v * v) * (-0.72134752044f);
    f32x2 e; e.x = __builtin_amdgcn_exp2f(s.x); e.y = __builtin_amdgcn_exp2f(s.y);
    const f32x2 m = v * (q * e), r = v - m;
    f32x2 o; o.x = v.x < 0.f ? m.x : r.x; o.y = v.y < 0.f ? m.y : r.y; return o;
}

template <int ACT  > struct EpiBf16 {
    static constexpr bool PERM = true, AFTER_DRAIN = false; static_assert(ACT == 0 || ACT == 1, "EpiBf16: ACT is 0 (none) or 1 (gelu_pk)");
    bf16_t* O; int ldc; const float* bias; int split_cols; size_t split_stride; float scale0;
    __device__ __forceinline__ void operator()(const f32x4 (&acc)[2][2][4][2], const Unit& u, int wr, int wc, int fr, int fq) const {
        const int row0 = u.pm * BM + wr * 64 + fr; int colt = u.pn * BM; bf16_t* base = O;
        float sc = 1.f; if (split_cols) { const int t = colt / split_cols; base += (size_t)t * split_stride; colt -= t * split_cols; if (t == 0) sc = scale0; }
        const int col0 = colt + wc * 32 + 8 * fq, bcol0 = u.pn * BM + wc * 32 + 8 * fq;
        f32x4 bv[2][2];
#pragma unroll
        for (int bj = 0; bj < 2; ++bj)
#pragma unroll
            for (int n = 0; n < 2; ++n) bv[bj][n] = bias ? *(const f32x4*)(bias + bcol0 + bj * HALF + 4 * n) : (f32x4){0.f, 0.f, 0.f, 0.f};
#pragma unroll
        for (int ai = 0; ai < 2; ++ai)
#pragma unroll
            for (int m = 0; m < 4; ++m) { bf16_t* rowp = base + (size_t)(row0 + ai * HALF + m * 16) * ldc + col0;
#pragma unroll
                for (int bj = 0; bj < 2; ++bj) { f32x4 v0 = acc[ai][bj][m][0] + bv[bj][0], v1 = acc[ai][bj][m][1] + bv[bj][1];
                    if (ACT == 1) { f32x2 a = gelu_pk((f32x2){v0[0], v0[1]}), b = gelu_pk((f32x2){v0[2], v0[3]}), c = gelu_pk((f32x2){v1[0], v1[1]}), d = gelu_pk((f32x2){v1[2], v1[3]});
                        v0 = (f32x4){a.x, a.y, b.x, b.y}; v1 = (f32x4){c.x, c.y, d.x, d.y}; }
                    v0 = v0 * sc; v1 = v1 * sc; u32x4 w; w.x = cvt_pk_bf16(v0[0], v0[1]); w.y = cvt_pk_bf16(v0[2], v0[3]); w.z = cvt_pk_bf16(v1[0], v1[1]); w.w = cvt_pk_bf16(v1[2], v1[3]);
                    *(u32x4*)(rowp + bj * HALF) = w; } }
    }
};
template <class Epi, class Sched, bool ALIGN_EPI = false, bool SP2 = false>
__device__ __forceinline__ void gemm_phase(PG8_LAS unsigned char* lds, const Gemm g, const Sched& S, const Epi& E) {
    const int tid = threadIdx.x, wid = __builtin_amdgcn_readfirstlane(tid >> 6), lane = tid & 63, wr = wid >> 2, wc = wid & 3, fr = lane & 15, fq = lane >> 4;
    const int K = g.K, nt = K / BK;
    unsigned voffA[2], voffB[2];
#pragma unroll
    for (int i = 0; i < 2; ++i) { int R, C; stage_rc(tid * 16 + i * 8192, R, C); const int Rb = Epi::PERM ? ((R & ~31) + perm32(R & 31)) : R;
        voffA[i] = (unsigned)(R * K + C) * 2u; voffB[i] = (unsigned)(Rb * K + C) * 2u; }
    const size_t kstep = (size_t)(BK * 2);
    const size_t hstep = (size_t)HALF * K * 2;
    const size_t tstep = 2 * hstep;
    const unsigned ldsw = (unsigned)wid * 1024u;
    const int aoff = lds_byte(wr * 64 + fr, fq * 8), boff = lds_byte(wc * 32 + fr, fq * 8);
#define PG8_SA(b, h) (((b) * 2 + (h)) * HTB)
#define PG8_SB(b, h) ((4 + (b) * 2 + (h)) * HTB)
#define PG8_STAGE(bufoff, gbase, voff) do { _Pragma("unroll") for (int _i = 0; _i < 2; ++_i) \
        __builtin_amdgcn_global_load_lds((const unsigned*)((const char*)(gbase) + (voff)[_i]), (PG8_LAS unsigned*)(lds + (bufoff) + ldsw + _i * 8192), 16, 0, 0); } while (0)
#define PG8_LDA(dst, b, h) do { _Pragma("unroll") for (int m = 0; m < 4; ++m) _Pragma("unroll") for (int k = 0; k < 2; ++k) dst[m][k] = *(const PG8_LAS bf16x8*)(lds + PG8_SA(b, h) + aoff + m * 2048 + k * 1024); } while (0)
#define PG8_LDB(dst, b, h) do { _Pragma("unroll") for (int n = 0; n < 2; ++n) _Pragma("unroll") for (int k = 0; k < 2; ++k) dst[n][k] = *(const PG8_LAS bf16x8*)(lds + PG8_SB(b, h) + boff + n * 2048 + k * 1024); } while (0)
#define PG8_MMA(ai, bj, At, Bt) do { __builtin_amdgcn_s_setprio(1); _Pragma("unroll") for (int m = 0; m < 4; ++m) _Pragma("unroll") for (int n = 0; n < 2; ++n) _Pragma("unroll") for (int k = 0; k < 2; ++k) \
        acc[ai][bj][m][n] = __builtin_amdgcn_mfma_f32_16x16x32_bf16(Bt[n][k], At[m][k], acc[ai][bj][m][n], 0, 0, 0); __builtin_amdgcn_s_setprio(0); } while (0)
#define PG8_WAIT_V(n) asm volatile("s_waitcnt vmcnt(" #n ")" ::: "memory")
#define PG8_WAIT_L(n) asm volatile("s_waitcnt lgkmcnt(" #n ")" ::: "memory")
#define PG8_BAR __builtin_amdgcn_s_barrier()
#define PG8_SCHED __builtin_amdgcn_sched_barrier(0)
    Unit cur, nxt; int ui = 0;
    if (!S.next(0, cur)) return;
    f32x4 acc[2][2][4][2];
#pragma unroll
    for (int a = 0; a < 2; ++a)
#pragma unroll
        for (int b = 0; b < 2; ++b)
#pragma unroll
            for (int m = 0; m < 4; ++m)
#pragma unroll
                for (int n = 0; n < 2; ++n) acc[a][b][m][n] = (f32x4){0.f, 0.f, 0.f, 0.f};
    bf16x8 At[4][2], B0[2][2], B1[2][2];
    const char* cA = (const char*)g.A + (size_t)cur.pm * tstep; const char* cB = (const char*)g.Bt + (size_t)cur.pn * tstep;
    S.a_ready(cur);
    if constexpr (SP2) {
        PG8_STAGE(PG8_SB(0, 0), cB, voffB); PG8_STAGE(PG8_SB(0, 1), cB + hstep, voffB); PG8_STAGE(PG8_SA(0, 0), cA, voffA); PG8_STAGE(PG8_SA(0, 1), cA + hstep, voffA);
        if (wr == 1) PG8_BAR;
        PG8_WAIT_V(2); PG8_BAR;
        PG8_STAGE(PG8_SB(1, 0), cB + kstep, voffB); PG8_STAGE(PG8_SA(1, 0), cA + kstep, voffA); PG8_STAGE(PG8_SB(1, 1), cB + hstep + kstep, voffB);
        PG8_WAIT_V(6); PG8_BAR;
    } else {
        PG8_STAGE(PG8_SB(0, 0), cB, voffB); PG8_STAGE(PG8_SA(0, 0), cA, voffA); PG8_STAGE(PG8_SB(0, 1), cB + hstep, voffB); PG8_STAGE(PG8_SA(0, 1), cA + hstep, voffA);
        if (wr == 1) PG8_BAR;
        PG8_WAIT_V(4); PG8_BAR;
        PG8_STAGE(PG8_SB(1, 0), cB + kstep, voffB); PG8_STAGE(PG8_SA(1, 0), cA + kstep, voffA); PG8_STAGE(PG8_SB(1, 1), cB + hstep + kstep, voffB);
        PG8_WAIT_V(6); PG8_BAR;
    }
    for (;;) {
        const bool has_next = S.next(ui + 1, nxt);
        const char* nA = has_next ? (const char*)g.A + (size_t)nxt.pm * tstep : cA; const char* nB = has_next ? (const char*)g.Bt + (size_t)nxt.pn * tstep : cB;
        for (int t = 0; t < nt; t += 2) {
            const bool last = (t == nt - 2);
            const char* a1 = cA + (size_t)(t + 1) * kstep;
            const char* a2 = last ? nA : cA + (size_t)(t + 2) * kstep; const char* b2 = last ? nB : cB + (size_t)(t + 2) * kstep;
            const char* a3 = a2 + kstep; const char* b3 = b2 + kstep;
            if (last && has_next) S.a_ready(nxt);
            if constexpr (SP2) {
            PG8_LDB(B0, 0, 0); PG8_LDB(B1, 0, 1); PG8_SCHED; PG8_LDA(At, 0, 0); PG8_STAGE(PG8_SA(1, 1), a1 + hstep, voffA);
            PG8_WAIT_V(8); PG8_WAIT_L(0); PG8_BAR; PG8_MMA(0, 0, At, B0); PG8_MMA(0, 1, At, B1); PG8_BAR; PG8_SCHED;
            PG8_LDA(At, 0, 1); PG8_STAGE(PG8_SB(0, 0), b2, voffB); PG8_STAGE(PG8_SB(0, 1), b2 + hstep, voffB); PG8_STAGE(PG8_SA(0, 0), a2, voffA);
            PG8_WAIT_V(8); PG8_WAIT_L(0); PG8_BAR; PG8_MMA(1, 0, At, B0); PG8_MMA(1, 1, At, B1); PG8_BAR; PG8_SCHED;
            PG8_LDB(B0, 1, 0); PG8_LDB(B1, 1, 1); PG8_SCHED; PG8_LDA(At, 1, 0); PG8_STAGE(PG8_SA(0, 1), a2 + hstep, voffA);
            PG8_WAIT_V(8); PG8_WAIT_L(0); PG8_BAR; PG8_MMA(0, 0, At, B0); PG8_MMA(0, 1, At, B1); PG8_BAR; PG8_SCHED;
            PG8_LDA(At, 1, 1); PG8_STAGE(PG8_SB(1, 0), b3, voffB); PG8_STAGE(PG8_SB(1, 1), b3 + hstep, voffB); PG8_STAGE(PG8_SA(1, 0), a3, voffA);
            PG8_WAIT_V(8); PG8_WAIT_L(0); PG8_BAR; PG8_MMA(1, 0, At, B0); PG8_MMA(1, 1, At, B1); PG8_BAR; PG8_SCHED;
            } else {
            PG8_LDB(B0, 0, 0); PG8_SCHED; PG8_LDA(At, 0, 0); PG8_STAGE(PG8_SA(1, 1), a1 + hstep, voffA);
            PG8_WAIT_L(8); PG8_BAR; PG8_WAIT_L(0); PG8_MMA(0, 0, At, B0); PG8_BAR; PG8_SCHED;
            PG8_LDB(B1, 0, 1); PG8_STAGE(PG8_SB(0, 0), b2, voffB);
            PG8_BAR; PG8_WAIT_L(0); PG8_MMA(0, 1, At, B1); PG8_BAR;
            PG8_LDA(At, 0, 1); PG8_STAGE(PG8_SA(0, 0), a2, voffA);
            PG8_BAR; PG8_WAIT_L(0); PG8_MMA(1, 0, At, B0); PG8_BAR; PG8_SCHED;
            PG8_STAGE(PG8_SB(0, 1), b2 + hstep, voffB);
            PG8_WAIT_V(6); PG8_BAR; PG8_MMA(1, 1, At, B1); PG8_BAR;
            PG8_LDB(B0, 1, 0); PG8_SCHED; PG8_LDA(At, 1, 0); PG8_STAGE(PG8_SA(0, 1), a2 + hstep, voffA);
            PG8_WAIT_L(8); PG8_BAR; PG8_WAIT_L(0); PG8_MMA(0, 0, At, B0); PG8_BAR; PG8_SCHED;
            PG8_LDB(B1, 1, 1); PG8_STAGE(PG8_SB(1, 0), b3, voffB);
            PG8_BAR; PG8_WAIT_L(0); PG8_MMA(0, 1, At, B1); PG8_BAR;
            PG8_LDA(At, 1, 1); PG8_STAGE(PG8_SA(1, 0), a3, voffA);
            PG8_BAR; PG8_WAIT_L(0); PG8_MMA(1, 0, At, B0); PG8_BAR; PG8_SCHED;
            PG8_STAGE(PG8_SB(1, 1), b3 + hstep, voffB);
            PG8_WAIT_V(6); PG8_BAR; PG8_MMA(1, 1, At, B1); PG8_BAR;
            }
        }
        if constexpr (ALIGN_EPI) { if (wr == 0) PG8_BAR; }
        if constexpr (!Epi::AFTER_DRAIN) { E(acc, cur, wr, wc, fr, fq); S.done(cur); }
        if (!has_next) break;
#pragma unroll
        for (int a = 0; a < 2; ++a)
#pragma unroll
            for (int b = 0; b < 2; ++b)
#pragma unroll
                for (int m = 0; m < 4; ++m)
#pragma unroll
                    for (int n = 0; n < 2; ++n) acc[a][b][m][n] = (f32x4){0.f, 0.f, 0.f, 0.f};
        cur = nxt; cA = nA; cB = nB; ++ui;
        if constexpr (ALIGN_EPI) { if (wr == 1) PG8_BAR; }
    }
    PG8_WAIT_V(0);
    if constexpr (!ALIGN_EPI) { if (wr == 0) PG8_BAR; }
    PG8_BAR;
    if constexpr (Epi::AFTER_DRAIN) { E.fused(acc, cur, wr, wc, fr, fq, lds, wid, lane); S.done(cur); }
#undef PG8_SA
#undef PG8_SB
#undef PG8_STAGE
#undef PG8_LDA
#undef PG8_LDB
#undef PG8_MMA
#undef PG8_WAIT_V
#undef PG8_WAIT_L
#undef PG8_BAR
#undef PG8_SCHED
}
}
#include <hip/hip_bf16.h>
#include <cmath>
namespace attn_body {
using bf16=__hip_bfloat16;
using bf16x8=__attribute__((ext_vector_type(8)))short;
using s16x4=__attribute__((ext_vector_type(4)))short;
using f32x16=__attribute__((ext_vector_type(16)))float;
using u32x4=__attribute__((ext_vector_type(4)))unsigned;
constexpr int BATCH=2,NHEAD=8,NKVH=2,SEQ=8192,D=64,QP=512,KP=512,VP=512,OP=1024;
constexpr int NW=8,QBLK=32,QB=QBLK*NW,KVBLK=64,NQB=SEQ/QB;
constexpr int ATTN_UNIT_ROWS=QB;
__device__ __forceinline__ int crow(int r,int hi){return (r&3)+8*(r>>2)+4*hi;}
#define SBAR() __builtin_amdgcn_sched_barrier(0)
__device__ __forceinline__ void cmask(f32x16&p0,f32x16&p1,int jb,int qrel,int hi){
  const float NEG=-INFINITY; int kb=64*jb+4*hi;
  #pragma unroll
  for(int r=0;r<16;++r){int kv=kb+(r&3)+8*(r>>2); if(kv>qrel)p0[r]=NEG; if(kv+32>qrel)p1[r]=NEG;}
}

constexpr int NSLOT=3, SLOTB=8192;
constexpr int LDS_K=0, LDS_V=NSLOT*SLOTB, LDS_WS=2*NSLOT*SLOTB, LDS_OST=LDS_WS+NW*64*4, LDS_BYTES=LDS_OST+NW*4096;
constexpr float C2=0.125f*1.4426950408889634f;
__device__ __forceinline__ void glds16(const void*gsrc,unsigned lds_dst){unsigned keep;
  asm volatile("s_mov_b32 %0, m0\n\ts_mov_b32 m0, %2\n\ts_nop 0\n\tglobal_load_lds_dwordx4 %1, off\n\ts_mov_b32 m0, %0":"=&s"(keep):"v"(gsrc),"s"(lds_dst):"memory");}
__device__ __forceinline__ float max3f(float a,float b,float c){float r;asm("v_max3_f32 %0, %1, %2, %3":"=v"(r):"v"(a),"v"(b),"v"(c));return r;}
__device__ __forceinline__ float max2f(float a,float b){float r;asm("v_max_f32_e32 %0, %1, %2":"=v"(r):"v"(a),"v"(b));return r;}
__device__ __forceinline__ float fadd_s(float a,float b){float r;asm("v_add_f32_e32 %0, %1, %2":"=v"(r):"v"(a),"v"(b));return r;}
__device__ __forceinline__ float fsub_s(float a,float b){float r;asm("v_sub_f32_e32 %0, %1, %2":"=v"(r):"v"(a),"v"(b));return r;}
typedef float f32x2_t __attribute__((ext_vector_type(2))); typedef __bf16 bf16x2_t __attribute__((ext_vector_type(2)));
__device__ __forceinline__ unsigned cvtpk_s(float lo,float hi){f32x2_t v={lo,hi};bf16x2_t b=__builtin_convertvector(v,bf16x2_t);return __builtin_bit_cast(unsigned,b);}
#define WAIT_BAR(N) asm volatile("s_waitcnt vmcnt(" #N ") lgkmcnt(0)\n\ts_barrier":::"memory")

__device__ __forceinline__ void qkt(f32x16&p0,f32x16&p1,const char*Kslot,const bf16x8*qr,const f32x16&negm,int r32,int hi){
  const char*kb=Kslot+hi*1024+r32*16;
  #pragma unroll
  for(int d0=0;d0<4;++d0){
    const bf16x8 b0=*reinterpret_cast<const bf16x8*>(kb+d0*2048);
    const bf16x8 b1=*reinterpret_cast<const bf16x8*>(kb+d0*2048+512);
    if(d0==0){p0=__builtin_amdgcn_mfma_f32_32x32x16_bf16(b0,qr[0],negm,0,0,0);p1=__builtin_amdgcn_mfma_f32_32x32x16_bf16(b1,qr[0],negm,0,0,0);}
    else{p0=__builtin_amdgcn_mfma_f32_32x32x16_bf16(b0,qr[d0],p0,0,0,0);p1=__builtin_amdgcn_mfma_f32_32x32x16_bf16(b1,qr[d0],p1,0,0,0);}}
}
typedef __attribute__((address_space(3))) const char* lds_cptr;
typedef short v4i16_t __attribute__((ext_vector_type(4)));
__device__ __forceinline__ void kload8(bf16x8*kf,lds_cptr kp){
  kf[0]=*(const __attribute__((address_space(3))) bf16x8*)(kp);      kf[1]=*(const __attribute__((address_space(3))) bf16x8*)(kp+512);
  kf[2]=*(const __attribute__((address_space(3))) bf16x8*)(kp+2048); kf[3]=*(const __attribute__((address_space(3))) bf16x8*)(kp+2560);
  kf[4]=*(const __attribute__((address_space(3))) bf16x8*)(kp+4096); kf[5]=*(const __attribute__((address_space(3))) bf16x8*)(kp+4608);
  kf[6]=*(const __attribute__((address_space(3))) bf16x8*)(kp+6144); kf[7]=*(const __attribute__((address_space(3))) bf16x8*)(kp+6656);
}
__device__ __forceinline__ void kload2(bf16x8*kf,lds_cptr kp,int j){ kf[2*j]=*(const __attribute__((address_space(3))) bf16x8*)(kp+j*2048); kf[2*j+1]=*(const __attribute__((address_space(3))) bf16x8*)(kp+j*2048+512); }
__device__ __forceinline__ s16x4 vtr(lds_cptr p){ return __builtin_bit_cast(s16x4,__builtin_amdgcn_ds_read_tr16_b64_v4i16((__attribute__((address_space(3))) v4i16_t*)p)); }
__device__ __forceinline__ float rowmax(const f32x16&p0,const f32x16&p1){
  float a=max3f(p0[0],p0[1],p1[0]),b=max3f(p0[2],p0[3],p1[1]);a=max3f(a,p1[2],p1[3]);
  #pragma unroll
  for(int r=4;r<16;r+=4){a=max3f(a,p0[r],p0[r+1]);b=max3f(b,p0[r+2],p0[r+3]);a=max3f(a,p1[r],p1[r+1]);b=max3f(b,p1[r+2],p1[r+3]);}
  const float m=max2f(a,b);
  auto rr=__builtin_amdgcn_permlane32_swap(__float_as_uint(m),__float_as_uint(m),false,false);
  return max2f(__uint_as_float(rr[0]),__uint_as_float(rr[1]));
}
__device__ __forceinline__ void pv(f32x16*o,int vb,bf16x8 pa0,bf16x8 pa1,bf16x8 pa2,bf16x8 pa3){
  #pragma unroll
  for(int d0=0;d0<2;++d0){s16x4 lo[4],hi[4];
    #pragma unroll
    for(int ks=0;ks<4;++ks){
      asm volatile("ds_read_b64_tr_b16 %0,%1 offset:%c2":"=&v"(lo[ks]):"v"(vb),"i"(d0*4096+ks*1024):"memory");
      asm volatile("ds_read_b64_tr_b16 %0,%1 offset:%c2":"=&v"(hi[ks]):"v"(vb),"i"(d0*4096+ks*1024+512):"memory");}
    asm volatile("s_waitcnt lgkmcnt(0)":::"memory");SBAR();
    #define PK(k) (bf16x8){lo[k][0],lo[k][1],lo[k][2],lo[k][3],hi[k][0],hi[k][1],hi[k][2],hi[k][3]}
    o[d0]=__builtin_amdgcn_mfma_f32_32x32x16_bf16(pa0,PK(0),o[d0],0,0,0);
    o[d0]=__builtin_amdgcn_mfma_f32_32x32x16_bf16(pa1,PK(1),o[d0],0,0,0);
    o[d0]=__builtin_amdgcn_mfma_f32_32x32x16_bf16(pa2,PK(2),o[d0],0,0,0);
    o[d0]=__builtin_amdgcn_mfma_f32_32x32x16_bf16(pa3,PK(3),o[d0],0,0,0);
    #undef PK
  }
}

#ifndef ATTN_STORE16
#define ATTN_STORE16(p,v) (*(u32x4*)(p)=(v))
#endif
template<int THRL> __device__ __forceinline__ void attn_unit(int b,int h,int qb,const bf16*Q,const bf16*__restrict__ K,const bf16*__restrict__ V,bf16*O,char*shm){
  const int tid=threadIdx.x,lane=tid&63,r32=lane&31,hi=lane>>5; const int wid=__builtin_amdgcn_readfirstlane(tid>>6);
  const long rowbase=(long)b*SEQ; const int q0=qb*QB;
  const bf16*Qw=Q+(rowbase+q0+wid*QBLK)*QP+h*D; const int hk=h>>2;
  const bf16*Kh=K+rowbase*KP+hk*D,*Vh=V+rowbase*VP+hk*D;
  const unsigned lds0=(unsigned)(uintptr_t)shm;
  float*wsf=(float*)(shm+LDS_WS)+wid*64;
  const bf16*ksrc=Kh+(long)lane*KP+wid*8;
  const bf16*vsrc=Vh+(long)(16*(wid&3)+(lane>>2))*VP+(wid>>2)*32+(lane&3)*8;
  const unsigned kdst=lds0+LDS_K+wid*1024, vdst=lds0+LDS_V+wid*1024;
  #define DMA_K(t,slot) glds16(ksrc+(long)(t)*KVBLK*KP,(unsigned)__builtin_amdgcn_readfirstlane(kdst+(slot)))
  #define DMA_V(t,slot) glds16(vsrc+(long)(t)*KVBLK*VP,(unsigned)__builtin_amdgcn_readfirstlane(vdst+(slot)))
  const int vb0=(int)(lds0+LDS_V)+((lane>>4)&1)*32+(lane&3)*8+(4*hi+((lane&15)>>2))*64;
  const char*Kbase=shm+LDS_K; bf16x8 kf[8];
  const lds_cptr shm3=(lds_cptr)shm; const lds_cptr kp0=shm3+LDS_K+hi*1024+r32*16; const lds_cptr vp0=shm3+LDS_V+((lane>>4)&1)*32+(lane&3)*8+(4*hi+((lane&15)>>2))*64;
  const int NT=SEQ/KVBLK;
  DMA_K(0,0);DMA_V(0,0);DMA_K(1,SLOTB);
  bf16x8 qr[4];
  #pragma unroll
  for(int d0=0;d0<4;++d0)qr[d0]=*reinterpret_cast<const bf16x8*>(&Qw[(long)r32*QP+d0*16+hi*8]);
  float mhat=0.f,l_reg=0.f;f32x16 o[2];o[0]=f32x16{};o[1]=f32x16{};f32x16 negm=f32x16{};asm volatile("":"+v"(negm));

  #define CMASK(P0,P1,t) do{}while(0)
  bool resc=false;
  #define START(P0,P1) do{ const float rm=rowmax(P0,P1); resc=false; \
    { const float dl=rm; mhat=fadd_s(mhat,dl); \
      _Pragma("unroll") for(int r=0;r<16;++r){P0[r]=fsub_s(P0[r],dl);P1[r]=fsub_s(P1[r],dl);} \
      _Pragma("unroll") for(int r=0;r<16;++r)negm[r]=-mhat; asm volatile("":"+v"(negm)); } \
    _Pragma("unroll") for(int r=0;r<16;++r)P0[r]=__builtin_amdgcn_exp2f(P0[r]); }while(0)
  #define RESC() do{ if(resc){ asm volatile("s_waitcnt lgkmcnt(0)":::"memory"); \
      _Pragma("unroll") for(int d_=0;d_<2;++d_) _Pragma("unroll") for(int r=0;r<16;++r)o[d_][r]*=wsf[crow(r,hi)]; } }while(0)
  f32x16 pA0,pA1,pB0,pB1;
  int sl_prev=0,sl_cur=0,sl_next=SLOTB;
  #define ROT() do{sl_prev=sl_cur;sl_cur=sl_next;sl_next=(sl_next==(NSLOT-1)*SLOTB)?0:sl_next+SLOTB;}while(0)
  DMA_K(2,2*SLOTB);
  WAIT_BAR(3);
  qkt(pA0,pA1,Kbase,qr,negm,r32,hi);asm volatile("s_nop 15\n\ts_nop 7":"+v"(pA0),"+v"(pA1));CMASK(pA0,pA1,0);
  START(pA0,pA1);
  _Pragma("unroll") for(int r=0;r<16;++r)pA1[r]=__builtin_amdgcn_exp2f(pA1[r]);
  WAIT_BAR(0);
  DMA_K(3,0);DMA_V(1,SLOTB);
  ROT();
  kload8(kf,kp0+sl_cur);
  WAIT_BAR(2);
  s16x4 vlo[8],vhi[8]; u32x4 pw0,pw1,pw2,pw3;
  #define PKW(P,B) cvtpk_s(P[B],P[B+1])
  #define PAF(k) __builtin_bit_cast(bf16x8,pw##k)
  #define VFR(i) (bf16x8){vlo[i][0],vlo[i][1],vlo[i][2],vlo[i][3],vhi[i][0],vhi[i][1],vhi[i][2],vhi[i][3]}
  #define PIN(x) asm volatile("":"+v"(x))
  #define MX3(a,b,c) __builtin_fmaxf(__builtin_fmaxf((a),(b)),(c))
  #define GAPA(MF,A0,A1,A2,A3,W0,W1,PW) do{ MF; sacc+=A0; sacc+=A1; sacc+=A2; sacc+=A3; PIN(sacc); W0; W1; PIN(PW); SBAR(); }while(0)
  #define EX(v) __builtin_amdgcn_exp2f(v)
  #define GAPB(MF,X,B) do{ MF; X[B]=EX(X[B]); X[B+1]=EX(X[B+1]); X[B+2]=EX(X[B+2]); X[B+3]=EX(X[B+3]); PIN(X); SBAR(); }while(0)
  #define VRD(i) do{ vlo[i]=vtr(vp_+(((i)>>2)*4096+((i)&3)*1024)); vhi[i]=vtr(vp_+(((i)>>2)*4096+((i)&3)*1024+512)); }while(0)
  #define KRD(G,j) do{ if(G){ kload2(kf,kp0+sl_next,j); SBAR(); } }while(0)
  #define STEP(C0,C1,P0,P1,t,GK,GV,GL) do{ SBAR(); \
    const lds_cptr vp_=vp0+sl_prev; \
    VRD(0); SBAR(); float sacc=(P0[0]+P0[1]); \
    GAPA(C0=__builtin_amdgcn_mfma_f32_32x32x16_bf16(kf[0],qr[0],negm,0,0,0), P0[2],P0[3],P0[4],P0[5],     pw0[0]=PKW(P0,0), pw0[1]=PKW(P0,2), pw0); \
    VRD(4); SBAR(); GAPA(C1=__builtin_amdgcn_mfma_f32_32x32x16_bf16(kf[1],qr[0],negm,0,0,0), P0[6],P0[7],P0[8],P0[9],     pw0[2]=PKW(P0,4), pw0[3]=PKW(P0,6), pw0); \
    VRD(1); SBAR(); GAPA(C0=__builtin_amdgcn_mfma_f32_32x32x16_bf16(kf[2],qr[1],C0,0,0,0),   P0[10],P0[11],P0[12],P0[13], pw1[0]=PKW(P0,8), pw1[1]=PKW(P0,10), pw1); \
    VRD(5); SBAR(); GAPA(C1=__builtin_amdgcn_mfma_f32_32x32x16_bf16(kf[3],qr[1],C1,0,0,0),   P0[14],P0[15],P1[0],P1[1],   pw1[2]=PKW(P0,12),pw1[3]=PKW(P0,14), pw1); \
    VRD(2); SBAR(); GAPA(C0=__builtin_amdgcn_mfma_f32_32x32x16_bf16(kf[4],qr[2],C0,0,0,0),   P1[2],P1[3],P1[4],P1[5],     pw2[0]=PKW(P1,0), pw2[1]=PKW(P1,2), pw2); \
    VRD(6); SBAR(); GAPA(C1=__builtin_amdgcn_mfma_f32_32x32x16_bf16(kf[5],qr[2],C1,0,0,0),   P1[6],P1[7],P1[8],P1[9],     pw2[2]=PKW(P1,4), pw2[3]=PKW(P1,6), pw2); \
    VRD(3); SBAR(); GAPA(C0=__builtin_amdgcn_mfma_f32_32x32x16_bf16(kf[6],qr[3],C0,0,0,0),   P1[10],P1[11],P1[12],P1[13], pw3[0]=PKW(P1,8), pw3[1]=PKW(P1,10), pw3); \
    VRD(7); SBAR(); GAPA(C1=__builtin_amdgcn_mfma_f32_32x32x16_bf16(kf[7],qr[3],C1,0,0,0),   P1[14],P1[15],0.f,0.f,       pw3[2]=PKW(P1,12),pw3[3]=PKW(P1,14), pw3); \
    l_reg+=sacc; \
    if(GK){DMA_K((t)+3,sl_cur);} if(GV){DMA_V((t)+1,sl_next);} \
    CMASK(C0,C1,t); \
    { float a=MX3(C0[0],C0[1],C1[0]),b=MX3(C0[2],C0[3],C1[1]); a=MX3(a,C1[2],C1[3]); \
      _Pragma("unroll") for(int r=4;r<16;r+=4){a=MX3(a,C0[r],C0[r+1]);b=MX3(b,C0[r+2],C0[r+3]);a=MX3(a,C1[r],C1[r+1]);b=MX3(b,C1[r+2],C1[r+3]);} \
      float rm=__builtin_fmaxf(a,b); { auto rr=__builtin_amdgcn_permlane32_swap(__float_as_uint(rm),__float_as_uint(rm),false,false); rm=__builtin_fmaxf(__uint_as_float(rr[0]),__uint_as_float(rr[1])); } \
      resc=false; \
      if(__builtin_expect(__any(rm>(float)THRL),0)){ const float dl=__builtin_fmaxf(rm,0.f); mhat+=dl; \
        _Pragma("unroll") for(int r=0;r<16;++r){C0[r]-=dl;C1[r]-=dl;} \
        _Pragma("unroll") for(int r=0;r<16;++r)negm[r]=-mhat; asm volatile("":"+v"(negm)); \
        const float f=__builtin_amdgcn_exp2f(-dl); l_reg*=f; if(hi==0)wsf[r32]=f; resc=true; } } \
    SBAR(); \
    GAPB(o[0]=__builtin_amdgcn_mfma_f32_32x32x16_bf16(PAF(0),VFR(0),o[0],0,0,0), C0,0); \
    GAPB(o[1]=__builtin_amdgcn_mfma_f32_32x32x16_bf16(PAF(0),VFR(4),o[1],0,0,0), C0,4); \
    KRD(GL,0); GAPB(o[0]=__builtin_amdgcn_mfma_f32_32x32x16_bf16(PAF(1),VFR(1),o[0],0,0,0), C0,8); \
    KRD(GL,1); GAPB(o[1]=__builtin_amdgcn_mfma_f32_32x32x16_bf16(PAF(1),VFR(5),o[1],0,0,0), C0,12); \
    KRD(GL,2); GAPB(o[0]=__builtin_amdgcn_mfma_f32_32x32x16_bf16(PAF(2),VFR(2),o[0],0,0,0), C1,0); \
    KRD(GL,3); GAPB(o[1]=__builtin_amdgcn_mfma_f32_32x32x16_bf16(PAF(2),VFR(6),o[1],0,0,0), C1,4); \
    GAPB(o[0]=__builtin_amdgcn_mfma_f32_32x32x16_bf16(PAF(3),VFR(3),o[0],0,0,0), C1,8); \
    GAPB(o[1]=__builtin_amdgcn_mfma_f32_32x32x16_bf16(PAF(3),VFR(7),o[1],0,0,0), C1,12); \
    }while(0)
  int t=1;
  #undef CMASK
  #define CMASK(P0,P1,t) do{}while(0)
  for(;t+5<NT;t+=2){
    STEP(pB0,pB1,pA0,pA1,t,true,true,true);     WAIT_BAR(2); RESC(); ROT();
    STEP(pA0,pA1,pB0,pB1,t+1,true,true,true);   WAIT_BAR(2); RESC(); ROT();
  }
  #undef CMASK
  #define CMASK(P0,P1,t) do{}while(0)
  #define ENDW(tt) do{ if((tt)+3<NT){WAIT_BAR(2);} else if((tt)+2<NT){WAIT_BAR(1);} else {WAIT_BAR(0);} }while(0)
  for(;t+1<NT;t+=2){
    STEP(pB0,pB1,pA0,pA1,t,(t+3<NT),(t+1<NT),(t+1<NT));       ENDW(t);   RESC(); ROT();
    STEP(pA0,pA1,pB0,pB1,t+1,(t+4<NT),(t+2<NT),(t+2<NT));     ENDW(t+1); RESC(); ROT();
  }
  STEP(pB0,pB1,pA0,pA1,NT-1,false,false,false); RESC();
  { float sacc=pB0[0]+pB0[1]; _Pragma("unroll") for(int r=2;r<16;++r)sacc+=pB0[r]; _Pragma("unroll") for(int r=0;r<16;++r)sacc+=pB1[r]; l_reg+=sacc;
    pw0=(u32x4){PKW(pB0,0),PKW(pB0,2),PKW(pB0,4),PKW(pB0,6)};pw1=(u32x4){PKW(pB0,8),PKW(pB0,10),PKW(pB0,12),PKW(pB0,14)};pw2=(u32x4){PKW(pB1,0),PKW(pB1,2),PKW(pB1,4),PKW(pB1,6)};pw3=(u32x4){PKW(pB1,8),PKW(pB1,10),PKW(pB1,12),PKW(pB1,14)};
    SBAR(); pv(o,vb0+sl_cur,PAF(0),PAF(1),PAF(2),PAF(3)); }
  #undef PKW
  #undef PAF
  #undef VFR
  #undef PIN
  #undef MX3
  #undef GAPA
  #undef GAPB
  #undef EX
  #undef VRD
  #undef KRD
  #undef STEP
  #undef ENDW
  {auto rr=__builtin_amdgcn_permlane32_swap(__float_as_uint(l_reg),__float_as_uint(l_reg),false,false);l_reg=__uint_as_float(rr[0])+__uint_as_float(rr[1]);}
  if(hi==0)wsf[32+r32]=l_reg;asm volatile("s_waitcnt lgkmcnt(0)":::"memory");
  float rli[16];
  #pragma unroll
  for(int r=0;r<16;++r)rli[r]=__builtin_amdgcn_rcpf(wsf[32+crow(r,hi)]);
  bf16*Ow=O+(rowbase+q0+wid*QBLK)*OP+h*D;
  { bf16*stg=(bf16*)(shm+LDS_OST)+wid*2048;
    #pragma unroll
    for(int r=0;r<16;++r){const int orow=crow(r,hi);
      #pragma unroll
      for(int d0=0;d0<2;++d0)stg[orow*64+d0*32+r32]=__float2bfloat16(o[d0][r]*rli[r]);}
    asm volatile("s_waitcnt lgkmcnt(0)":::"memory");
    #pragma unroll
    for(int i=0;i<4;++i){const int row=i*8+(lane>>3),ch=lane&7; const u32x4 v=*(const u32x4*)(stg+row*64+ch*8); ATTN_STORE16(Ow+(long)row*OP+ch*8,v);} }
  asm volatile("s_waitcnt lgkmcnt(0)\n\ts_barrier":::"memory");
  #undef DMA_K
  #undef DMA_V
  #undef CMASK
  #undef START
  #undef RESC
  #undef ROT
}
constexpr int ATTN_LDS_BYTES=LDS_BYTES;
struct AttnTensors { const bf16* Q; const bf16* K; const bf16* V; bf16* O; };
struct AttnUnit { int bh; int qb; };
struct StaticOrder {
  int vcu;
  __device__ __forceinline__ explicit StaticOrder(int vcu_):vcu(vcu_){}
  __device__ __forceinline__ bool next(int i,AttnUnit&u)const{ if(i>=2)return false; const int p=vcu>>6, li=vcu&63, un=li*2+i; u.bh=(p>>1)*NHEAD+(p&1)*4+(un>>5); u.qb=un&31; return true; }
  __device__ __forceinline__ void a_ready(const AttnUnit&)const{}
  __device__ __forceinline__ void done(const AttnUnit&)const{}
};
template<class Sched,int THRL=8> __device__ __forceinline__ void attn_phase(char*lds,const AttnTensors&T,const Sched&S){
  AttnUnit u;
  for(int i=0;S.next(i,u);++i){ S.a_ready(u); attn_unit<THRL>(u.bh/NHEAD,u.bh%NHEAD,u.qb,T.Q,T.K,T.V,T.O,lds); S.done(u); }
}
#undef SBAR
#undef WAIT_BAR
}
#define GAS __attribute__((address_space(1)))
#define LAS __attribute__((address_space(3)))
typedef unsigned short bf16;
typedef unsigned v4u __attribute__((ext_vector_type(4)));
typedef float f32x4 __attribute__((ext_vector_type(4)));
typedef short bf16x8 __attribute__((ext_vector_type(8)));
typedef GAS unsigned gu32;
typedef GAS unsigned long long gu64;
#define RLX_AGENT __ATOMIC_RELAXED, __HIP_MEMORY_SCOPE_AGENT
#define LDS_WAIT() asm volatile("s_waitcnt lgkmcnt(0)" ::: "memory")
#define VM_WAIT() asm volatile("s_waitcnt vmcnt(0)" ::: "memory")
__device__ __forceinline__ unsigned long long rt() { return __builtin_amdgcn_s_memrealtime(); }
__device__ __forceinline__ unsigned f2bf(float f) { unsigned u = __builtin_bit_cast(unsigned, f); return (u + 0x7fffu + ((u >> 16) & 1u)) >> 16; }
__device__ __forceinline__ unsigned pk2(float lo, float hi) { return f2bf(lo) | (f2bf(hi) << 16); }
#define XB_TMO      128
#define XB_XCNT(j)  (256  + 64 * (j))
#define XB_XSUB(j)  (1280 + 64 * (j))
#define XB_XGEN(j)  (2304 + 64 * (j))
#define XB_TOP      3328
#define XB_TOPGEN   3392
#define XCD_BAR_WORDS 3456
#define XB_SPIN_CAP (1u << 18)

__device__ __forceinline__ unsigned xb_ld(unsigned* p)              { return __hip_atomic_load(p, __ATOMIC_RELAXED, __HIP_MEMORY_SCOPE_AGENT); }
__device__ __forceinline__ unsigned xb_add(unsigned* p, unsigned v) { return __hip_atomic_fetch_add(p, v, __ATOMIC_RELAXED, __HIP_MEMORY_SCOPE_AGENT); }
__device__ __forceinline__ unsigned xb_xcc_id() { return (unsigned)__builtin_amdgcn_s_getreg((3 << 11) | 20) & 0xFu; }
#define XB_SPIN(cond, bar) do { unsigned _sp = 0; while (cond) { __builtin_amdgcn_s_sleep(1); \
    if ((++_sp & 255u) == 0u) { if (xb_ld(&(bar)[XB_TMO])) break; if (_sp > XB_SPIN_CAP) { atomicAdd(&(bar)[XB_TMO], 1u); break; } } } } while (0)

struct XcdBarrier {
    unsigned* bar; unsigned x;
    volatile LAS unsigned* st;
};

__device__ __forceinline__ XcdBarrier xcd_barrier_post(unsigned* bar, volatile LAS unsigned* st) {
    XcdBarrier b; b.bar = bar; b.x = xb_xcc_id(); b.st = st;
    if (threadIdx.x == 0) (void)xb_add(&bar[XB_XCNT(b.x)], 1u);
    return b;
}
__device__ __forceinline__ void xcd_barrier_complete(unsigned* bar, unsigned x, unsigned& nloc, unsigned& nx) {
    const unsigned G = gridDim.x * gridDim.y * gridDim.z;
    unsigned sum, cnt, mine, sp = 0u;
    for (;;) {
        sum = 0u; cnt = 0u; mine = 0u;
#pragma unroll
        for (unsigned j = 0; j < 16; ++j) { const unsigned c = xb_ld(&bar[XB_XCNT(j)]); sum += c; cnt += (c > 0u) ? 1u : 0u; mine = (j == x) ? c : mine; }
        if (sum == G) break;
        __builtin_amdgcn_s_sleep(1);
        if ((++sp & 255u) == 0u) { if (xb_ld(&bar[XB_TMO])) break; if (sp > XB_SPIN_CAP) { atomicAdd(&bar[XB_TMO], 1u); break; } }
    }
    nloc = mine > 0u ? mine : 1u; nx = cnt > 0u ? cnt : 1u;
}

__device__ __forceinline__ void xcd_barrier(const XcdBarrier& b) {
    asm volatile("s_waitcnt vmcnt(0)" ::: "memory");
    __syncthreads();
    if (threadIdx.x == 0) {
        unsigned* bar = b.bar;
        __builtin_amdgcn_s_waitcnt(0);
        unsigned nloc = b.st[0], nx = b.st[1];
        if (nloc == 0u) { xcd_barrier_complete(bar, b.x, nloc, nx); b.st[0] = nloc; b.st[1] = nx; }
        const unsigned old = xb_add(&bar[XB_XSUB(b.x)], 1u);
        const unsigned gen = old / nloc;
        if (old + 1u == (gen + 1u) * nloc) {
            __builtin_amdgcn_fence(__ATOMIC_RELEASE, "agent");
            asm volatile("s_waitcnt vmcnt(0)" ::: "memory");
            const unsigned og = xb_add(&bar[XB_TOP], 1u);
            const unsigned tg = og / nx;
            if (og + 1u == (tg + 1u) * nx) xb_add(&bar[XB_TOPGEN], 1u);
            else XB_SPIN(xb_ld(&bar[XB_TOPGEN]) == tg, bar);
            __builtin_amdgcn_fence(__ATOMIC_ACQUIRE, "agent");
            xb_add(&bar[XB_XGEN(b.x)], 1u);
            asm volatile("s_waitcnt vmcnt(0)" ::: "memory");
        } else {
            XB_SPIN(xb_ld(&bar[XB_XGEN(b.x)]) == gen, bar);
            __builtin_amdgcn_fence(__ATOMIC_ACQUIRE, "agent");
            asm volatile("s_waitcnt vmcnt(0)" ::: "memory");
        }
    }
    __syncthreads();
}

namespace pg8 {
struct EpiSwiGLU {
    static constexpr bool PERM = true, AFTER_DRAIN = false;
    bf16_t* O; int ldc;
    __device__ __forceinline__ void operator()(const f32x4 (&acc)[2][2][4][2], const Unit& u, int wr, int wc, int fr, int fq) const {
        const int row0 = u.pm * BM + wr * 64 + fr; const int col0 = u.pn * HALF + wc * 32 + 8 * fq;
#pragma unroll
        for (int ai = 0; ai < 2; ++ai)
#pragma unroll
            for (int m = 0; m < 4; ++m) { bf16_t* rowp = O + (size_t)(row0 + ai * HALF + m * 16) * ldc + col0;
                float r[8];
#pragma unroll
                for (int n = 0; n < 2; ++n)
#pragma unroll
                    for (int i = 0; i < 4; ++i) { const float g = acc[ai][0][m][n][i], up = acc[ai][1][m][n][i];
                        const float e = __builtin_amdgcn_exp2f(-g * 1.4426950408889634f); r[n * 4 + i] = g * __builtin_amdgcn_rcpf(1.0f + e) * up; }
                u32x4 w; w.x = cvt_pk_bf16(r[0], r[1]); w.y = cvt_pk_bf16(r[2], r[3]); w.z = cvt_pk_bf16(r[4], r[5]); w.w = cvt_pk_bf16(r[6], r[7]);
                *(u32x4*)rowp = w; }
    }
};
}

constexpr int NWAVES = 8;
constexpr int BATCH = 2, SEQ = 8192, D = 1024, M = BATCH * SEQ, FFH = 2816;
constexpr float EPS = 1e-6f;
constexpr int NKEY = 387, NKEYP = 392;

constexpr size_t MiB = 1u << 20, HMiB = 1u << 19;
constexpr size_t WS_CTL = 0, CTL_ZERO_BYTES = 1 * MiB;
constexpr size_t WS_SMALL = 1 * MiB;
constexpr size_t SM_MOD = 0;
constexpr size_t SM_BIAST = 131072;
constexpr size_t SM_LB = 147456;
constexpr size_t SM_TW = 262144;
constexpr size_t WS_WINAB = 2 * MiB, WS_WOUTAB = 10 * MiB, WS_WINCD = 12 * MiB, WS_WOUTCD = 14 * MiB + HMiB;
constexpr size_t WS_WF1 = 16 * MiB + HMiB, WF1_BYTES = 11 * MiB, WS_WF2 = 38 * MiB + HMiB, WF2_BYTES = 5 * MiB + HMiB;
constexpr size_t WS_XN = 50 * MiB, WS_YB = 82 * MiB, WS_Z = 114 * MiB, WS_END = 242 * MiB;
constexpr size_t SEG = (size_t)M * 512;
constexpr int CW_BAR = 4096;

constexpr int RING_OFF = 0, RING_BYTES = 131072;
constexpr int TAB_OFF = RING_BYTES;
constexpr int LDSCTL_OFF = RING_BYTES + 1024, MISC_OFF = LDSCTL_OFF + 320;
constexpr int LDS_BYTES = 147456;

__device__ __forceinline__ float bf2f(unsigned short h) { return __builtin_bit_cast(float, (unsigned)h << 16); }
__device__ __forceinline__ float bflo(unsigned w) { return __builtin_bit_cast(float, w << 16); }
__device__ __forceinline__ float bfhi(unsigned w) { return __builtin_bit_cast(float, w & 0xffff0000u); }
__device__ __forceinline__ float wave_sum(float v) {
#pragma unroll
    for (int o = 1; o < 64; o <<= 1) v += __shfl_xor(v, o);
    return v;
}
__device__ __forceinline__ float wave_max(float v) {
#pragma unroll
    for (int o = 1; o < 64; o <<= 1) v = fmaxf(v, __shfl_xor(v, o));
    return v;
}
__device__ __forceinline__ float rdlane(float v, int j) { return __builtin_bit_cast(float, __builtin_amdgcn_readlane(__builtin_bit_cast(int, v), j)); }
__device__ __forceinline__ float siluf(float g) { return g / (1.0f + __expf(-g)); }

struct Frame {
    LAS unsigned char* lds;
    volatile LAS unsigned* MISC;
    gu32* ctl;
    int tid, lane, wave, vcu, G;
    const float *x, *c, *t5, *lbl, *ada_w, *ada_b, *gains, *ab_in, *ab_out, *hnorm, *cd_in, *cd_out, *qkn, *f_in, *f_out;
    float* out;
    unsigned char* ws;
};

__device__ __forceinline__ void p_adaln(Frame& F) {
    LAS float* red = (LAS float*)(F.lds + RING_OFF);
    float* MOD = (float*)(F.ws + WS_SMALL + SM_MOD);
    const int r4 = F.lane >> 4, c4 = F.lane & 15;
    for (int task = blockIdx.x; task < 192; task += F.G) {
        const int l = task / 96, cg = task % 96;
        const float* W = F.ada_w + (size_t)l * 1024 * 6144 + cg * 64 + 4 * c4;
        f32x4 a0 = {0.f, 0.f, 0.f, 0.f}, a1 = {0.f, 0.f, 0.f, 0.f};
#pragma unroll 4
        for (int i = 0; i < 32; ++i) {
            const int row = 128 * F.wave + 4 * i + r4;
            const f32x4 wv = *(const f32x4*)(W + (size_t)row * 6144);
            const float c0 = F.c[row], c1 = F.c[1024 + row];
            a0 += siluf(c0) * wv; a1 += siluf(c1) * wv;
        }
#pragma unroll
        for (int i = 0; i < 4; ++i) { a0[i] += __shfl_xor(a0[i], 16); a0[i] += __shfl_xor(a0[i], 32); a1[i] += __shfl_xor(a1[i], 16); a1[i] += __shfl_xor(a1[i], 32); }
        if (r4 == 0) {
#pragma unroll
            for (int i = 0; i < 4; ++i) { red[(F.wave * 2 + 0) * 64 + 4 * c4 + i] = a0[i]; red[(F.wave * 2 + 1) * 64 + 4 * c4 + i] = a1[i]; }
        }
        __syncthreads();
        if (F.tid < 128) { const int b = F.tid >> 6, col = F.tid & 63; float s = 0.f;
#pragma unroll
            for (int w = 0; w < 8; ++w) s += red[(w * 2 + b) * 64 + col];
            MOD[(l * 2 + b) * 6144 + cg * 64 + col] = s + F.ada_b[l * 6144 + cg * 64 + col]; }
        __syncthreads();
    }
    if ((int)blockIdx.x == F.G - 1) {
        float* BT = (float*)(F.ws + WS_SMALL + SM_BIAST);
        for (int idx = F.tid; idx < NKEY; idx += NWAVES * 64) {
            const int r = idx / 129, j = idx - r * 129 - 64, d = (r == 0) ? 1 : (r == 1) ? 4 : 16, rel = j * d, n = rel < 0 ? -rel : rel;
            int large = 8 + (int)(log((double)(n > 1 ? n : 1) / 8.0) / log(128.0) * 8.0); if (large > 15) large = 15;
            const int bucket = (rel > 0 ? 16 : 0) + (n < 8 ? n : large);
#pragma unroll
            for (int h = 0; h < 8; ++h) BT[h * NKEYP + idx] = F.t5[bucket * 8 + h];
        }
    }
    if ((int)blockIdx.x == F.G - 2) {
        float* LB = (float*)(F.ws + WS_SMALL + SM_LB);
        for (int i = F.tid; i < 1024; i += NWAVES * 64) {
            const float l0 = F.lbl[i], l1 = F.lbl[1024 + i], l2 = F.lbl[2048 + i]; const float mx = fmaxf(l0, fmaxf(l1, l2));
            const float e0 = expf(l0 - mx), e1 = expf(l1 - mx), e2 = expf(l2 - mx); LB[i] = e0 / (e0 + e1 + e2);
        }
    }
    if ((int)blockIdx.x >= F.G - 18 && (int)blockIdx.x < F.G - 2) {
        float* TW = (float*)(F.ws + WS_SMALL + SM_TW);
        const int j = ((int)blockIdx.x - (F.G - 18)) * 512 + F.tid;
        const double a = (double)j * (6.283185307179586476925286766559 / 8192.0);
        TW[j] = (float)cos(a); TW[8192 + j] = (float)sin(a);
    }
}

__device__ __forceinline__ void transpose_item(const float* W, int K, int N, bf16* WT, int dest_row0, int k0, int n0, LAS float* scr, int lane) {
#pragma unroll 8
    for (int i = 0; i < 32; ++i) { const int kk = 2 * i + (lane >> 5); scr[kk * 33 + (lane & 31)] = W[(size_t)(k0 + kk) * N + n0 + (lane & 31)]; }
    LDS_WAIT(); asm volatile("" ::: "memory");
    const int c = lane & 7;
#pragma unroll
    for (int j = 0; j < 4; ++j) { const int n = (lane >> 3) + 8 * j; const LAS float* s = scr + (8 * c) * 33 + n;
        v4u o; o.x = pk2(s[0 * 33], s[1 * 33]); o.y = pk2(s[2 * 33], s[3 * 33]); o.z = pk2(s[4 * 33], s[5 * 33]); o.w = pk2(s[6 * 33], s[7 * 33]);
        *(GAS v4u*)(WT + (size_t)(dest_row0 + n) * K + k0 + 8 * c) = o; }
    LDS_WAIT(); asm volatile("" ::: "memory");
}
__device__ __forceinline__ void p_weights(Frame& F) {
    LAS float* scr = (LAS float*)(F.lds + RING_OFF + F.wave * 16384);
    const int gw = F.vcu * NWAVES + F.wave, NGW = F.G * NWAVES;
    constexpr int I_ABI = 16 * 128, I_ABO = 16 * 32, I_CDI = 16 * 40, I_CDO = 16 * 32, I_F1 = 16 * 176, I_F2 = 44 * 32;
    constexpr int NITEMS = I_ABI + I_ABO + I_CDI + I_CDO + 2 * I_F1 + 2 * I_F2;
    for (int it = gw; it < NITEMS; it += NGW) {
        int r = it;
        if (r < I_ABI) { const int nb = 128, kb = r / nb, n0 = 32 * (r % nb); transpose_item(F.ab_in, 1024, 4096, (bf16*)(F.ws + WS_WINAB), n0, 64 * kb, n0, scr, F.lane); continue; } r -= I_ABI;
        if (r < I_ABO) { const int nb = 32, kb = r / nb, n0 = 32 * (r % nb); transpose_item(F.ab_out, 1024, 1024, (bf16*)(F.ws + WS_WOUTAB), n0, 64 * kb, n0, scr, F.lane); continue; } r -= I_ABO;
        if (r < I_CDI) { const int nb = 40, kb = r / nb, n0 = 32 * (r % nb); transpose_item(F.cd_in, 1024, 1280, (bf16*)(F.ws + WS_WINCD), n0, 64 * kb, n0, scr, F.lane); continue; } r -= I_CDI;
        if (r < I_CDO) { const int nb = 32, kb = r / nb, n0 = 32 * (r % nb); transpose_item(F.cd_out, 1024, 1024, (bf16*)(F.ws + WS_WOUTCD), n0, 64 * kb, n0, scr, F.lane); continue; } r -= I_CDO;
        if (r < 2 * I_F1) { const int l = r / I_F1; r -= l * I_F1; const int nb = 176, kb = r / nb, n0 = 32 * (r % nb);
            const int up = n0 >= FFH ? 1 : 0, j = n0 - up * FFH, drow = 256 * (j >> 7) + 128 * up + (j & 127);
            transpose_item(F.f_in + (size_t)l * 1024 * 5632, 1024, 5632, (bf16*)(F.ws + WS_WF1 + l * WF1_BYTES), drow, 64 * kb, n0, scr, F.lane); continue; } r -= 2 * I_F1;
        { const int l = r / I_F2; r -= l * I_F2; const int nb = 32, kb = r / nb, n0 = 32 * (r % nb);
            transpose_item(F.f_out + (size_t)l * FFH * 1024, FFH, 1024, (bf16*)(F.ws + WS_WF2 + l * WF2_BYTES), n0, 64 * kb, n0, scr, F.lane); }
    }
}
__device__ __forceinline__ void p_rows(Frame& F, const float* xin, const bf16* y, const float* gate_mod  , const float* gain_post,
                                       float* xout, const float* mod_next  , const float* gain_pre, bf16* xn) {
    const int gw = F.vcu * NWAVES + F.wave, NGW = F.G * NWAVES;
    for (int b = 0; b < BATCH; ++b) {
        f32x4 A1[4], A2[4], B2[4];
#pragma unroll
        for (int j = 0; j < 4; ++j) { const int col = 4 * F.lane + 256 * j;
            if (y) { const f32x4 g = *(const f32x4*)(gate_mod + b * 6144 + col), gp = *(const f32x4*)(gain_post + col); A1[j] = g * gp; } else A1[j] = (f32x4){0.f, 0.f, 0.f, 0.f};
            if (mod_next) { const f32x4 sh = *(const f32x4*)(mod_next + b * 6144 + col), sc = *(const f32x4*)(mod_next + b * 6144 + 1024 + col), gp = *(const f32x4*)(gain_pre + col);
                A2[j] = gp * (sc + 1.0f); B2[j] = sh; } else { A2[j] = (f32x4){0.f, 0.f, 0.f, 0.f}; B2[j] = A2[j]; } }
        for (int m = b * SEQ + gw; m < (b + 1) * SEQ; m += NGW) {
            f32x4 v[4];
#pragma unroll
            for (int j = 0; j < 4; ++j) v[j] = *(const f32x4*)(xin + (size_t)m * D + 4 * F.lane + 256 * j);
            if (y) {
                f32x4 yv[4]; float ss = 0.f;
#pragma unroll
                for (int j = 0; j < 4; ++j) { const uint2 w = *(const uint2*)(y + (size_t)m * D + 4 * F.lane + 256 * j);
                    yv[j] = (f32x4){bflo(w.x), bfhi(w.x), bflo(w.y), bfhi(w.y)}; ss += (yv[j].x * yv[j].x + yv[j].y * yv[j].y) + (yv[j].z * yv[j].z + yv[j].w * yv[j].w); }
                const float rs = 1.0f / sqrtf(wave_sum(ss) * (1.0f / D) + EPS);
#pragma unroll
                for (int j = 0; j < 4; ++j) v[j] = v[j] + A1[j] * (yv[j] * rs);
            }
            if (xout) {
#pragma unroll
                for (int j = 0; j < 4; ++j) *(f32x4*)(xout + (size_t)m * D + 4 * F.lane + 256 * j) = v[j];
            }
            if (mod_next) {
                float ss = 0.f;
#pragma unroll
                for (int j = 0; j < 4; ++j) ss += (v[j].x * v[j].x + v[j].y * v[j].y) + (v[j].z * v[j].z + v[j].w * v[j].w);
                const float rs = 1.0f / sqrtf(wave_sum(ss) * (1.0f / D) + EPS);
#pragma unroll
                for (int j = 0; j < 4; ++j) { const f32x4 h = (v[j] * rs) * A2[j] + B2[j];
                    uint2 w; w.x = pk2(h.x, h.y); w.y = pk2(h.z, h.w); *(uint2*)(xn + (size_t)m * D + 4 * F.lane + 256 * j) = w; }
            }
        }
    }
}

__device__ __forceinline__ void p_dilated_naive(Frame& F, const bf16* Q, const bf16* K, const bf16* V, bf16* O  ) {
    const float* BT = (const float*)(F.ws + WS_SMALL + SM_BIAST);
    const int gw = F.vcu * NWAVES + F.wave, NGW = F.G * NWAVES, lane = F.lane;
    for (int item = gw; item < M * 8; item += NGW) {
        const int m = item >> 3, h = item & 7, b = m >> 13, t = m & 8191;
        float qf[64];
        { const uint4* qp = (const uint4*)(Q + (size_t)m * 512 + h * 64);
#pragma unroll
          for (int i = 0; i < 8; ++i) { const uint4 w = qp[i]; qf[8 * i + 0] = bflo(w.x); qf[8 * i + 1] = bfhi(w.x); qf[8 * i + 2] = bflo(w.y); qf[8 * i + 3] = bfhi(w.y);
              qf[8 * i + 4] = bflo(w.z); qf[8 * i + 5] = bfhi(w.z); qf[8 * i + 6] = bflo(w.w); qf[8 * i + 7] = bfhi(w.w); } }
        float lg[7]; int posv[7]; float mx = -3.0e38f;
#pragma unroll
        for (int g = 0; g < 7; ++g) {
            const int idx = g * 64 + lane; float l = -3.0e38f; int pos = t;
            if (idx < NKEY) { const int r = idx / 129, j = idx - r * 129 - 64, d = (r == 0) ? 1 : (r == 1) ? 4 : 16; pos = t + j * d;
                if (pos >= 0 && pos < SEQ) { const uint4* kp = (const uint4*)(K + (size_t)(b * SEQ + pos) * 512 + h * 64); float dot = 0.f;
#pragma unroll
                    for (int i = 0; i < 8; ++i) { const uint4 w = kp[i]; dot += qf[8 * i + 0] * bflo(w.x) + qf[8 * i + 1] * bfhi(w.x) + qf[8 * i + 2] * bflo(w.y) + qf[8 * i + 3] * bfhi(w.y)
                                                                            + qf[8 * i + 4] * bflo(w.z) + qf[8 * i + 5] * bfhi(w.z) + qf[8 * i + 6] * bflo(w.w) + qf[8 * i + 7] * bfhi(w.w); }
                    l = dot * 0.125f + BT[h * NKEYP + idx]; } else pos = t; }
            lg[g] = l; posv[g] = pos; mx = fmaxf(mx, l);
        }
        mx = wave_max(mx);
        float s = 0.f;
#pragma unroll
        for (int g = 0; g < 7; ++g) { lg[g] = (lg[g] > -1.0e38f) ? __expf(lg[g] - mx) : 0.f; s += lg[g]; }
        s = wave_sum(s);
        float acc = 0.f; const bf16* Vb = V + (size_t)b * SEQ * 512 + h * 64 + lane;
#pragma unroll
        for (int g = 0; g < 7; ++g) { const int n = (g < 6) ? 64 : (NKEY - 384);
            for (int j = 0; j < n; ++j) { const float pj = rdlane(lg[g], j); const int pos = __builtin_amdgcn_readlane(posv[g], j);
                if (pj != 0.f) acc += pj * bf2f(Vb[(size_t)pos * 512]); } }
        O[(size_t)m * 1024 + h * 64 + lane] = (bf16)f2bf(acc / s);
    }
}

__device__ __forceinline__ void p_hgrn_naive(Frame& F, const bf16* Qh, const bf16* Ff, const bf16* Fb, const bf16* Ih, float* Odir) {
    const float* LB = (const float*)(F.ws + WS_SMALL + SM_LB);
    constexpr int TT = 32;
    LAS float* qs = (LAS float*)(F.lds + RING_OFF);
    LAS float* fa = qs + TT * 128;
    LAS float* vv = fa + TT * 128;
    const int tid = F.tid, lane = F.lane, vi = lane & 1, kq = lane >> 1;
    for (int item = blockIdx.x; item < 128; item += F.G) {
        const int chain = item >> 3, vs = item & 7, dir = chain >> 3, b = (chain >> 2) & 1, h = chain & 3;
        const bf16* Fp = dir ? Fb : Ff;
        float S[4] = {0.f, 0.f, 0.f, 0.f};
        const int vcol = h * 128 + vs * 16 + F.wave * 2 + vi;
        for (int s0 = 0; s0 < SEQ; s0 += TT) {
            __syncthreads();
            { const int tt = tid >> 4, k0 = (tid & 15) * 8; const int t = dir ? (SEQ - 1 - (s0 + tt)) : (s0 + tt); const size_t row = (size_t)(b * SEQ + t) * 512 + h * 128 + k0;
              const uint4 qw = *(const uint4*)(Qh + row), fw = *(const uint4*)(Fp + row);
              const unsigned qa[4] = {qw.x, qw.y, qw.z, qw.w}, fb_[4] = {fw.x, fw.y, fw.z, fw.w};
#pragma unroll
              for (int i = 0; i < 4; ++i) {
                  const float lb0 = LB[dir * 512 + h * 128 + k0 + 2 * i], lb1 = LB[dir * 512 + h * 128 + k0 + 2 * i + 1];
                  qs[tt * 128 + k0 + 2 * i] = bflo(qa[i]) * 0.08838834764831845f; qs[tt * 128 + k0 + 2 * i + 1] = bfhi(qa[i]) * 0.08838834764831845f;
                  fa[tt * 128 + k0 + 2 * i] = lb0 + (1.0f - lb0) / (1.0f + __expf(-bflo(fb_[i]))); fa[tt * 128 + k0 + 2 * i + 1] = lb1 + (1.0f - lb1) / (1.0f + __expf(-bfhi(fb_[i]))); }
              if (tid < TT * 16) { const int tv = tid >> 4, vc = tid & 15; const int t2 = dir ? (SEQ - 1 - (s0 + tv)) : (s0 + tv);
                  vv[tv * 16 + vc] = bf2f(Ih[(size_t)(b * SEQ + t2) * 512 + h * 128 + vs * 16 + vc]); } }
            __syncthreads();
#pragma unroll 4
            for (int tt = 0; tt < TT; ++tt) {
                const f32x4 f4 = *(const LAS f32x4*)(fa + tt * 128 + 4 * kq), q4 = *(const LAS f32x4*)(qs + tt * 128 + 4 * kq); const float v = vv[tt * 16 + F.wave * 2 + vi];
                float o = 0.f;
#pragma unroll
                for (int i = 0; i < 4; ++i) { S[i] = f4[i] * S[i] + (1.0f - f4[i]) * v; o += q4[i] * S[i]; }
                o += __shfl_xor(o, 2); o += __shfl_xor(o, 4); o += __shfl_xor(o, 8); o += __shfl_xor(o, 16); o += __shfl_xor(o, 32);
                if (kq == 0) { const int t = dir ? (SEQ - 1 - (s0 + tt)) : (s0 + tt); Odir[((size_t)dir * M + (size_t)(b * SEQ + t)) * 512 + vcol] = o; }
            }
        }
    }
}
__device__ __forceinline__ void p_hgrn_final(Frame& F, const float* Odir, const bf16* Gh, bf16* O) {
    const int gw = F.vcu * NWAVES + F.wave, NGW = F.G * NWAVES, lane = F.lane;
    const float g0 = F.hnorm[2 * lane], g1 = F.hnorm[2 * lane + 1];
    for (int item = gw; item < M * 4; item += NGW) {
        const int m = item >> 2, h = item & 3; const size_t off = (size_t)m * 512 + h * 128 + 2 * lane;
        const float2 a = *(const float2*)(Odir + off), c = *(const float2*)(Odir + (size_t)M * 512 + off);
        const float o0 = a.x + c.x, o1 = a.y + c.y; const float rs = 1.0f / sqrtf(wave_sum(o0 * o0 + o1 * o1) * (1.0f / 128.0f) + EPS);
        const unsigned gw2 = *(const unsigned*)(Gh + off); const float r0 = o0 * rs * g0 * siluf(bflo(gw2)), r1 = o1 * rs * g1 * siluf(bfhi(gw2));
        *(unsigned*)(O + (size_t)m * 1024 + 512 + h * 128 + 2 * lane) = pk2(r0, r1);
    }
}

__device__ __forceinline__ void tab128_init(Frame& F) {
    LAS float* T = (LAS float*)(F.lds + TAB_OFF);
    if (F.tid < 128) { float s, c; sincospif((float)F.tid * (1.0f / 64.0f), &s, &c); T[F.tid] = c; T[128 + F.tid] = s; }
    __syncthreads();
}
__device__ __forceinline__ void p_fnet1_naive(Frame& F, const bf16* U  , float* APR, float* API) {
    const float* TW = (const float*)(F.ws + WS_SMALL + SM_TW);
    LAS float* T = (LAS float*)(F.lds + TAB_OFF);
    LAS float* Us = (LAS float*)(F.lds + RING_OFF);
    LAS float* Zr = Us + 64 * 129 + 64;
    LAS float* Zi = Zr + 64 * 128;
    tab128_init(F);
    const int tid = F.tid, kc = tid & 127, grp = tid >> 7;
    for (int unit = blockIdx.x; unit < 2 * 4 * 128; unit += F.G) {
        const int b = unit >> 9, g = (unit >> 7) & 3, n2 = unit & 127;
        __syncthreads();
        { const int row = tid >> 3, c0 = (tid & 7) * 16; const uint4* p = (const uint4*)(U + (size_t)(b * SEQ + 128 * row + n2) * 512 + g * 128 + c0);
#pragma unroll
          for (int i = 0; i < 2; ++i) { const uint4 w = p[i]; LAS float* d = Us + row * 129 + c0 + 8 * i;
              d[0] = bflo(w.x); d[1] = bfhi(w.x); d[2] = bflo(w.y); d[3] = bfhi(w.y); d[4] = bflo(w.z); d[5] = bfhi(w.z); d[6] = bflo(w.w); d[7] = bfhi(w.w); } }
        __syncthreads();
        { float zr[16], zi[16];
#pragma unroll
          for (int i = 0; i < 16; ++i) { zr[i] = 0.f; zi[i] = 0.f; }
          for (int c = 0; c < 128; ++c) { const int idx = (c * kc) & 127; const float cs = T[idx], sn = T[128 + idx];
#pragma unroll
              for (int i = 0; i < 16; ++i) { const float u = Us[(grp * 16 + i) * 129 + c]; zr[i] += u * cs; zi[i] -= u * sn; } }
#pragma unroll
          for (int i = 0; i < 16; ++i) { Zr[(grp * 16 + i) * 128 + kc] = zr[i]; Zi[(grp * 16 + i) * 128 + kc] = zi[i]; } }
        __syncthreads();
        { float ar[16], ai[16];
#pragma unroll
          for (int i = 0; i < 16; ++i) { ar[i] = 0.f; ai[i] = 0.f; }
          for (int n1 = 0; n1 < 64; ++n1) { const float zr = Zr[n1 * 128 + kc], zi = Zi[n1 * 128 + kc];
#pragma unroll
              for (int i = 0; i < 16; ++i) { const int idx = (2 * n1 * (grp * 16 + i)) & 127; const float cs = T[idx], sn = T[128 + idx]; ar[i] += zr * cs + zi * sn; ai[i] += zi * cs - zr * sn; } }
#pragma unroll
          for (int i = 0; i < 16; ++i) { const int k1 = grp * 16 + i; const float ct = TW[n2 * k1], st = TW[8192 + n2 * k1];
              const size_t o = ((size_t)((b * 4 + g) * 128 + n2) * 64 + k1) * 128 + kc;
              APR[o] = ar[i] * ct + ai[i] * st; API[o] = ai[i] * ct - ar[i] * st; } }
    }
}
__device__ __forceinline__ void p_fnet2_naive(Frame& F, const float* APR, const float* API, bf16* O) {
    LAS float* T = (LAS float*)(F.lds + TAB_OFF);
    LAS float* Ar = (LAS float*)(F.lds + RING_OFF);
    LAS float* Ai = Ar + 128 * 128;
    tab128_init(F);
    const int tid = F.tid, kc = tid & 127, grp = tid >> 7;
    for (int unit = blockIdx.x; unit < 2 * 4 * 64; unit += F.G) {
        const int b = unit >> 8, g = (unit >> 6) & 3, k1 = unit & 63;
        __syncthreads();
        for (int e = tid; e < 128 * 128 / 4; e += NWAVES * 64) { const int n2 = e >> 5, c4 = (e & 31) * 4; const size_t o = ((size_t)((b * 4 + g) * 128 + n2) * 64 + k1) * 128 + c4;
            *(LAS f32x4*)(Ar + n2 * 128 + c4) = *(const f32x4*)(APR + o); *(LAS f32x4*)(Ai + n2 * 128 + c4) = *(const f32x4*)(API + o); }
        __syncthreads();
        float y[32];
#pragma unroll
        for (int i = 0; i < 32; ++i) y[i] = 0.f;
        for (int n2 = 0; n2 < 128; ++n2) { const float ar = Ar[n2 * 128 + kc], ai = Ai[n2 * 128 + kc];
#pragma unroll
            for (int i = 0; i < 32; ++i) { const int idx = (n2 * (grp * 32 + i)) & 127; y[i] += ar * T[idx] + ai * T[128 + idx]; } }
#pragma unroll
        for (int i = 0; i < 32; ++i) { const int k2 = grp * 32 + i; O[(size_t)(b * SEQ + k1 + 64 * k2) * 1024 + g * 128 + kc] = (bf16)f2bf(y[i] * (1.0f / 1024.0f)); }
    }
}

__device__ __forceinline__ void p_qkprep(Frame& F, bf16* QD, bf16* KV, float qscale) {
    const int gw = F.vcu * NWAVES + F.wave, NGW = F.G * NWAVES, lane = F.lane;
    const float invf = powf(10000.0f, -(float)(lane & 15) * (1.0f / 16.0f));
    const float gq = F.qkn[lane], gk = F.qkn[64 + lane];
    for (int m = gw; m < M; m += NGW) {
        const int t = m & 8191; const float pos = (lane < 32) ? (float)(t >> 6) : (float)(t & 63); const float ang = pos * invf; const float cs = cosf(ang), sn = sinf(ang);
#pragma unroll
        for (int hh = 0; hh < 10; ++hh) {
            bf16* p = (hh < 8) ? (QD + (size_t)m * 512 + hh * 64 + lane) : (KV + (size_t)m * 512 + (hh - 8) * 64 + lane);
            const float x = bf2f(*p); const float rs = 1.0f / sqrtf(wave_sum(x * x) * (1.0f / 64.0f) + EPS); const float xn = x * rs * ((hh < 8) ? gq : gk);
            const float xp = __shfl_xor(xn, 16);
            const float r = (lane & 16) ? (xp * sn + xn * cs) : (xn * cs - xp * sn);
            *p = (bf16)f2bf(r * ((hh < 8) ? qscale : 1.0f));
        }
    }
}
__device__ __forceinline__ void p_gqa_naive(Frame& F, const bf16* QD, const bf16* KV, bf16* O) {
    const int gw = F.vcu * NWAVES + F.wave, NGW = F.G * NWAVES, lane = F.lane;
    for (int item = gw; item < M * 8; item += NGW) {
        const int m = item >> 3, hq = item & 7, b = m >> 13, hk = hq >> 2;
        float qf[64];
        { const uint4* qp = (const uint4*)(QD + (size_t)m * 512 + hq * 64);
#pragma unroll
          for (int i = 0; i < 8; ++i) { const uint4 w = qp[i]; qf[8 * i + 0] = bflo(w.x); qf[8 * i + 1] = bfhi(w.x); qf[8 * i + 2] = bflo(w.y); qf[8 * i + 3] = bfhi(w.y);
              qf[8 * i + 4] = bflo(w.z); qf[8 * i + 5] = bfhi(w.z); qf[8 * i + 6] = bflo(w.w); qf[8 * i + 7] = bfhi(w.w); } }
        float mrun = -3.0e38f, srun = 0.f, acc = 0.f;
        const bf16* Kb = KV + (size_t)b * SEQ * 512 + hk * 64; const bf16* Vb = KV + (size_t)b * SEQ * 512 + 128 + hk * 64 + lane;
        for (int kg = 0; kg < SEQ / 64; ++kg) {
            const uint4* kp = (const uint4*)(Kb + (size_t)(kg * 64 + lane) * 512); float dot = 0.f;
#pragma unroll
            for (int i = 0; i < 8; ++i) { const uint4 w = kp[i]; dot += qf[8 * i + 0] * bflo(w.x) + qf[8 * i + 1] * bfhi(w.x) + qf[8 * i + 2] * bflo(w.y) + qf[8 * i + 3] * bfhi(w.y)
                                                                    + qf[8 * i + 4] * bflo(w.z) + qf[8 * i + 5] * bfhi(w.z) + qf[8 * i + 6] * bflo(w.w) + qf[8 * i + 7] * bfhi(w.w); }
            const float mnew = fmaxf(mrun, wave_max(dot)); const float corr = __expf(mrun - mnew); const float p = __expf(dot - mnew);
            srun = srun * corr + wave_sum(p); acc *= corr; mrun = mnew;
#pragma unroll 8
            for (int j = 0; j < 64; ++j) acc += rdlane(p, j) * bf2f(Vb[(size_t)(kg * 64 + j) * 512]);
        }
        O[(size_t)m * 1024 + 512 + hq * 64 + lane] = (bf16)f2bf(acc / srun);
    }
}

namespace dil {
typedef short bf16x8 __attribute__((ext_vector_type(8)));
typedef short s16x4 __attribute__((ext_vector_type(4)));
typedef float f32x16 __attribute__((ext_vector_type(16)));
typedef unsigned u32x4v __attribute__((ext_vector_type(4)));
typedef unsigned u32x2v __attribute__((ext_vector_type(2)));
typedef short v4i16_t __attribute__((ext_vector_type(4)));
#define DIL_LAS __attribute__((address_space(3)))
constexpr float LOG2E = 1.4426950408889634f, C2 = 0.125f * LOG2E, THR = 8.0f;
constexpr int BT_OFF = 0, BT_H = 396, BT_BR = 132;
constexpr int WAVE_OFF = 12800, WAVE_BYTES = 8192;
constexpr int LDS_NEED = WAVE_OFF + 8 * WAVE_BYTES;
__device__ __forceinline__ unsigned cvtpk(float lo, float hi) { typedef float f2 __attribute__((ext_vector_type(2))); typedef __bf16 b2 __attribute__((ext_vector_type(2))); f2 v = {lo, hi}; b2 r = __builtin_convertvector(v, b2); return __builtin_bit_cast(unsigned, r); }
__device__ __forceinline__ s16x4 vtr(const DIL_LAS char* p) { return __builtin_bit_cast(s16x4, __builtin_amdgcn_ds_read_tr16_b64_v4i16((DIL_LAS v4i16_t*)p)); }
__device__ __forceinline__ float halfmax(float v) { auto rr = __builtin_amdgcn_permlane32_swap(__float_as_uint(v), __float_as_uint(v), false, false); return fmaxf(__uint_as_float(rr[0]), __uint_as_float(rr[1])); }
__device__ __forceinline__ float halfsum(float v) { auto rr = __builtin_amdgcn_permlane32_swap(__float_as_uint(v), __float_as_uint(v), false, false); return __uint_as_float(rr[0]) + __uint_as_float(rr[1]); }

__device__ __forceinline__ void tile_desc(int t, int it, int rho, int i0, int& base_tok, int& stride, int& dbase, bool& kindA, bool& tvalid) {
    if (t < 17) { const int a = (t == 0) ? 8 : ((t - 1 < 8) ? t - 1 : t); kindA = true; tvalid = (unsigned)(it - 8 + a) < 64u; base_tok = 4 * (i0 - 256 + 32 * a) + rho; stride = 4; dbase = 32 * (a - 8); }
    else { const int e = t - 17; kindA = false; tvalid = (unsigned)(4 * it - 2 + e) < 256u; base_tok = 128 * it - 64 + 32 * e; stride = 1; dbase = 32 * (e - 2) - rho; }
    if (!tvalid) base_tok = 0;
}

__device__ __forceinline__ void job(const unsigned short* __restrict__ Qg, const unsigned short* __restrict__ Kg, const unsigned short* __restrict__ Vg, unsigned short* Og,
                                    int b, int h, int rho, int it, DIL_LAS char* lbase, int wave, int lane) {
    const int c = lane & 31, hi = lane >> 5, i0 = 32 * it;
    const size_t rowb = (size_t)b * 8192;
    const int posq = 4 * (i0 + c) + rho;
    bf16x8 qf[4];
#pragma unroll
    for (int ks = 0; ks < 4; ++ks) qf[ks] = *(const bf16x8*)(Qg + (rowb + posq) * 512 + h * 64 + 16 * ks + 8 * hi);
    const DIL_LAS float* bt = (const DIL_LAS float*)(lbase + BT_OFF) + h * BT_H;
    DIL_LAS char* vbuf = lbase + WAVE_OFF + wave * WAVE_BYTES;
    const int krow = lane & 31, vrow = lane >> 1, vdh = lane & 1;
    const int vtro = ((lane >> 4) & 1) * 32 + (lane & 3) * 8 + (4 * hi + ((lane & 15) >> 2)) * 64;
    f32x16 o0, o1;
#pragma unroll
    for (int r = 0; r < 16; ++r) { o0[r] = 0.f; o1[r] = 0.f; }
    float lsum = 0.f, mhat = 0.f;
    int base_tok, stride, dbase; bool kindA, tvalid;
    tile_desc(0, it, rho, i0, base_tok, stride, dbase, kindA, tvalid);
    bf16x8 kc[4]; u32x4v vr[4];
    { const unsigned short* kp = Kg + (rowb + base_tok + stride * krow) * 512 + h * 64 + 8 * hi;
#pragma unroll
      for (int ks = 0; ks < 4; ++ks) kc[ks] = *(const bf16x8*)(kp + 16 * ks);
      const unsigned short* vp = Vg + (rowb + base_tok + stride * vrow) * 512 + h * 64 + 32 * vdh;
#pragma unroll
      for (int i = 0; i < 4; ++i) vr[i] = *(const u32x4v*)(vp + 8 * i); }
    for (int t = 0; t < 25; ++t) {
        DIL_LAS char* vb = vbuf + (t & 1) * 4096;
#pragma unroll
        for (int i = 0; i < 4; ++i) *(DIL_LAS u32x4v*)(vb + vdh * 2048 + vrow * 64 + 16 * i) = vr[i];
        const int dbase_c = dbase; const bool kindA_c = kindA, tvalid_c = tvalid;
        bf16x8 kn[4];
        if (t + 1 < 25) {
            tile_desc(t + 1, it, rho, i0, base_tok, stride, dbase, kindA, tvalid);
            const unsigned short* kp = Kg + (rowb + base_tok + stride * krow) * 512 + h * 64 + 8 * hi;
#pragma unroll
            for (int ks = 0; ks < 4; ++ks) kn[ks] = *(const bf16x8*)(kp + 16 * ks);
            const unsigned short* vp = Vg + (rowb + base_tok + stride * vrow) * 512 + h * 64 + 32 * vdh;
#pragma unroll
            for (int i = 0; i < 4; ++i) vr[i] = *(const u32x4v*)(vp + 8 * i);
        } else {
#pragma unroll
            for (int ks = 0; ks < 4; ++ks) kn[ks] = kc[ks];
        }
        f32x16 acc;
#pragma unroll
        for (int r = 0; r < 16; ++r) acc[r] = 0.f;
#pragma unroll
        for (int ks = 0; ks < 4; ++ks) acc = __builtin_amdgcn_mfma_f32_32x32x16_bf16(kc[ks], qf[ks], acc, 0, 0, 0);
        const int cm = kindA_c ? c : 4 * c;
        const int d0 = dbase_c + 4 * hi - cm;
        const int tb1 = kindA_c ? BT_BR : 0;
        const float NEG = -INFINITY;
        f32x16 t1, t2;
        float rm = NEG;
#pragma unroll
        for (int r = 0; r < 16; ++r) {
            const int dl = d0 + (r & 3) + 8 * (r >> 2);
            const bool v1 = tvalid_c && dl >= -64 && dl <= 64;
            int i1 = dl + 64; i1 = i1 < 0 ? 0 : (i1 > 128 ? 128 : i1);
            const float s = acc[r] * C2;
            t1[r] = v1 ? s + bt[tb1 + i1] : NEG;
            rm = fmaxf(rm, t1[r]);
        }
        if (kindA_c) {
#pragma unroll
            for (int r = 0; r < 16; ++r) {
                const int dl = d0 + (r & 3) + 8 * (r >> 2);
                const bool v2 = tvalid_c && ((dl & 3) == 0) && dl >= -256 && dl <= 256;
                int i2 = (dl >> 2) + 64; i2 = i2 < 0 ? 0 : (i2 > 128 ? 128 : i2);
                t2[r] = v2 ? acc[r] * C2 + bt[2 * BT_BR + i2] : NEG;
                rm = fmaxf(rm, t2[r]);
            }
        } else {
#pragma unroll
            for (int r = 0; r < 16; ++r) t2[r] = NEG;
        }
        rm = halfmax(rm);
        if (t == 0) { mhat = rm; }
        else {
            const float d = rm - mhat;
            if (__any(d > THR)) { const float dl = fmaxf(d, 0.f); mhat += dl; const float f = __builtin_amdgcn_exp2f(-dl); lsum *= f;
#pragma unroll
                for (int r = 0; r < 16; ++r) { o0[r] *= f; o1[r] *= f; } }
        }
        float p[16]; float ps = 0.f;
#pragma unroll
        for (int r = 0; r < 16; ++r) { p[r] = __builtin_amdgcn_exp2f(t1[r] - mhat) + __builtin_amdgcn_exp2f(t2[r] - mhat); ps += p[r]; }
        lsum += ps;
        u32x4v pw0, pw1;
        pw0[0] = cvtpk(p[0], p[1]); pw0[1] = cvtpk(p[2], p[3]); pw0[2] = cvtpk(p[4], p[5]); pw0[3] = cvtpk(p[6], p[7]);
        pw1[0] = cvtpk(p[8], p[9]); pw1[1] = cvtpk(p[10], p[11]); pw1[2] = cvtpk(p[12], p[13]); pw1[3] = cvtpk(p[14], p[15]);
        const bf16x8 pf0 = __builtin_bit_cast(bf16x8, pw0), pf1 = __builtin_bit_cast(bf16x8, pw1);
        const DIL_LAS char* vt = vb + vtro;
#pragma unroll
        for (int dt = 0; dt < 2; ++dt) {
            const s16x4 a0 = vtr(vt + dt * 2048), a1 = vtr(vt + dt * 2048 + 512), b0 = vtr(vt + dt * 2048 + 1024), b1 = vtr(vt + dt * 2048 + 1536);
            const bf16x8 vf0 = {a0[0], a0[1], a0[2], a0[3], a1[0], a1[1], a1[2], a1[3]}, vf1 = {b0[0], b0[1], b0[2], b0[3], b1[0], b1[1], b1[2], b1[3]};
            if (dt == 0) { o0 = __builtin_amdgcn_mfma_f32_32x32x16_bf16(vf0, pf0, o0, 0, 0, 0); o0 = __builtin_amdgcn_mfma_f32_32x32x16_bf16(vf1, pf1, o0, 0, 0, 0); }
            else         { o1 = __builtin_amdgcn_mfma_f32_32x32x16_bf16(vf0, pf0, o1, 0, 0, 0); o1 = __builtin_amdgcn_mfma_f32_32x32x16_bf16(vf1, pf1, o1, 0, 0, 0); }
        }
#pragma unroll
        for (int ks = 0; ks < 4; ++ks) kc[ks] = kn[ks];
    }
    const float inv = 1.0f / halfsum(lsum);
    unsigned short* op = Og + (rowb + posq) * 1024 + h * 64 + 4 * hi;
#pragma unroll
    for (int g = 0; g < 4; ++g) {
        u32x2v w0, w1;
        w0[0] = cvtpk(o0[4 * g] * inv, o0[4 * g + 1] * inv); w0[1] = cvtpk(o0[4 * g + 2] * inv, o0[4 * g + 3] * inv);
        w1[0] = cvtpk(o1[4 * g] * inv, o1[4 * g + 1] * inv); w1[1] = cvtpk(o1[4 * g + 2] * inv, o1[4 * g + 3] * inv);
        *(u32x2v*)(op + 8 * g) = w0; *(u32x2v*)(op + 32 + 8 * g) = w1;
    }
}
}

__device__ __forceinline__ void p_dilated(Frame& F, const bf16* Q, const bf16* K, const bf16* V, bf16* O  ) {
    const float* BT = (const float*)(F.ws + WS_SMALL + SM_BIAST);
    LAS float* bt = (LAS float*)(F.lds + RING_OFF + dil::BT_OFF);
    __syncthreads();
    for (int idx = F.tid; idx < 8 * NKEY; idx += NWAVES * 64) { const int h = idx / NKEY, rem = idx - h * NKEY, br = rem / 129, j = rem - br * 129;
        bt[h * dil::BT_H + br * dil::BT_BR + j] = BT[h * NKEYP + rem] * dil::LOG2E; }
    __syncthreads();
    const int gw = F.vcu * NWAVES + F.wave, NGW = F.G * NWAVES;
    for (int j = gw; j < 4096; j += NGW) { const int s = j >> 11, g = j & 2047, bh = 2 * (g >> 8) + s, w256 = g & 255;
        dil::job(Q, K, V, O, bh >> 3, bh & 7, w256 & 3, w256 >> 2, (LAS char*)(F.lds + RING_OFF), F.wave, F.lane); }
    __syncthreads();
}

namespace hg {
typedef short bf16x8 __attribute__((ext_vector_type(8)));
typedef short s16x4 __attribute__((ext_vector_type(4)));
typedef float f32x16 __attribute__((ext_vector_type(16)));
typedef float f32x4v __attribute__((ext_vector_type(4)));
typedef float f32x2v __attribute__((ext_vector_type(2)));
typedef unsigned u32x4v __attribute__((ext_vector_type(4)));
typedef short v4i16_t __attribute__((ext_vector_type(4)));
#define HG_LAS __attribute__((address_space(3)))
constexpr int QT_S = 272, AT_S = 144, SP_S = 272;
constexpr int L_QT = 0, L_KT = 17408, L_KB = 34816, L_VB = 51200, L_AT = 67584, L_SP = 76800, L_TOT = 111616, L_ER = 115712, L_E2 = 116224, L_END = 116736;
constexpr int NSC = 16, SCLEN = 512;
__device__ __forceinline__ int crow(int r, int hi) { return (r & 3) + 8 * (r >> 2) + 4 * hi; }
__device__ __forceinline__ s16x4 vtr(const HG_LAS char* p) { return __builtin_bit_cast(s16x4, __builtin_amdgcn_ds_read_tr16_b64_v4i16((HG_LAS v4i16_t*)p)); }
__device__ __forceinline__ unsigned short bf1(float f) { unsigned u = __builtin_bit_cast(unsigned, f); return (unsigned short)((u + 0x7fffu + ((u >> 16) & 1u)) >> 16); }
__device__ __forceinline__ unsigned pk(float lo, float hi) { return (unsigned)bf1(lo) | ((unsigned)bf1(hi) << 16); }
#define HG_BAR() do { asm volatile("s_waitcnt vmcnt(0) lgkmcnt(0)" ::: "memory"); __builtin_amdgcn_s_barrier(); asm volatile("" ::: "memory"); } while (0)

template <bool OUT>
__device__ __forceinline__ void unit(HG_LAS char* L, const unsigned short* __restrict__ Qh, const unsigned short* __restrict__ Fp, const unsigned short* __restrict__ Ih, const float* __restrict__ LB,
                                     float* Ubuf, float* LDbuf, float* Od, int dir, int b, int h, int sc, int chain, int tid, int wave, int lane) {
    const int c = lane & 31, hi = lane >> 5, vb = wave >> 1, kb0 = 2 * (wave & 1);
    f32x16 st0, st1;
    float* Up = Ubuf + (size_t)(chain * NSC + sc) * 16384;
    if (OUT) {
#pragma unroll
        for (int r = 0; r < 16; ++r) { st0[r] = Up[(32 * vb + crow(r, hi)) * 128 + 32 * kb0 + c]; st1[r] = Up[(32 * vb + crow(r, hi)) * 128 + 32 * kb0 + 32 + c]; }
    } else {
#pragma unroll
        for (int r = 0; r < 16; ++r) { st0[r] = 0.f; st1[r] = 0.f; }
    }
    const float lb0 = LB[dir * 512 + h * 128 + 2 * lane], lb1 = LB[dir * 512 + h * 128 + 2 * lane + 1];
    float ldt0 = 0.f, ldt1 = 0.f;
    HG_LAS float* TOT = (HG_LAS float*)(L + L_TOT); HG_LAS float* ER = (HG_LAS float*)(L + L_ER); HG_LAS float* E2 = (HG_LAS float*)(L + L_E2);
    const size_t rowb = (size_t)b * 8192;
    for (int j = 0; j < 8; ++j) {
        const int tg0 = SCLEN * sc + 64 * j;
        float qv[16], fav[16], cum[16]; float c0 = 0.f, c1 = 0.f;
#pragma unroll
        for (int i = 0; i < 8; ++i) {
            const int tg = tg0 + 8 * wave + i, t = dir ? (8191 - tg) : tg; const size_t row = (rowb + t) * 512 + h * 128 + 2 * lane;
            const unsigned qw = *(const unsigned*)(Qh + row), fw = *(const unsigned*)(Fp + row);
            const float f0 = __builtin_bit_cast(float, fw << 16), f1 = __builtin_bit_cast(float, fw & 0xffff0000u);
            const float a0 = lb0 + (1.0f - lb0) / (1.0f + __expf(-f0)), a1 = lb1 + (1.0f - lb1) / (1.0f + __expf(-f1));
            c0 += __logf(a0); c1 += __logf(a1);
            qv[2 * i] = __builtin_bit_cast(float, qw << 16) * 0.08838834764831845f; qv[2 * i + 1] = __builtin_bit_cast(float, qw & 0xffff0000u) * 0.08838834764831845f;
            fav[2 * i] = a0; fav[2 * i + 1] = a1; cum[2 * i] = c0; cum[2 * i + 1] = c1;
        }
        *(HG_LAS f32x2v*)(TOT + wave * 128 + 2 * lane) = (f32x2v){c0, c1};
        const int vs = tid >> 3, seg = tid & 7;
        u32x4v vv0, vv1;
        { const int tg = tg0 + vs, t = dir ? (8191 - tg) : tg; const u32x4v* vp = (const u32x4v*)(Ih + (rowb + t) * 512 + h * 128 + seg * 16); vv0 = vp[0]; vv1 = vp[1]; }
        HG_BAR();
        float off0 = 0.f, off1 = 0.f, r0 = 0.f, r1 = 0.f, bl0 = 0.f, bl1 = 0.f;
#pragma unroll
        for (int w2 = 0; w2 < 8; ++w2) { const f32x2v tt = *(const HG_LAS f32x2v*)(TOT + w2 * 128 + 2 * lane);
            if (w2 < wave) { off0 += tt.x; off1 += tt.y; } if (w2 < 4) { r0 += tt.x; r1 += tt.y; } bl0 += tt.x; bl1 += tt.y; }
#pragma unroll
        for (int i = 0; i < 8; ++i) {
            const int tau = 8 * wave + i;
            const float b0 = off0 + cum[2 * i], b1 = off1 + cum[2 * i + 1];
            const float kt0 = (1.0f - fav[2 * i]) * __expf(fminf(r0 - b0, 80.0f)), kt1 = (1.0f - fav[2 * i + 1]) * __expf(fminf(r1 - b1, 80.0f));
            const unsigned kw = pk(kt0, kt1);
            *(HG_LAS unsigned*)(L + L_KB + (lane >> 4) * 4096 + tau * 64 + ((2 * lane) & 31) * 2) = kw;
            if (OUT) { const float qt0 = qv[2 * i] * __expf(b0 - r0), qt1 = qv[2 * i + 1] * __expf(b1 - r1);
                *(HG_LAS unsigned*)(L + L_QT + tau * QT_S + 4 * lane) = pk(qt0, qt1); *(HG_LAS unsigned*)(L + L_KT + tau * QT_S + 4 * lane) = kw; }
        }
        if (wave == 0) { *(HG_LAS f32x2v*)(ER + 2 * lane) = (f32x2v){__expf(r0), __expf(r1)}; *(HG_LAS f32x2v*)(E2 + 2 * lane) = (f32x2v){__expf(bl0 - r0), __expf(bl1 - r1)}; ldt0 += bl0; ldt1 += bl1; }
        { HG_LAS char* vd = L + L_VB + (seg >> 1) * 4096 + vs * 64 + (seg & 1) * 32; *(HG_LAS u32x4v*)vd = vv0; *(HG_LAS u32x4v*)(vd + 16) = vv1; }
        HG_BAR();
        const float er0 = ER[32 * kb0 + c], er1 = ER[32 * kb0 + 32 + c];
        f32x16 sp0 = st0 * er0, sp1 = st1 * er1;
        if (OUT) {
#pragma unroll
            for (int r = 0; r < 16; ++r) { HG_LAS char* p = L + L_SP + (32 * vb + crow(r, hi)) * SP_S + (32 * kb0 + c) * 2;
                *(HG_LAS unsigned short*)p = bf1(sp0[r]); *(HG_LAS unsigned short*)(p + 64) = bf1(sp1[r]); }
            const int tb = wave >> 1, fr = lane & 15, fq = lane >> 4;
#pragma unroll
            for (int jj = 0; jj < 2; ++jj) {
                const int sb = 2 * (wave & 1) + jj; f32x4v acc = {0.f, 0.f, 0.f, 0.f};
                if (sb <= tb) {
#pragma unroll
                    for (int ks = 0; ks < 4; ++ks) {
                        const bf16x8 af = *(const HG_LAS bf16x8*)(L + L_QT + (16 * tb + fr) * QT_S + (32 * ks + 8 * fq) * 2);
                        const bf16x8 bfr = *(const HG_LAS bf16x8*)(L + L_KT + (16 * sb + fr) * QT_S + (32 * ks + 8 * fq) * 2);
                        acc = __builtin_amdgcn_mfma_f32_16x16x32_bf16(af, bfr, acc, 0, 0, 0);
                    }
                }
                const int s_ = 16 * sb + fr;
#pragma unroll
                for (int r = 0; r < 4; ++r) { const int t_ = 16 * tb + 4 * fq + r; *(HG_LAS unsigned short*)(L + L_AT + t_ * AT_S + s_ * 2) = bf1(s_ <= t_ ? acc[r] : 0.f); }
            }
            HG_BAR();
        }
        bf16x8 vf[4];
        { const HG_LAS char* vbase = L + L_VB + vb * 4096 + (8 * hi + ((lane & 15) >> 2)) * 64 + ((lane >> 4) & 1) * 32 + (lane & 3) * 8;
#pragma unroll
          for (int ks = 0; ks < 4; ++ks) { const s16x4 lo = vtr(vbase + ks * 1024), hh = vtr(vbase + ks * 1024 + 256); vf[ks] = (bf16x8){lo[0], lo[1], lo[2], lo[3], hh[0], hh[1], hh[2], hh[3]}; } }
        if (OUT) {
            const int tb2 = wave & 1; f32x16 o;
#pragma unroll
            for (int r = 0; r < 16; ++r) o[r] = 0.f;
#pragma unroll
            for (int ks = 0; ks < 4; ++ks) { const bf16x8 af = *(const HG_LAS bf16x8*)(L + L_AT + (32 * tb2 + c) * AT_S + (16 * ks + 8 * hi) * 2);
                o = __builtin_amdgcn_mfma_f32_32x32x16_bf16(af, vf[ks], o, 0, 0, 0); }
#pragma unroll
            for (int ks = 0; ks < 8; ++ks) { const bf16x8 af = *(const HG_LAS bf16x8*)(L + L_QT + (32 * tb2 + c) * QT_S + (16 * ks + 8 * hi) * 2);
                const bf16x8 bfr = *(const HG_LAS bf16x8*)(L + L_SP + (32 * vb + c) * SP_S + (16 * ks + 8 * hi) * 2);
                o = __builtin_amdgcn_mfma_f32_32x32x16_bf16(af, bfr, o, 0, 0, 0); }
#pragma unroll
            for (int r = 0; r < 16; ++r) { const int tg = tg0 + 32 * tb2 + crow(r, hi), t = dir ? (8191 - tg) : tg; Od[(rowb + t) * 512 + h * 128 + 32 * vb + c] = o[r]; }
        }
        { const HG_LAS char* kbase = L + L_KB + kb0 * 4096 + (8 * hi + ((lane & 15) >> 2)) * 64 + ((lane >> 4) & 1) * 32 + (lane & 3) * 8;
#pragma unroll
          for (int ks = 0; ks < 4; ++ks) {
              const s16x4 lo0 = vtr(kbase + ks * 1024), hh0 = vtr(kbase + ks * 1024 + 256), lo1 = vtr(kbase + 4096 + ks * 1024), hh1 = vtr(kbase + 4096 + ks * 1024 + 256);
              const bf16x8 k0 = {lo0[0], lo0[1], lo0[2], lo0[3], hh0[0], hh0[1], hh0[2], hh0[3]}, k1 = {lo1[0], lo1[1], lo1[2], lo1[3], hh1[0], hh1[1], hh1[2], hh1[3]};
              sp0 = __builtin_amdgcn_mfma_f32_32x32x16_bf16(vf[ks], k0, sp0, 0, 0, 0); sp1 = __builtin_amdgcn_mfma_f32_32x32x16_bf16(vf[ks], k1, sp1, 0, 0, 0);
          } }
        const float e20 = E2[32 * kb0 + c], e21 = E2[32 * kb0 + 32 + c];
        st0 = sp0 * e20; st1 = sp1 * e21;
    }
    if (!OUT) {
#pragma unroll
        for (int r = 0; r < 16; ++r) { Up[(32 * vb + crow(r, hi)) * 128 + 32 * kb0 + c] = st0[r]; Up[(32 * vb + crow(r, hi)) * 128 + 32 * kb0 + 32 + c] = st1[r]; }
        if (wave == 0) *(f32x2v*)(LDbuf + (size_t)(chain * NSC + sc) * 128 + 2 * lane) = (f32x2v){ldt0, ldt1};
    }
    HG_BAR();
}
}

template <bool OUT>
__device__ __forceinline__ void p_hgrn_mfma(Frame& F, const bf16* Qh, const bf16* Ff, const bf16* Fb, const bf16* Ih, float* Ubuf, float* LDbuf, float* Odir) {
    const float* LB = (const float*)(F.ws + WS_SMALL + SM_LB);
    __syncthreads();
    for (int u = F.vcu; u < 16 * hg::NSC; u += F.G) {
        const int chain = u >> 4, sc = u & 15, dir = chain >> 3, b = (chain >> 2) & 1, h = chain & 3;
        hg::unit<OUT>((LAS char*)(F.lds + RING_OFF), Qh, dir ? Fb : Ff, Ih, LB, Ubuf, LDbuf, Odir + (size_t)dir * M * 512, dir, b, h, sc, chain, F.tid, F.wave, F.lane);
    }
}
__device__ __forceinline__ void p_hgrn_scan(Frame& F, float* Ubuf, const float* LDbuf) {
    const int gt = F.vcu * NWAVES * 64 + F.tid, NT = F.G * NWAVES * 64;
    for (int e = gt; e < 16 * 16384; e += NT) {
        const int chain = e >> 14, vk = e & 16383, k = vk & 127; float carry = 0.f;
#pragma unroll 4
        for (int sc = 0; sc < hg::NSC; ++sc) { float* p = Ubuf + (size_t)(chain * hg::NSC + sc) * 16384 + vk; const float u = *p; *p = carry; carry = __expf(LDbuf[(chain * hg::NSC + sc) * 128 + k]) * carry + u; }
    }
}

namespace fn {
typedef short bf16x8 __attribute__((ext_vector_type(8)));
typedef short s16x4 __attribute__((ext_vector_type(4)));
typedef float f32x16 __attribute__((ext_vector_type(16)));
typedef float f32x4v __attribute__((ext_vector_type(4)));
typedef unsigned u32x4v __attribute__((ext_vector_type(4)));
typedef short v4i16_t __attribute__((ext_vector_type(4)));
#define FN_LAS __attribute__((address_space(3)))
constexpr int U_S = 272, OUT_S = 528, L_U = 0, L_OUT = 17408;
constexpr int N_TT = 256 * 128, N_CP = 64 * 64, N_TC = 128 * 128, N_TAB = N_TT + 2 * N_CP + 2 * N_TC;
__device__ __forceinline__ int crow(int r, int hi) { return (r & 3) + 8 * (r >> 2) + 4 * hi; }
__device__ __forceinline__ s16x4 vtr(const FN_LAS char* p) { return __builtin_bit_cast(s16x4, __builtin_amdgcn_ds_read_tr16_b64_v4i16((FN_LAS v4i16_t*)p)); }
__device__ __forceinline__ unsigned short bf1(float f) { unsigned u = __builtin_bit_cast(unsigned, f); return (unsigned short)((u + 0x7fffu + ((u >> 16) & 1u)) >> 16); }
__device__ __forceinline__ unsigned pk(float lo, float hi) { return (unsigned)bf1(lo) | ((unsigned)bf1(hi) << 16); }
#define FN_BAR() do { asm volatile("s_waitcnt vmcnt(0) lgkmcnt(0)" ::: "memory"); __builtin_amdgcn_s_barrier(); asm volatile("" ::: "memory"); } while (0)

__device__ __forceinline__ unsigned short table_entry(int e) {
    float s, c;
    if (e < N_TT) { const int kcp = e >> 7, cc = e & 127, m = (cc * (kcp & 127)) & 127; sincospif((float)m * (1.0f / 64.0f), &s, &c); return bf1(kcp < 128 ? c : -s); }
    e -= N_TT;
    if (e < 2 * N_CP) { const int i = e & (N_CP - 1), k1 = i >> 6, sl = i & 63, ks2 = sl >> 5, q = (sl >> 3) & 3, j = sl & 7, n1 = 32 * ks2 + (j < 4 ? 4 * q + j : 16 + 4 * q + (j - 4)), m = (k1 * n1) & 63;
        sincospif((float)m * (1.0f / 32.0f), &s, &c); return bf1(e < N_CP ? c : s); }
    e -= 2 * N_CP;
    { const int i = e & (N_TC - 1), k2 = i >> 7, n2 = i & 127, m = (k2 * n2) & 127; sincospif((float)m * (1.0f / 64.0f), &s, &c); return bf1(e < N_TC ? c : s); }
}

struct F1Tabs { bf16x8 tr_[4], ti_[4]; };
__device__ __forceinline__ void f1_unit(FN_LAS char* L, const unsigned short* __restrict__ U, const F1Tabs& tb, const unsigned short* __restrict__ CP, const unsigned short* __restrict__ SP, const float* __restrict__ TW,
                                        unsigned short* AP, int b, int g, int n2, int tid, int wave, int lane) {
    { const int row = tid >> 3, seg = tid & 7; const u32x4v* p = (const u32x4v*)(U + ((size_t)b * 8192 + 128 * row + n2) * 512 + g * 128 + seg * 16);
      const u32x4v v0 = p[0], v1 = p[1]; FN_LAS char* d = L + L_U + row * U_S + seg * 32; *(FN_LAS u32x4v*)d = v0; *(FN_LAS u32x4v*)(d + 16) = v1; }
    FN_BAR();
    const int r = lane & 15, q = lane >> 4;
    f32x4v Zr[4], Zi[4];
#pragma unroll
    for (int nb = 0; nb < 4; ++nb) { Zr[nb] = (f32x4v){0.f, 0.f, 0.f, 0.f}; Zi[nb] = Zr[nb];
#pragma unroll
        for (int ks = 0; ks < 4; ++ks) { const bf16x8 af = *(const FN_LAS bf16x8*)(L + L_U + (16 * nb + r) * U_S + (32 * ks + 8 * q) * 2);
            Zr[nb] = __builtin_amdgcn_mfma_f32_16x16x32_bf16(af, tb.tr_[ks], Zr[nb], 0, 0, 0); Zi[nb] = __builtin_amdgcn_mfma_f32_16x16x32_bf16(af, tb.ti_[ks], Zi[nb], 0, 0, 0); } }
    f32x4v Ar[4], Ai[4];
#pragma unroll
    for (int kb = 0; kb < 4; ++kb) { Ar[kb] = (f32x4v){0.f, 0.f, 0.f, 0.f}; Ai[kb] = Ar[kb]; }
#pragma unroll
    for (int ks2 = 0; ks2 < 2; ++ks2) {
        u32x4v zrw, ziw, nzw;
        zrw[0] = pk(Zr[2 * ks2][0], Zr[2 * ks2][1]); zrw[1] = pk(Zr[2 * ks2][2], Zr[2 * ks2][3]); zrw[2] = pk(Zr[2 * ks2 + 1][0], Zr[2 * ks2 + 1][1]); zrw[3] = pk(Zr[2 * ks2 + 1][2], Zr[2 * ks2 + 1][3]);
        ziw[0] = pk(Zi[2 * ks2][0], Zi[2 * ks2][1]); ziw[1] = pk(Zi[2 * ks2][2], Zi[2 * ks2][3]); ziw[2] = pk(Zi[2 * ks2 + 1][0], Zi[2 * ks2 + 1][1]); ziw[3] = pk(Zi[2 * ks2 + 1][2], Zi[2 * ks2 + 1][3]);
        nzw = zrw ^ 0x80008000u;
        const bf16x8 zr = __builtin_bit_cast(bf16x8, zrw), zi = __builtin_bit_cast(bf16x8, ziw), nzr = __builtin_bit_cast(bf16x8, nzw);
#pragma unroll
        for (int kb = 0; kb < 4; ++kb) {
            const bf16x8 cf = *(const bf16x8*)(CP + (16 * kb + r) * 64 + 32 * ks2 + 8 * q), sf = *(const bf16x8*)(SP + (16 * kb + r) * 64 + 32 * ks2 + 8 * q);
            Ar[kb] = __builtin_amdgcn_mfma_f32_16x16x32_bf16(cf, zr, Ar[kb], 0, 0, 0); Ar[kb] = __builtin_amdgcn_mfma_f32_16x16x32_bf16(sf, zi, Ar[kb], 0, 0, 0);
            Ai[kb] = __builtin_amdgcn_mfma_f32_16x16x32_bf16(cf, zi, Ai[kb], 0, 0, 0); Ai[kb] = __builtin_amdgcn_mfma_f32_16x16x32_bf16(sf, nzr, Ai[kb], 0, 0, 0);
        }
    }
#pragma unroll
    for (int kb = 0; kb < 4; ++kb)
#pragma unroll
        for (int rg = 0; rg < 4; ++rg) { const int k1 = 16 * kb + 4 * q + rg, idx = n2 * k1; const float ct = TW[idx], st = TW[8192 + idx], ar = Ar[kb][rg], ai = Ai[kb][rg];
            FN_LAS char* o = L + L_OUT + k1 * OUT_S + (16 * wave + r) * 2;
            *(FN_LAS unsigned short*)o = bf1(ar * ct + ai * st); *(FN_LAS unsigned short*)(o + 256) = bf1(ai * ct - ar * st); }
    FN_BAR();
    { const int k1 = tid >> 3, seg = tid & 7; const FN_LAS char* s = L + L_OUT + k1 * OUT_S + seg * 64;
      unsigned short* d = AP + ((size_t)(((b * 4 + g) * 64 + k1) * 128 + n2)) * 256 + seg * 32;
#pragma unroll
      for (int i = 0; i < 4; ++i) *(u32x4v*)(d + 8 * i) = *(const FN_LAS u32x4v*)(s + 16 * i); }
}

__device__ __forceinline__ void f2_unit(FN_LAS char* L, const unsigned short* __restrict__ AP, const unsigned short* __restrict__ TC, const unsigned short* __restrict__ TS, unsigned short* O,
                                        int b, int g, int k1, int tid, int wave, int lane) {
    { const unsigned short* src = AP + (size_t)((b * 4 + g) * 64 + k1) * 128 * 256; const int n2 = tid >> 2, qt = tid & 3;
#pragma unroll
      for (int bl2 = 0; bl2 < 2; ++bl2) { const u32x4v* p = (const u32x4v*)(src + n2 * 256 + 64 * qt + 32 * bl2); FN_LAS char* d = L + (2 * qt + bl2) * 8192 + n2 * 64;
          const u32x4v v0 = p[0], v1 = p[1], v2 = p[2], v3 = p[3];
          *(FN_LAS u32x4v*)d = v0; *(FN_LAS u32x4v*)(d + 16) = v1; *(FN_LAS u32x4v*)(d + 32) = v2; *(FN_LAS u32x4v*)(d + 48) = v3; } }
    FN_BAR();
    const int c = lane & 31, hi = lane >> 5, kb2 = wave >> 1, cb0 = 2 * (wave & 1);
    f32x16 y0, y1;
#pragma unroll
    for (int rg = 0; rg < 16; ++rg) { y0[rg] = 0.f; y1[rg] = 0.f; }
    const FN_LAS char* base = L + (8 * hi + ((lane & 15) >> 2)) * 64 + ((lane >> 4) & 1) * 32 + (lane & 3) * 8;
#pragma unroll
    for (int ks = 0; ks < 8; ++ks) {
        const bf16x8 cf = *(const bf16x8*)(TC + (32 * kb2 + c) * 128 + 16 * ks + 8 * hi), sf = *(const bf16x8*)(TS + (32 * kb2 + c) * 128 + 16 * ks + 8 * hi);
#pragma unroll
        for (int i = 0; i < 2; ++i) {
            const FN_LAS char* pr = base + (cb0 + i) * 8192 + ks * 1024; const FN_LAS char* pi = pr + 4 * 8192;
            const s16x4 rl = vtr(pr), rh = vtr(pr + 256), il = vtr(pi), ih = vtr(pi + 256);
            const bf16x8 rf = {rl[0], rl[1], rl[2], rl[3], rh[0], rh[1], rh[2], rh[3]}, imf = {il[0], il[1], il[2], il[3], ih[0], ih[1], ih[2], ih[3]};
            if (i == 0) { y0 = __builtin_amdgcn_mfma_f32_32x32x16_bf16(cf, rf, y0, 0, 0, 0); y0 = __builtin_amdgcn_mfma_f32_32x32x16_bf16(sf, imf, y0, 0, 0, 0); }
            else        { y1 = __builtin_amdgcn_mfma_f32_32x32x16_bf16(cf, rf, y1, 0, 0, 0); y1 = __builtin_amdgcn_mfma_f32_32x32x16_bf16(sf, imf, y1, 0, 0, 0); }
        }
    }
#pragma unroll
    for (int rg = 0; rg < 16; ++rg) { const int k2 = 32 * kb2 + crow(rg, hi); unsigned short* o = O + ((size_t)b * 8192 + k1 + 64 * k2) * 1024 + g * 128 + 32 * cb0 + c;
        o[0] = bf1(y0[rg] * (1.0f / 1024.0f)); o[32] = bf1(y1[rg] * (1.0f / 1024.0f)); }
    FN_BAR();
}
}

constexpr size_t SM_FT = 327680;
__device__ __forceinline__ void p_fnet_tables(Frame& F) {
    unsigned short* T = (unsigned short*)(F.ws + WS_SMALL + SM_FT);
    const int gt = F.vcu * NWAVES * 64 + F.tid, NT = F.G * NWAVES * 64;
    for (int e = gt; e < fn::N_TAB; e += NT) T[e] = fn::table_entry(e);
}
__device__ __forceinline__ void p_fnet1(Frame& F, const bf16* U, bf16* AP) {
    const unsigned short* T = (const unsigned short*)(F.ws + WS_SMALL + SM_FT); const float* TW = (const float*)(F.ws + WS_SMALL + SM_TW);
    const unsigned short* TT = T; const unsigned short* CP = T + fn::N_TT; const unsigned short* SP = CP + fn::N_CP;
    fn::F1Tabs tb; const int r = F.lane & 15, q = F.lane >> 4;
#pragma unroll
    for (int ks = 0; ks < 4; ++ks) { tb.tr_[ks] = *(const fn::bf16x8*)(TT + (16 * F.wave + r) * 128 + 32 * ks + 8 * q); tb.ti_[ks] = *(const fn::bf16x8*)(TT + (128 + 16 * F.wave + r) * 128 + 32 * ks + 8 * q); }
    __syncthreads();
    for (int unit = F.vcu; unit < 2 * 4 * 128; unit += F.G) { const int b = unit >> 9, g = (unit >> 7) & 3, n2 = unit & 127;
        fn::f1_unit((LAS char*)(F.lds + RING_OFF), U, tb, CP, SP, TW, AP, b, g, n2, F.tid, F.wave, F.lane); }
    __syncthreads();
}
__device__ __forceinline__ void p_fnet2(Frame& F, const bf16* AP, bf16* O) {
    const unsigned short* T = (const unsigned short*)(F.ws + WS_SMALL + SM_FT);
    const unsigned short* TC = T + fn::N_TT + 2 * fn::N_CP; const unsigned short* TS = TC + fn::N_TC;
    __syncthreads();
    for (int unit = F.vcu; unit < 2 * 4 * 64; unit += F.G) { const int b = unit >> 8, g = (unit >> 6) & 3, k1 = unit & 63;
        fn::f2_unit((LAS char*)(F.lds + RING_OFF), AP, TC, TS, O, b, g, k1, F.tid, F.wave, F.lane); }
}

#ifndef MK_ONE_LAUNCH
#define MK_ONE_LAUNCH 1
#endif
constexpr int N_PHASES = 18;
struct Args { const float* in[15]; float* out; unsigned char* ws; int ph_lo, ph_hi; };
__global__ void __launch_bounds__(NWAVES * 64, 2) mk_fwd(Args args) {
    extern __shared__ __attribute__((aligned(16))) unsigned char lds[];
    Frame F;
    F.lds = (LAS unsigned char*)lds;
    F.MISC = (volatile LAS unsigned*)(F.lds + MISC_OFF);
    F.tid = threadIdx.x; F.lane = F.tid & 63; F.wave = __builtin_amdgcn_readfirstlane(F.tid >> 6);
    F.G = gridDim.x; { const int bx = blockIdx.x; F.vcu = (F.G % 8 == 0) ? (bx % 8) * (F.G / 8) + bx / 8 : bx; }
    F.ws = args.ws; F.ctl = (gu32*)(args.ws + WS_CTL);
    F.x = args.in[0]; F.c = args.in[1]; F.t5 = args.in[2]; F.lbl = args.in[3]; F.ada_w = args.in[4]; F.ada_b = args.in[5]; F.gains = args.in[6];
    F.ab_in = args.in[7]; F.ab_out = args.in[8]; F.hnorm = args.in[9]; F.cd_in = args.in[10]; F.cd_out = args.in[11]; F.qkn = args.in[12]; F.f_in = args.in[13]; F.f_out = args.in[14];
    F.out = args.out;
    for (int u = F.tid; u < (LDS_BYTES - LDSCTL_OFF) / 4; u += NWAVES * 64) ((LAS unsigned*)(F.lds + LDSCTL_OFF))[u] = 0u;
    __syncthreads();
    XcdBarrier bar; bar.bar = (unsigned*)(F.ctl + CW_BAR); bar.x = 0; bar.st = nullptr;
    if (MK_ONE_LAUNCH) bar = xcd_barrier_post((unsigned*)(F.ctl + CW_BAR), F.MISC + 8);
    const int lo = args.ph_lo, hi = args.ph_hi;
#define IN(k) (lo <= (k) && (k) < hi)
#define SEAM(k) do { if (MK_ONE_LAUNCH && IN(k) && IN((k) + 1)) xcd_barrier(bar); } while (0)
    unsigned char* ws = args.ws;
    float* MOD = (float*)(ws + WS_SMALL + SM_MOD);
    bf16* XN = (bf16*)(ws + WS_XN); bf16* YB = (bf16*)(ws + WS_YB); bf16* Z = (bf16*)(ws + WS_Z);
    bf16* H = Z;
    const float* G0 = F.gains; const float* G1 = F.gains + 4 * 1024;
    float* MOD0 = MOD; float* MOD1 = MOD + 2 * 6144;

    if (IN(0)) { p_adaln(F); p_fnet_tables(F); } SEAM(0);
    if (IN(1)) { p_weights(F); p_rows(F, F.x, nullptr, nullptr, nullptr, nullptr, MOD0, G0, XN); } SEAM(1);
    if (IN(2)) { pg8::Gemm g{XN, (const bf16*)(ws + WS_WINAB), M, 4096, 1024}; pg8::StaticOrder S; S.init(M, 4096, F.G, (int)blockIdx.x);
        pg8::EpiBf16<0> E{Z, 512, nullptr, 512, SEG, 1.0f};
        pg8::gemm_phase<pg8::EpiBf16<0>, pg8::StaticOrder, true, true>(F.lds + RING_OFF, g, S, E); } SEAM(2);
    float* UB = (float*)(ws + WS_YB); float* LDB = UB + (size_t)16 * hg::NSC * 16384;
    if (IN(3)) { p_hgrn_mfma<false>(F, Z + 3 * SEG, Z + 4 * SEG, Z + 5 * SEG, Z + 6 * SEG, UB, LDB, F.out); } if (MK_ONE_LAUNCH && IN(3)) xcd_barrier(bar);
    if (IN(3)) { p_hgrn_scan(F, UB, LDB); p_dilated(F, Z, Z + SEG, Z + 2 * SEG, XN); } if (MK_ONE_LAUNCH && IN(3)) xcd_barrier(bar);
    if (IN(3)) { p_hgrn_mfma<true>(F, Z + 3 * SEG, Z + 4 * SEG, Z + 5 * SEG, Z + 6 * SEG, UB, LDB, F.out); } SEAM(3);
    if (IN(4)) { p_hgrn_final(F, F.out, Z + 7 * SEG, XN); } SEAM(4);
    if (IN(5)) { pg8::Gemm g{XN, (const bf16*)(ws + WS_WOUTAB), M, 1024, 1024}; pg8::StaticOrder S; S.init(M, 1024, F.G, (int)blockIdx.x);
        pg8::EpiBf16<0> E{YB, 1024, nullptr, 0, 0, 1.0f};
        pg8::gemm_phase<pg8::EpiBf16<0>, pg8::StaticOrder, true, true>(F.lds + RING_OFF, g, S, E); } SEAM(5);
    if (IN(6)) { p_rows(F, F.x, YB, MOD0 + 2048, G0 + 1024, F.out, MOD0 + 3072, G0 + 2048, XN); } SEAM(6);
    if (IN(7)) { pg8::Gemm g{XN, (const bf16*)(ws + WS_WF1), M, 2 * FFH, 1024}; pg8::StaticOrder S; S.init(M, 2 * FFH, F.G, (int)blockIdx.x);
        pg8::EpiSwiGLU E{H, FFH};
        pg8::gemm_phase<pg8::EpiSwiGLU, pg8::StaticOrder, true, true>(F.lds + RING_OFF, g, S, E); } SEAM(7);
    if (IN(8)) { pg8::Gemm g{H, (const bf16*)(ws + WS_WF2), M, 1024, FFH}; pg8::StaticOrder S; S.init(M, 1024, F.G, (int)blockIdx.x);
        pg8::EpiBf16<0> E{YB, 1024, nullptr, 0, 0, 1.0f};
        pg8::gemm_phase<pg8::EpiBf16<0>, pg8::StaticOrder, true, true>(F.lds + RING_OFF, g, S, E); } SEAM(8);
    if (IN(9)) { p_rows(F, F.out, YB, MOD0 + 5120, G0 + 3072, F.out, MOD1, G1, XN); } SEAM(9);
    if (IN(10)) { pg8::Gemm g{XN, (const bf16*)(ws + WS_WINCD), M, 1280, 1024}; pg8::StaticOrder S; S.init(M, 1280, F.G, (int)blockIdx.x);
        pg8::EpiBf16<0> E{Z, 512, nullptr, 512, SEG, 1.0f};
        pg8::gemm_phase<pg8::EpiBf16<0>, pg8::StaticOrder, true, true>(F.lds + RING_OFF, g, S, E); } SEAM(10);
    bf16* MIX1 = Z + 4 * SEG;
    bf16* APB = (bf16*)(ws + WS_XN);
    if (IN(11)) { p_qkprep(F, Z + SEG, Z + 2 * SEG, attn_body::C2); p_fnet1(F, Z, APB); } SEAM(11);
    if (IN(12)) { p_fnet2(F, APB, MIX1); __syncthreads();
        const attn_body::AttnTensors AT{(const attn_body::bf16*)(Z + SEG), (const attn_body::bf16*)(Z + 2 * SEG), (const attn_body::bf16*)(Z + 2 * SEG + 128), (attn_body::bf16*)(MIX1 + 512)};
        const attn_body::StaticOrder S(F.vcu);
        attn_body::attn_phase<attn_body::StaticOrder>((char*)lds + RING_OFF, AT, S); } SEAM(12);
    if (IN(13)) { pg8::Gemm g{MIX1, (const bf16*)(ws + WS_WOUTCD), M, 1024, 1024}; pg8::StaticOrder S; S.init(M, 1024, F.G, (int)blockIdx.x);
        pg8::EpiBf16<0> E{YB, 1024, nullptr, 0, 0, 1.0f};
        pg8::gemm_phase<pg8::EpiBf16<0>, pg8::StaticOrder, true, true>(F.lds + RING_OFF, g, S, E); } SEAM(13);
    if (IN(14)) { p_rows(F, F.out, YB, MOD1 + 2048, G1 + 1024, F.out, MOD1 + 3072, G1 + 2048, XN); } SEAM(14);
    if (IN(15)) { pg8::Gemm g{XN, (const bf16*)(ws + WS_WF1 + WF1_BYTES), M, 2 * FFH, 1024}; pg8::StaticOrder S; S.init(M, 2 * FFH, F.G, (int)blockIdx.x);
        pg8::EpiSwiGLU E{H, FFH};
        pg8::gemm_phase<pg8::EpiSwiGLU, pg8::StaticOrder, true, true>(F.lds + RING_OFF, g, S, E); } SEAM(15);
    if (IN(16)) { pg8::Gemm g{H, (const bf16*)(ws + WS_WF2 + WF2_BYTES), M, 1024, FFH}; pg8::StaticOrder S; S.init(M, 1024, F.G, (int)blockIdx.x);
        pg8::EpiBf16<0> E{YB, 1024, nullptr, 0, 0, 1.0f};
        pg8::gemm_phase<pg8::EpiBf16<0>, pg8::StaticOrder, true, true>(F.lds + RING_OFF, g, S, E); } SEAM(16);
    if (IN(17)) { p_rows(F, F.out, YB, MOD1 + 5120, G1 + 3072, F.out, nullptr, nullptr, nullptr); }
#undef IN
#undef SEAM
}

extern "C" void kernel_launch(void* const* d_in, const int* in_sizes, int n_in, void* d_out, int out_size, void* d_ws, size_t ws_size, hipStream_t stream) {
    static int grid = 0;
    if (grid == 0) {
        if (n_in != 15 || in_sizes[0] != M * D || out_size != M * D || ws_size < WS_END) { fprintf(stderr, "kernel_launch: unexpected shapes (n_in %d, in0 %d, out %d, ws %zu)\n", n_in, n_in > 0 ? in_sizes[0] : -1, out_size, ws_size); grid = -1; return; }
        int dev = 0, cus = 0;
        if (hipGetDevice(&dev) != hipSuccess || hipDeviceGetAttribute(&cus, hipDeviceAttributeMultiprocessorCount, dev) != hipSuccess) { grid = -1; return; }
        if (hipFuncSetAttribute((const void*)mk_fwd, hipFuncAttributeMaxDynamicSharedMemorySize, LDS_BYTES) != hipSuccess) { fprintf(stderr, "kernel_launch: hipFuncSetAttribute failed\n"); grid = -1; return; }
        (void)hipGetLastError();
        grid = cus;
    }
    if (grid < 0) return;
    if (hipMemsetAsync((char*)d_ws + WS_CTL, 0, CTL_ZERO_BYTES, stream) != hipSuccess) return;
    Args a{};
    for (int i = 0; i < 15; ++i) a.in[i] = (const float*)d_in[i];
    a.out = (float*)d_out; a.ws = (unsigned char*)d_ws;
#if MK_ONE_LAUNCH
    a.ph_lo = 0; a.ph_hi = N_PHASES;
    hipLaunchKernelGGL(mk_fwd, dim3(grid), dim3(NWAVES * 64), LDS_BYTES, stream, a);
#else
    for (int p = 0; p < N_PHASES; ++p) { a.ph_lo = p; a.ph_hi = p + 1; hipLaunchKernelGGL(mk_fwd, dim3(grid), dim3(NWAVES * 64), LDS_BYTES, stream, a); }
#endif
}
```
